# Optimizing an MI355X kernel written in HIP

```python
import jax, jax.numpy as jnp
from jax import lax
import numpy as np

D_MODEL = 2048
BATCH = 1
SEQ = 16384
DEPTH = 2

N_EVEN = (DEPTH + 1) // 2
N_ODD = DEPTH // 2
PLE_DIM = 256
D_FF = 4 * D_MODEL
ROPE_THETA = 10000.0
NORM_EPS = 1e-6
ATTN_Q_BLOCK = 128

MLA_HEADS = 8
MLA_Q_RANK = 512
MLA_KV_RANK = 512
MLA_NOPE = 128
MLA_ROPE = 64
MLA_V = 128
MLA_QK = MLA_NOPE + MLA_ROPE

SWA_HEADS = 16
SWA_KV_HEADS = 2
SWA_HD = 64
SWA_WINDOW = 128
SWA_BLOCK = 128

EVEN_IN_SPLITS = (MLA_Q_RANK, MLA_KV_RANK, MLA_ROPE, SWA_HEADS * SWA_HD, SWA_KV_HEADS * SWA_HD, SWA_KV_HEADS * SWA_HD)
EVEN_IN_WIDTH = sum(EVEN_IN_SPLITS)
EVEN_MIX_WIDTH = MLA_HEADS * MLA_V + SWA_HEADS * SWA_HD

MOBA_HEADS = 16
MOBA_HD = D_MODEL // MOBA_HEADS
MOBA_BLOCK = 256
MOBA_TOPK = 3
MOBA_Q_CHUNK = 32

kernel_name = 'hybrid_mla_swa_moba_sandwich_block'


def rms_norm(t, g):
    tf = t.astype(jnp.float32)
    y = tf * lax.rsqrt(jnp.mean(tf * tf, axis=-1, keepdims=True) + NORM_EPS)
    return (y * g.astype(jnp.float32)).astype(t.dtype)


def apply_rope(t, positions):
    d = t.shape[-1]
    half = d // 2
    inv_freq = jnp.power(ROPE_THETA, -jnp.arange(half, dtype=jnp.float32) * (2.0 / d))
    ang = positions.astype(jnp.float32)[..., None] * inv_freq
    cos = jnp.cos(ang)[:, :, None, :]
    sin = jnp.sin(ang)[:, :, None, :]
    tf = t.astype(jnp.float32)
    t1, t2 = tf[..., :half], tf[..., half:]
    return jnp.concatenate([t1 * cos - t2 * sin, t2 * cos + t1 * sin], axis=-1).astype(t.dtype)


def mla_causal_attention(q_nope, q_rope, k_nope, k_rope, v):
    B, S, H, _ = q_nope.shape
    nb = S // ATTN_Q_BLOCK
    scale = MLA_QK ** -0.5
    qn = q_nope.reshape(B, nb, ATTN_Q_BLOCK, H, MLA_NOPE).transpose(1, 0, 2, 3, 4)
    qr = q_rope.reshape(B, nb, ATTN_Q_BLOCK, H, MLA_ROPE).transpose(1, 0, 2, 3, 4)
    k_idx = jnp.arange(S)

    def one_block(args):
        i, qn_b, qr_b = args
        s = (jnp.einsum('bqhd,bkhd->bhqk', qn_b, k_nope, preferred_element_type=jnp.float32)
             + jnp.einsum('bqhd,bkd->bhqk', qr_b, k_rope, preferred_element_type=jnp.float32)) * scale
        q_idx = i * ATTN_Q_BLOCK + jnp.arange(ATTN_Q_BLOCK)
        s = jnp.where(k_idx[None, :] <= q_idx[:, None], s, -jnp.inf)
        w = jax.nn.softmax(s, axis=-1).astype(v.dtype)
        return jnp.einsum('bhqk,bkhd->bqhd', w, v)

    out = lax.map(one_block, (jnp.arange(nb), qn, qr))
    return out.transpose(1, 0, 2, 3, 4).reshape(B, S, H * MLA_V)


def swa_sink_attention(q, k, v, sinks):
    B, S, HQ, d = q.shape
    G = HQ // SWA_KV_HEADS
    nb = S // SWA_BLOCK
    qb = q.reshape(B, nb, SWA_BLOCK, SWA_KV_HEADS, G, d)
    kb = k.reshape(B, nb, SWA_BLOCK, SWA_KV_HEADS, d)
    vb = v.reshape(B, nb, SWA_BLOCK, SWA_KV_HEADS, d)

    def with_prev(t):
        prev = jnp.pad(t, ((0, 0), (1, 0), (0, 0), (0, 0), (0, 0)))[:, :-1]
        return jnp.concatenate([prev, t], axis=2)

    kw, vw = with_prev(kb), with_prev(vb)
    s = jnp.einsum('bnqkgd,bnjkd->bnkgqj', qb, kw, preferred_element_type=jnp.float32) * (d ** -0.5)
    q_pos = jnp.arange(SWA_BLOCK)[:, None] + SWA_BLOCK
    k_pos = jnp.arange(2 * SWA_BLOCK)[None, :]
    valid = (k_pos <= q_pos) & (q_pos - k_pos < SWA_WINDOW)
    valid_b = valid[None] & ((jnp.arange(nb)[:, None, None] > 0) | (k_pos[None] >= SWA_BLOCK))
    s = jnp.where(valid_b[None, :, None, None], s, -jnp.inf)
    sink = jnp.broadcast_to(sinks.astype(jnp.float32).reshape(SWA_KV_HEADS, G)[None, None, :, :, None, None],
                            s.shape[:-1] + (1,))
    w = jax.nn.softmax(jnp.concatenate([s, sink], axis=-1), axis=-1)[..., :-1].astype(v.dtype)
    o = jnp.einsum('bnkgqj,bnjkd->bnqkgd', w, vw)
    return o.reshape(B, S, HQ * d)


def moba_attention(q, k, v):
    B, S, H, d = q.shape
    pad = (-S) % MOBA_BLOCK
    padw = ((0, 0), (0, pad), (0, 0), (0, 0))
    q, k, v = jnp.pad(q, padw), jnp.pad(k, padw), jnp.pad(v, padw)
    Sp = S + pad
    nkb = Sp // MOBA_BLOCK
    k_sel_n = min(MOBA_TOPK, nkb)
    scale = d ** -0.5
    kb = k.reshape(B, nkb, MOBA_BLOCK, H, d).transpose(0, 3, 1, 2, 4)
    vb = v.reshape(B, nkb, MOBA_BLOCK, H, d).transpose(0, 3, 1, 2, 4)
    k_mean = jnp.mean(kb.astype(jnp.float32), axis=3)
    gate = jnp.einsum('bshd,bhnd->bhsn', q.astype(jnp.float32), k_mean)
    q_blk = jnp.arange(Sp) // MOBA_BLOCK
    fully_past = jnp.arange(nkb)[None, :] < q_blk[:, None]
    gate = jnp.where(fully_past[None, None], gate, -jnp.inf)
    top_val, top_idx = lax.top_k(gate, k_sel_n)
    sel_ok = jnp.isfinite(top_val)
    C = MOBA_Q_CHUNK
    nq = Sp // C
    qc = q.reshape(B, nq, C, H, d).transpose(1, 0, 2, 3, 4)
    idx_c = top_idx.reshape(B, H, nq, C, k_sel_n).transpose(2, 0, 1, 3, 4)
    ok_c = sel_ok.reshape(B, H, nq, C, k_sel_n).transpose(2, 0, 1, 3, 4)
    b_ix = jnp.arange(B)[:, None, None, None]
    h_ix = jnp.arange(H)[None, :, None, None]

    def one_chunk(args):
        ci, q_c, idx, ok = args
        start = ci * C
        blk = start // MOBA_BLOCK
        k_g = kb[b_ix, h_ix, idx]
        v_g = vb[b_ix, h_ix, idx]
        s_sel = jnp.einsum('bqhd,bhqkjd->bhqkj', q_c, k_g, preferred_element_type=jnp.float32) * scale
        s_sel = jnp.where(ok[..., None], s_sel, -jnp.inf).reshape(B, H, C, k_sel_n * MOBA_BLOCK)
        own_k = lax.dynamic_index_in_dim(kb, blk, axis=2, keepdims=False)
        own_v = lax.dynamic_index_in_dim(vb, blk, axis=2, keepdims=False)
        s_own = jnp.einsum('bqhd,bhjd->bhqj', q_c, own_k, preferred_element_type=jnp.float32) * scale
        q_pos = start + jnp.arange(C)
        k_pos = blk * MOBA_BLOCK + jnp.arange(MOBA_BLOCK)
        s_own = jnp.where(k_pos[None, :] <= q_pos[:, None], s_own, -jnp.inf)
        w = jax.nn.softmax(jnp.concatenate([s_sel, s_own], axis=-1), axis=-1).astype(v.dtype)
        w_sel = w[..., :k_sel_n * MOBA_BLOCK].reshape(B, H, C, k_sel_n, MOBA_BLOCK)
        w_own = w[..., k_sel_n * MOBA_BLOCK:]
        return (jnp.einsum('bhqkj,bhqkjd->bqhd', w_sel, v_g)
                + jnp.einsum('bhqj,bhjd->bqhd', w_own, own_v))

    o = lax.map(one_chunk, (jnp.arange(nq), qc, idx_c, ok_c))
    return o.transpose(1, 0, 2, 3, 4).reshape(B, Sp, H * d)[:, :S]


def even_mixer(h, positions, w_in, q_norm_g, w_q_up, kv_norm_g, w_kv_up, sinks, w_out):
    B, S, _ = h.shape
    proj = h @ w_in
    offs = np.cumsum(EVEN_IN_SPLITS)[:-1].tolist()
    cq, ckv, k_rope, q_s, k_s, v_s = jnp.split(proj, offs, axis=-1)
    q = (rms_norm(cq, q_norm_g) @ w_q_up).reshape(B, S, MLA_HEADS, MLA_QK)
    q_nope = q[..., :MLA_NOPE]
    q_rope = apply_rope(q[..., MLA_NOPE:], positions)
    kv = (rms_norm(ckv, kv_norm_g) @ w_kv_up).reshape(B, S, MLA_HEADS, MLA_NOPE + MLA_V)
    k_nope, v_mla = kv[..., :MLA_NOPE], kv[..., MLA_NOPE:]
    k_rope = apply_rope(k_rope[:, :, None, :], positions)[:, :, 0, :]
    o_mla = mla_causal_attention(q_nope, q_rope, k_nope, k_rope, v_mla)
    q_s = apply_rope(q_s.reshape(B, S, SWA_HEADS, SWA_HD), positions)
    k_s = apply_rope(k_s.reshape(B, S, SWA_KV_HEADS, SWA_HD), positions)
    v_s = v_s.reshape(B, S, SWA_KV_HEADS, SWA_HD)
    o_swa = swa_sink_attention(q_s, k_s, v_s, sinks)
    return jnp.concatenate([o_mla, o_swa], axis=-1) @ w_out


def odd_mixer(h, positions, w_qkv, w_out):
    B, S, _ = h.shape
    q, k, v = jnp.split(h @ w_qkv, 3, axis=-1)
    q = apply_rope(q.reshape(B, S, MOBA_HEADS, MOBA_HD), positions)
    k = apply_rope(k.reshape(B, S, MOBA_HEADS, MOBA_HD), positions)
    v = v.reshape(B, S, MOBA_HEADS, MOBA_HD)
    return moba_attention(q, k, v) @ w_out


def sq_relu_mlp(h, w_up, w_down):
    a = jax.nn.relu(h @ w_up)
    return (a * a) @ w_down


def setup_inputs(seed: int = 0) -> dict:
    key = jax.random.key(seed)
    ks = iter(jax.random.split(key, 32))

    def w(shape, fan_in):
        return jax.random.normal(next(ks), shape, jnp.float32) * (fan_in ** -0.5)

    def gain(shape):
        return 1.0 + 0.05 * jax.random.normal(next(ks), shape, jnp.float32)

    x = jax.random.normal(next(ks), (BATCH, SEQ, D_MODEL), jnp.float32)
    p = jax.random.normal(next(ks), (DEPTH, BATCH, SEQ, PLE_DIM), jnp.float32)
    positions = jnp.broadcast_to(jnp.arange(SEQ, dtype=jnp.int32)[None, :], (BATCH, SEQ))
    return {
        'x': x,
        'p': p,
        'positions': positions,
        'even_pre_g': gain((N_EVEN, D_MODEL)),
        'even_w_in': w((N_EVEN, D_MODEL, EVEN_IN_WIDTH), D_MODEL),
        'mla_q_norm_g': gain((N_EVEN, MLA_Q_RANK)),
        'mla_w_q_up': w((N_EVEN, MLA_Q_RANK, MLA_HEADS * MLA_QK), MLA_Q_RANK),
        'mla_kv_norm_g': gain((N_EVEN, MLA_KV_RANK)),
        'mla_w_kv_up': w((N_EVEN, MLA_KV_RANK, MLA_HEADS * (MLA_NOPE + MLA_V)), MLA_KV_RANK),
        'swa_sinks': jax.random.normal(next(ks), (N_EVEN, SWA_HEADS), jnp.float32),
        'even_w_out': w((N_EVEN, EVEN_MIX_WIDTH, D_MODEL), EVEN_MIX_WIDTH),
        'even_post_g': gain((N_EVEN, D_MODEL)),
        'odd_pre_g': gain((N_ODD, D_MODEL)),
        'moba_w_qkv': w((N_ODD, D_MODEL, 3 * MOBA_HEADS * MOBA_HD), D_MODEL),
        'odd_w_out': w((N_ODD, MOBA_HEADS * MOBA_HD, D_MODEL), MOBA_HEADS * MOBA_HD),
        'odd_post_g': gain((N_ODD, D_MODEL)),
        'mlp_pre_g': gain((DEPTH, D_MODEL)),
        'mlp_w_up': w((DEPTH, D_MODEL, D_FF), D_MODEL),
        'mlp_w_down': w((DEPTH, D_FF, D_MODEL), D_FF),
        'mlp_post_g': gain((DEPTH, D_MODEL)),
        'ple_w_gate': w((DEPTH, D_MODEL, D_MODEL), D_MODEL),
        'ple_b_gate': 0.02 * jax.random.normal(next(ks), (DEPTH, D_MODEL), jnp.float32),
        'ple_w_proj': w((DEPTH, PLE_DIM, D_MODEL), PLE_DIM),
    }


def reference(x, p, positions, even_pre_g, even_w_in, mla_q_norm_g, mla_w_q_up, mla_kv_norm_g,
              mla_w_kv_up, swa_sinks, even_w_out, even_post_g, odd_pre_g, moba_w_qkv, odd_w_out,
              odd_post_g, mlp_pre_g, mlp_w_up, mlp_w_down, mlp_post_g, ple_w_gate, ple_b_gate,
              ple_w_proj):
    h = x
    for i in range(DEPTH):
        j = i // 2
        if i % 2 == 0:
            m = even_mixer(rms_norm(h, even_pre_g[j]), positions, even_w_in[j], mla_q_norm_g[j],
                           mla_w_q_up[j], mla_kv_norm_g[j], mla_w_kv_up[j], swa_sinks[j], even_w_out[j])
            h = h + rms_norm(m, even_post_g[j])
        else:
            m = odd_mixer(rms_norm(h, odd_pre_g[j]), positions, moba_w_qkv[j], odd_w_out[j])
            h = h + rms_norm(m, odd_post_g[j])
        f = sq_relu_mlp(rms_norm(h, mlp_pre_g[i]), mlp_w_up[i], mlp_w_down[i])
        h = h + rms_norm(f, mlp_post_g[i])
        gate = jax.nn.sigmoid(h @ ple_w_gate[i] + ple_b_gate[i])
        h = h + gate * (p[i] @ ple_w_proj[i])
    return h
```

```cpp
#include <hip/hip_runtime.h>
#include <cstdio>
#include <cstdint>
namespace pg8 {
#define PG8_LAS __attribute__((address_space(3)))
typedef unsigned short bf16_t;
typedef short bf16x8 __attribute__((ext_vector_type(8)));
typedef float f32x4 __attribute__((ext_vector_type(4)));
typedef unsigned u32x4 __attribute__((ext_vector_type(4)));
constexpr int BM = 256, BK = 64, HALF = 128, HTB = HALF * BK * 2  , STAGE_BYTES = 8 * HTB, NXCD = 8, WGM = 8;

__host__ __device__ __forceinline__ int lds_byte(int r, int c) { const int st = (r >> 4) * 2 + (c >> 5), rr = r & 15, cc = c & 31, ob = rr * 64 + cc * 2; return st * 1024 + (ob ^ (((ob >> 9) & 1) << 5)); }
__host__ __device__ __forceinline__ void stage_rc(int b, int& R, int& C) { const int st = b / 1024, sb = b % 1024, swz = sb ^ (((sb >> 9) & 1) << 5); R = (st >> 1) * 16 + swz / 64; C = (st & 1) * 32 + (swz % 64) / 2; }
__host__ __device__ __forceinline__ int perm32(int rho) { const int n = rho >> 4, i = rho & 15; return 8 * (i >> 2) + 4 * n + (i & 3); }

struct Unit { int pm, pn; };
struct Gemm { const bf16_t* A; const bf16_t* Bt; int M, N, K, lda; };

struct StaticOrder {
    int nM, nN, nwg, G, c;
    __host__ __device__ void init(int M, int N, int G_, int c_) { nM = M / BM; nN = N / BM; nwg = nM * nN; G = G_; c = c_; }
    __host__ __device__ bool next(int i, Unit& u) const {
        const long L = (long)i * G + c; if (L >= nwg) return false;
        int wgid = (int)L; { const int q = nwg / NXCD, r = nwg % NXCD, xcd = wgid % NXCD, off = wgid / NXCD; wgid = (xcd < r ? xcd * (q + 1) : r * (q + 1) + (xcd - r) * q) + off; }
        const int nig = WGM * nN, gid = wgid / nig, fm = gid * WGM, gsz = (nM - fm) < WGM ? (nM - fm) : WGM;
        u.pm = fm + ((wgid % nig) % gsz); u.pn = (wgid % nig) / gsz; return true;
    }
    __device__ __forceinline__ void a_ready(const Unit&) const {}
    __device__ __forceinline__ void done(const Unit&) const {}
};

__device__ __forceinline__ unsigned cvt_pk_bf16(float lo, float hi) { unsigned r; asm volatile("v_cvt_pk_bf16_f32 %0, %1, %2" : "=v"(r) : "v"(lo), "v"(hi)); return r; }
typedef float f32x2 __attribute__((ext_vector_type(2)));

template <int ACT, bool SUMSQ> struct EpiStore {
    static constexpr bool PERM = true, AFTER_DRAIN = false;
    bf16_t* O0; int ld0; int nt0; bf16_t* O1; int ld1; int nc1; float* SS;
    __device__ __forceinline__ void operator()(const f32x4 (&acc)[2][2][4][2], const Unit& u, int wr, int wc, int fr, int fq) const {
        const int row0 = u.pm * BM + wr * 64 + fr;
        bf16_t* base; int ld, colt, lim;
        if (u.pn < nt0) { base = O0; ld = ld0; colt = u.pn * BM; lim = 0x7fffffff; } else { base = O1; ld = ld1; colt = (u.pn - nt0) * BM; lim = nc1; }
        const int col0 = colt + wc * 32 + 8 * fq;
#pragma unroll
        for (int ai = 0; ai < 2; ++ai)
#pragma unroll
            for (int m = 0; m < 4; ++m) { const int row = row0 + ai * HALF + m * 16; bf16_t* rowp = base + (size_t)row * ld + col0; float ss = 0.f;
#pragma unroll
                for (int bj = 0; bj < 2; ++bj) { f32x4 v0 = acc[ai][bj][m][0], v1 = acc[ai][bj][m][1];
                    if (ACT == 1) {
#pragma unroll
                        for (int e = 0; e < 4; ++e) { const float a = fmaxf(v0[e], 0.f), b = fmaxf(v1[e], 0.f); v0[e] = a * a; v1[e] = b * b; } }
                    if (SUMSQ) ss += (v0[0] * v0[0] + v0[1] * v0[1]) + (v0[2] * v0[2] + v0[3] * v0[3]) + (v1[0] * v1[0] + v1[1] * v1[1]) + (v1[2] * v1[2] + v1[3] * v1[3]);
                    u32x4 w; w.x = cvt_pk_bf16(v0[0], v0[1]); w.y = cvt_pk_bf16(v0[2], v0[3]); w.z = cvt_pk_bf16(v1[0], v1[1]); w.w = cvt_pk_bf16(v1[2], v1[3]);
                    if (col0 + bj * HALF < lim) *(u32x4*)(rowp + bj * HALF) = w; }
                if (SUMSQ) { ss += __shfl_xor(ss, 16); ss += __shfl_xor(ss, 32); if (fq == 0) SS[(size_t)row * 32 + u.pn * 4 + wc] = ss; } }
    }
};
struct EpiPle {
    static constexpr bool PERM = true, AFTER_DRAIN = false;
    float* H; const bf16_t* PP; const float* bias; int ld;
    __device__ __forceinline__ void operator()(const f32x4 (&acc)[2][2][4][2], const Unit& u, int wr, int wc, int fr, int fq) const {
        const int row0 = u.pm * BM + wr * 64 + fr, col0 = u.pn * BM + wc * 32 + 8 * fq;
#pragma unroll
        for (int bj = 0; bj < 2; ++bj) { const f32x4 b0 = *(const f32x4*)(bias + col0 + bj * HALF), b1 = *(const f32x4*)(bias + col0 + bj * HALF + 4);
#pragma unroll
            for (int ai = 0; ai < 2; ++ai)
#pragma unroll
                for (int m = 0; m < 4; ++m) { const size_t off = (size_t)(row0 + ai * HALF + m * 16) * ld + col0 + bj * HALF;
                    const u32x4 pw = *(const u32x4*)(PP + off); f32x4 h0 = *(const f32x4*)(H + off), h1 = *(const f32x4*)(H + off + 4);
                    const f32x4 a0 = acc[ai][bj][m][0] + b0, a1 = acc[ai][bj][m][1] + b1;
                    const unsigned pwv[4] = {pw.x, pw.y, pw.z, pw.w};
#pragma unroll
                    for (int e = 0; e < 4; ++e) { const unsigned w0 = pwv[e >> 1], w1 = pwv[2 + (e >> 1)];
                        const float p0 = __uint_as_float((e & 1) ? (w0 & 0xffff0000u) : (w0 << 16)), p1 = __uint_as_float((e & 1) ? (w1 & 0xffff0000u) : (w1 << 16));
                        h0[e] += p0 / (1.f + __expf(-a0[e])); h1[e] += p1 / (1.f + __expf(-a1[e])); }
                    *(f32x4*)(H + off) = h0; *(f32x4*)(H + off + 4) = h1; } }
    }
};
template <class Epi, class Sched, bool ALIGN_EPI = false, bool SP2 = false>
__device__ __forceinline__ void gemm_phase(PG8_LAS unsigned char* lds, const Gemm g, const Sched& S, const Epi& E) {
    int tid = threadIdx.x; asm volatile("" : "+v"(tid));
    const int wid = __builtin_amdgcn_readfirstlane(tid >> 6), lane = tid & 63, wr = wid >> 2, wc = wid & 3, fr = lane & 15, fq = lane >> 4;
    const int K = g.K, nt = K / BK;
    unsigned voffA[2], voffB[2];
#pragma unroll
    for (int i = 0; i < 2; ++i) { int R, C; stage_rc(tid * 16 + i * 8192, R, C); const int Rb = Epi::PERM ? ((R & ~31) + perm32(R & 31)) : R;
        voffA[i] = (unsigned)(R * g.lda + C) * 2u; voffB[i] = (unsigned)(Rb * K + C) * 2u; }
    const size_t kstep = (size_t)(BK * 2);
    const size_t hstepA = (size_t)HALF * g.lda * 2, hstepB = (size_t)HALF * K * 2;
    const size_t tstepA = 2 * hstepA, tstepB = 2 * hstepB;
    const unsigned ldsw = (unsigned)wid * 1024u;
    const int aoff = lds_byte(wr * 64 + fr, fq * 8), boff = lds_byte(wc * 32 + fr, fq * 8);
#define PG8_SA(b, h) (((b) * 2 + (h)) * HTB)
#define PG8_SB(b, h) ((4 + (b) * 2 + (h)) * HTB)
#define PG8_STAGE(bufoff, gbase, voff) do { _Pragma("unroll") for (int _i = 0; _i < 2; ++_i) \
        __builtin_amdgcn_global_load_lds((const unsigned*)((const char*)(gbase) + (voff)[_i]), (PG8_LAS unsigned*)(lds + (bufoff) + ldsw + _i * 8192), 16, 0, 0); } while (0)
#define PG8_LDA(dst, b, h) do { _Pragma("unroll") for (int m = 0; m < 4; ++m) _Pragma("unroll") for (int k = 0; k < 2; ++k) dst[m][k] = *(const PG8_LAS bf16x8*)(lds + PG8_SA(b, h) + aoff + m * 2048 + k * 1024); } while (0)
#define PG8_LDB(dst, b, h) do { _Pragma("unroll") for (int n = 0; n < 2; ++n) _Pragma("unroll") for (int k = 0; k < 2; ++k) dst[n][k] = *(const PG8_LAS bf16x8*)(lds + PG8_SB(b, h) + boff + n * 2048 + k * 1024); } while (0)
#define PG8_MMA(ai, bj, At, Bt) do { __builtin_amdgcn_s_setprio(1); _Pragma("unroll") for (int m = 0; m < 4; ++m) _Pragma("unroll") for (int n = 0; n < 2; ++n) _Pragma("unroll") for (int k = 0; k < 2; ++k) \
        acc[ai][bj][m][n] = __builtin_amdgcn_mfma_f32_16x16x32_bf16(Bt[n][k], At[m][k], acc[ai][bj][m][n], 0, 0, 0); __builtin_amdgcn_s_setprio(0); } while (0)
#define PG8_WAIT_V(n) asm volatile("s_waitcnt vmcnt(" #n ")" ::: "memory")
#define PG8_WAIT_L(n) asm volatile("s_waitcnt lgkmcnt(" #n ")" ::: "memory")
#define PG8_BAR __builtin_amdgcn_s_barrier()
#define PG8_SCHED __builtin_amdgcn_sched_barrier(0)
    Unit cur, nxt; int ui = 0;
    if (!S.next(0, cur)) return;
    f32x4 acc[2][2][4][2];
#pragma unroll
    for (int a = 0; a < 2; ++a)
#pragma unroll
        for (int b = 0; b < 2; ++b)
#pragma unroll
            for (int m = 0; m < 4; ++m)
#pragma unroll
                for (int n = 0; n < 2; ++n) acc[a][b][m][n] = (f32x4){0.f, 0.f, 0.f, 0.f};
    bf16x8 At[4][2], B0[2][2], B1[2][2];
    const char* cA = (const char*)g.A + (size_t)cur.pm * tstepA; const char* cB = (const char*)g.Bt + (size_t)cur.pn * tstepB;
    S.a_ready(cur);
    if constexpr (SP2) {
        PG8_STAGE(PG8_SB(0, 0), cB, voffB); PG8_STAGE(PG8_SB(0, 1), cB + hstepB, voffB); PG8_STAGE(PG8_SA(0, 0), cA, voffA); PG8_STAGE(PG8_SA(0, 1), cA + hstepA, voffA);
        if (wr == 1) PG8_BAR;
        PG8_WAIT_V(2); PG8_BAR;
        PG8_STAGE(PG8_SB(1, 0), cB + kstep, voffB); PG8_STAGE(PG8_SA(1, 0), cA + kstep, voffA); PG8_STAGE(PG8_SB(1, 1), cB + hstepB + kstep, voffB);
        PG8_WAIT_V(6); PG8_BAR;
    } else {
        PG8_STAGE(PG8_SB(0, 0), cB, voffB); PG8_STAGE(PG8_SA(0, 0), cA, voffA); PG8_STAGE(PG8_SB(0, 1), cB + hstepB, voffB); PG8_STAGE(PG8_SA(0, 1), cA + hstepA, voffA);
        if (wr == 1) PG8_BAR;
        PG8_WAIT_V(4); PG8_BAR;
        PG8_STAGE(PG8_SB(1, 0), cB + kstep, voffB); PG8_STAGE(PG8_SA(1, 0), cA + kstep, voffA); PG8_STAGE(PG8_SB(1, 1), cB + hstepB + kstep, voffB);
        PG8_WAIT_V(6); PG8_BAR;
    }
    for (;;) {
        const bool has_next = S.next(ui + 1, nxt);
        const char* nA = has_next ? (const char*)g.A + (size_t)nxt.pm * tstepA : cA; const char* nB = has_next ? (const char*)g.Bt + (size_t)nxt.pn * tstepB : cB;
        for (int t = 0; t < nt; t += 2) {
            const bool last = (t == nt - 2);
            const char* a1 = cA + (size_t)(t + 1) * kstep;
            const char* a2 = last ? nA : cA + (size_t)(t + 2) * kstep; const char* b2 = last ? nB : cB + (size_t)(t + 2) * kstep;
            const char* a3 = a2 + kstep; const char* b3 = b2 + kstep;
            if (last && has_next) S.a_ready(nxt);
            if constexpr (SP2) {
            PG8_LDB(B0, 0, 0); PG8_LDB(B1, 0, 1); PG8_SCHED; PG8_LDA(At, 0, 0); PG8_STAGE(PG8_SA(1, 1), a1 + hstepA, voffA);
            PG8_WAIT_V(8); PG8_WAIT_L(0); PG8_BAR; PG8_MMA(0, 0, At, B0); PG8_MMA(0, 1, At, B1); PG8_BAR; PG8_SCHED;
            PG8_LDA(At, 0, 1); PG8_STAGE(PG8_SB(0, 0), b2, voffB); PG8_STAGE(PG8_SB(0, 1), b2 + hstepB, voffB); PG8_STAGE(PG8_SA(0, 0), a2, voffA);
            PG8_WAIT_V(8); PG8_WAIT_L(0); PG8_BAR; PG8_MMA(1, 0, At, B0); PG8_MMA(1, 1, At, B1); PG8_BAR; PG8_SCHED;
            PG8_LDB(B0, 1, 0); PG8_LDB(B1, 1, 1); PG8_SCHED; PG8_LDA(At, 1, 0); PG8_STAGE(PG8_SA(0, 1), a2 + hstepA, voffA);
            PG8_WAIT_V(8); PG8_WAIT_L(0); PG8_BAR; PG8_MMA(0, 0, At, B0); PG8_MMA(0, 1, At, B1); PG8_BAR; PG8_SCHED;
            PG8_LDA(At, 1, 1); PG8_STAGE(PG8_SB(1, 0), b3, voffB); PG8_STAGE(PG8_SB(1, 1), b3 + hstepB, voffB); PG8_STAGE(PG8_SA(1, 0), a3, voffA);
            PG8_WAIT_V(8); PG8_WAIT_L(0); PG8_BAR; PG8_MMA(1, 0, At, B0); PG8_MMA(1, 1, At, B1); PG8_BAR; PG8_SCHED;
            } else {
            PG8_LDB(B0, 0, 0); PG8_SCHED; PG8_LDA(At, 0, 0); PG8_STAGE(PG8_SA(1, 1), a1 + hstepA, voffA);
            PG8_WAIT_L(8); PG8_BAR; PG8_WAIT_L(0); PG8_MMA(0, 0, At, B0); PG8_BAR; PG8_SCHED;
            PG8_LDB(B1, 0, 1); PG8_STAGE(PG8_SB(0, 0), b2, voffB);
            PG8_BAR; PG8_WAIT_L(0); PG8_MMA(0, 1, At, B1); PG8_BAR;
            PG8_LDA(At, 0, 1); PG8_STAGE(PG8_SA(0, 0), a2, voffA);
            PG8_BAR; PG8_WAIT_L(0); PG8_MMA(1, 0, At, B0); PG8_BAR; PG8_SCHED;
            PG8_STAGE(PG8_SB(0, 1), b2 + hstepB, voffB);
            PG8_WAIT_V(6); PG8_BAR; PG8_MMA(1, 1, At, B1); PG8_BAR;
            PG8_LDB(B0, 1, 0); PG8_SCHED; PG8_LDA(At, 1, 0); PG8_STAGE(PG8_SA(0, 1), a2 + hstepA, voffA);
            PG8_WAIT_L(8); PG8_BAR; PG8_WAIT_L(0); PG8_MMA(0, 0, At, B0); PG8_BAR; PG8_SCHED;
            PG8_LDB(B1, 1, 1); PG8_STAGE(PG8_SB(1, 0), b3, voffB);
            PG8_BAR; PG8_WAIT_L(0); PG8_MMA(0, 1, At, B1); PG8_BAR;
            PG8_LDA(At, 1, 1); PG8_STAGE(PG8_SA(1, 0), a3, voffA);
            PG8_BAR; PG8_WAIT_L(0); PG8_MMA(1, 0, At, B0); PG8_BAR; PG8_SCHED;
            PG8_STAGE(PG8_SB(1, 1), b3 + hstepB, voffB);
            PG8_WAIT_V(6); PG8_BAR; PG8_MMA(1, 1, At, B1); PG8_BAR;
            }
        }
        if constexpr (ALIGN_EPI) { if (wr == 0) PG8_BAR; }
        if constexpr (!Epi::AFTER_DRAIN) { E(acc, cur, wr, wc, fr, fq); S.done(cur); }
        if (!has_next) break;
#pragma unroll
        for (int a = 0; a < 2; ++a)
#pragma unroll
            for (int b = 0; b < 2; ++b)
#pragma unroll
                for (int m = 0; m < 4; ++m)
#pragma unroll
                    for (int n = 0; n < 2; ++n) acc[a][b][m][n] = (f32x4){0.f, 0.f, 0.f, 0.f};
        cur = nxt; cA = nA; cB = nB; ++ui;
        if constexpr (ALIGN_EPI) { if (wr == 1) PG8_BAR; }
    }
    PG8_WAIT_V(0);
    if constexpr (!ALIGN_EPI) { if (wr == 0) PG8_BAR; }
    PG8_BAR;
    if constexpr (Epi::AFTER_DRAIN) { E.fused(acc, cur, wr, wc, fr, fq, lds, wid, lane); S.done(cur); }
#undef PG8_SA
#undef PG8_SB
#undef PG8_STAGE
#undef PG8_LDA
#undef PG8_LDB
#undef PG8_MMA
#undef PG8_WAIT_V
#undef PG8_WAIT_L
#undef PG8_BAR
#undef PG8_SCHED
}
}

namespace att {
typedef unsigned short bf16_t;
typedef short bf16x8 __attribute__((ext_vector_type(8)));
typedef short s16x4 __attribute__((ext_vector_type(4)));
typedef float f32x16 __attribute__((ext_vector_type(16)));
typedef float f32x4 __attribute__((ext_vector_type(4)));
typedef unsigned u32x4 __attribute__((ext_vector_type(4)));
constexpr int NW = 8, QBLK = 32, KVBLK = 64, SHM_V = 16384;
constexpr int LDS_V = 0, LDS_K = 2 * SHM_V, LDS_WS = LDS_K + 2 * 24576, LDS_OTAB = LDS_WS + NW * 256, LDS_PFX = LDS_OTAB + NW * 128, LDS_END = LDS_PFX + 8192;
#define SBAR() __builtin_amdgcn_sched_barrier(0)
__device__ __forceinline__ int v_st(int k, int c) { const int kk = (k & ~0xC) | ((k & 4) << 1) | ((k & 8) >> 1); return ((kk >> 3) * 4 + (c >> 5)) * 512 + ((kk & 7) * 32 + (c & 31)) * 2; }
__device__ __forceinline__ int v_rd_base(int lane) { return ((lane & 3) << 3) | (((lane >> 2) & 3) << 6) | (((lane >> 4) & 1) << 5) | (((lane >> 5) & 1) << 8); }
constexpr int v_rd_off(int d0, int ks, int half) { return d0 * 512 + ks * 4096 + half * 2048; }
__device__ __forceinline__ int crow(int r, int hi) { return (r & 3) + 8 * (r >> 2) + 4 * hi; }
__device__ __forceinline__ unsigned cvtpk(float lo, float hi) { unsigned r; asm volatile("v_cvt_pk_bf16_f32 %0, %1, %2" : "=v"(r) : "v"(lo), "v"(hi)); return r; }
__device__ __forceinline__ float bf2f(unsigned short x) { return __uint_as_float((unsigned)x << 16); }
template <int DQK> __device__ __forceinline__ int kswz(int row, int colB) { return row * (DQK * 2) + (colB ^ ((row & 7) << 4)); }
__device__ __forceinline__ void mask_tile(f32x16& p0, f32x16& p1, int dq, unsigned W) {
    const float NEG = -__builtin_inff();
#pragma unroll
    for (int r = 0; r < 16; ++r) { const int c = (r & 3) + 8 * (r >> 2);
        if ((unsigned)(dq - c) >= W) p0[r] = NEG;
        if ((unsigned)(dq - c - 32) >= W) p1[r] = NEG; }
}
__device__ __forceinline__ void partialSM(f32x16& p0, f32x16& p1, float& m_reg, float& alpha, float sc, float c2) {
    float pmax = p0[0];
#pragma unroll
    for (int r = 1; r < 16; ++r) pmax = fmaxf(pmax, p0[r]);
#pragma unroll
    for (int r = 0; r < 16; ++r) pmax = fmaxf(pmax, p1[r]);
    { auto rr = __builtin_amdgcn_permlane32_swap(__float_as_uint(pmax), __float_as_uint(pmax), false, false);
      pmax = fmaxf(__uint_as_float(rr[0]), __uint_as_float(rr[1])); }
    float mn;
    if (__builtin_expect(__all((pmax - m_reg) * sc <= 8.f), 1)) { mn = m_reg; alpha = 1.f; }
    else { mn = fmaxf(m_reg, pmax); alpha = __builtin_amdgcn_exp2f((m_reg - mn) * c2); m_reg = mn; }
    const float mnL = -mn * c2;
#pragma unroll
    for (int r = 0; r < 16; ++r) p0[r] = __builtin_amdgcn_exp2f(fmaf(p0[r], c2, mnL));
#pragma unroll
    for (int r = 0; r < 16; ++r) p1[r] = __builtin_amdgcn_exp2f(fmaf(p1[r], c2, mnL));
}
__device__ __forceinline__ void finishSM(f32x16& p0, f32x16& p1, float alpha, float& l_reg, bf16x8& pa0, bf16x8& pa1, bf16x8& pa2, bf16x8& pa3) {
    float ps = 0;
#pragma unroll
    for (int r = 0; r < 16; ++r) ps += p0[r];
#pragma unroll
    for (int r = 0; r < 16; ++r) ps += p1[r];
    { auto rr = __builtin_amdgcn_permlane32_swap(__float_as_uint(ps), __float_as_uint(ps), false, false);
      ps = __uint_as_float(rr[0]) + __uint_as_float(rr[1]); }
    l_reg = l_reg * alpha + ps;
#define PK4(P, B_, OUT) do { unsigned a0 = cvtpk(P[B_+0], P[B_+1]), a1 = cvtpk(P[B_+2], P[B_+3]);                          \
        unsigned b0 = cvtpk(P[B_+4], P[B_+5]), b1 = cvtpk(P[B_+6], P[B_+7]);                                             \
        auto r0 = __builtin_amdgcn_permlane32_swap(a0, b0, false, false); auto r1 = __builtin_amdgcn_permlane32_swap(a1, b1, false, false); \
        u32x4 w = {r0[0], r1[0], r0[1], r1[1]}; OUT = *reinterpret_cast<bf16x8*>(&w); } while (0)
    PK4(p0, 0, pa0); PK4(p0, 8, pa1); PK4(p1, 0, pa2); PK4(p1, 8, pa3);
#undef PK4
}
template <int DQK>
__device__ __forceinline__ void qkt(f32x16& p0, f32x16& p1, const char* Kbuf, int r32, int hi, const bf16x8* qr) {
    p0 = f32x16{}; p1 = f32x16{};
    const int sw = (r32 & 7) << 4; const char* rb = Kbuf + r32 * (DQK * 2);
#pragma unroll
    for (int d0 = 0; d0 < DQK / 16; ++d0) { const char* a = rb + ((d0 * 32 + hi * 16) ^ sw);
        const bf16x8 b0 = *reinterpret_cast<const bf16x8*>(a);
        const bf16x8 b1 = *reinterpret_cast<const bf16x8*>(a + 32 * DQK * 2);
        p0 = __builtin_amdgcn_mfma_f32_32x32x16_bf16(b0, qr[d0], p0, 0, 0, 0);
        p1 = __builtin_amdgcn_mfma_f32_32x32x16_bf16(b1, qr[d0], p1, 0, 0, 0); }
}
template <int DV>
__device__ __forceinline__ void pv_tile(f32x16* o, int vb, bf16x8 pa0, bf16x8 pa1, bf16x8 pa2, bf16x8 pa3) {
#define TRRD(dst, off) asm volatile("ds_read_b64_tr_b16 %0, %1 offset:%2" : "=&v"(dst) : "v"(vb), "i"(off) : "memory")
#define PV_D0(d0) do { s16x4 l0, l1, l2, l3, h0, h1, h2, h3; constexpr int b_ = v_rd_off(d0, 0, 0);   \
        TRRD(l0, b_); TRRD(h0, b_ + 2048); TRRD(l1, b_ + 4096); TRRD(h1, b_ + 6144); TRRD(l2, b_ + 8192); TRRD(h2, b_ + 10240); TRRD(l3, b_ + 12288); TRRD(h3, b_ + 14336); \
        asm volatile("s_waitcnt lgkmcnt(0)" ::: "memory"); SBAR();   \
        o[d0] = __builtin_amdgcn_mfma_f32_32x32x16_bf16(pa0, (bf16x8){l0[0], l0[1], l0[2], l0[3], h0[0], h0[1], h0[2], h0[3]}, o[d0], 0, 0, 0);   \
        o[d0] = __builtin_amdgcn_mfma_f32_32x32x16_bf16(pa1, (bf16x8){l1[0], l1[1], l1[2], l1[3], h1[0], h1[1], h1[2], h1[3]}, o[d0], 0, 0, 0);   \
        o[d0] = __builtin_amdgcn_mfma_f32_32x32x16_bf16(pa2, (bf16x8){l2[0], l2[1], l2[2], l2[3], h2[0], h2[1], h2[2], h2[3]}, o[d0], 0, 0, 0);   \
        o[d0] = __builtin_amdgcn_mfma_f32_32x32x16_bf16(pa3, (bf16x8){l3[0], l3[1], l3[2], l3[3], h3[0], h3[1], h3[2], h3[3]}, o[d0], 0, 0, 0); } while (0)
    PV_D0(0); PV_D0(1);
    if constexpr (DV == 128) { PV_D0(2); PV_D0(3); }
#undef PV_D0
#undef TRRD
}
struct Job {
    const bf16_t* K; long ldk;
    const bf16_t* K2; long ldk2;
    const bf16_t* V; long ldv;
    int j_lo, j_hi;
    int wq_lo;
    int qpos;
    unsigned W;
    int nomask;
    float m0, l0;
    float sc, c2;
};
template <int DQK, int DV>
__device__ __forceinline__ void attn_core(__attribute__((address_space(3))) unsigned char* lds3, const Job& J, const bf16x8* qr, f32x16* o, float& m_reg, float& l_reg) {
    constexpr int KB = KVBLK * DQK * 2, NKC = DQK / 8, NKT = DQK / 64, NVT = DV / 64;
    char* lds = (char*)lds3;
    int tid = threadIdx.x; asm volatile("" : "+v"(tid));
    const int wid = __builtin_amdgcn_readfirstlane(tid >> 6), lane = tid & 63, r32 = lane & 31, hi = lane >> 5;
    char* V_lds = lds + LDS_V; char* K_lds = lds + LDS_K;
    float* al_l = (float*)(lds + LDS_WS) + wid * 64 + 32;
    const bf16_t* ksrc[NKT]; long kld[NKT]; const bf16_t* vsrc[NVT];
#pragma unroll
    for (int i = 0; i < NKT; ++i) { const int q = (wid * NKT + i) * 64 + lane, row = q / NKC, pos = q % NKC, ch = pos ^ (row & 7);
        if (DQK == 192 && ch >= 16) { ksrc[i] = J.K2 + (long)row * J.ldk2 + (ch - 16) * 8; kld[i] = J.ldk2; } else { ksrc[i] = J.K + (long)row * J.ldk + ch * 8; kld[i] = J.ldk; } }
#pragma unroll
    for (int i = 0; i < NVT; ++i) { const int m = (DV == 128) ? (wid * 2 + i) : (wid * 2), q = m * 64 + lane, st = q >> 5, w = q & 31, kk = ((st >> 2) << 3) | (w >> 2), c = (st & 3) * 32 + (w & 3) * 8;
        const int k = (kk & ~0xC) | ((kk & 4) << 1) | ((kk & 8) >> 1); vsrc[i] = J.V + (long)k * J.ldv + c; }
#define LOADT(j, bf) do { const long kb_ = (long)(j) * KVBLK; \
        _Pragma("unroll") for (int i = 0; i < NKT; ++i) __builtin_amdgcn_global_load_lds((const unsigned*)(ksrc[i] + kb_ * kld[i]), (__attribute__((address_space(3))) unsigned*)(lds3 + LDS_K + (bf) * KB + (wid * NKT + i) * 1024), 16, 0, 0); \
        _Pragma("unroll") for (int i = 0; i < NVT; ++i) __builtin_amdgcn_global_load_lds((const unsigned*)(vsrc[i] + kb_ * J.ldv), (__attribute__((address_space(3))) unsigned*)(lds3 + LDS_V + (bf) * SHM_V + ((DV == 128) ? (wid * 2 + i) : (wid * 2)) * 1024), 16, 0, 0); } while (0)
    const int vb0 = (int)(uintptr_t)V_lds + v_rd_base(lane);
    m_reg = J.m0; l_reg = J.l0;
#pragma unroll
    for (int d = 0; d < DV / 32; ++d) o[d] = f32x16{};
    const int NT = J.j_hi - J.j_lo;
    LOADT(J.j_lo, 0); asm volatile("s_waitcnt vmcnt(0)" ::: "memory"); __syncthreads();
    for (int t = 0; t < NT; ++t) {
        const int bf = t & 1, kbase = (J.j_lo + t) * KVBLK;
        if (t + 1 < NT) LOADT(J.j_lo + t + 1, bf ^ 1);
        const bool act = J.nomask || ((kbase <= J.wq_lo + QBLK - 1) && (kbase + KVBLK - 1 >= J.wq_lo - (int)J.W + 1));
        if (act) {
            f32x16 p0, p1; bf16x8 pa0, pa1, pa2, pa3; float alpha;
            qkt<DQK>(p0, p1, K_lds + bf * KB, r32, hi, qr);
            if (!J.nomask && (kbase + KVBLK - 1 > J.wq_lo || kbase <= J.wq_lo + QBLK - 1 - (int)J.W)) mask_tile(p0, p1, J.qpos - 4 * hi - kbase, J.W);
            partialSM(p0, p1, m_reg, alpha, J.sc, J.c2);
            if (__any(alpha < 1.f)) { if (hi == 0) al_l[r32] = alpha; asm volatile("s_waitcnt lgkmcnt(0)" ::: "memory");
#pragma unroll
                for (int d_ = 0; d_ < DV / 32; ++d_)
#pragma unroll
                    for (int r = 0; r < 16; ++r) o[d_][r] *= al_l[crow(r, hi)]; }
            finishSM(p0, p1, alpha, l_reg, pa0, pa1, pa2, pa3); SBAR();
            pv_tile<DV>(o, vb0 + bf * SHM_V, pa0, pa1, pa2, pa3);
        }
        asm volatile("s_waitcnt vmcnt(0)" ::: "memory");
        __syncthreads();
    }
#undef LOADT
}
template <int DV, bool CONTIG>
__device__ __forceinline__ void store_o(__attribute__((address_space(3))) unsigned char* lds3, const f32x16* o, float l_reg, bf16_t* Ob, long ldo) {
    char* lds = (char*)lds3; int tid = threadIdx.x; asm volatile("" : "+v"(tid));
    const int wid = __builtin_amdgcn_readfirstlane(tid >> 6), lane = tid & 63, r32 = lane & 31, hi = lane >> 5;
    float* li_l = (float*)(lds + LDS_WS) + wid * 64; const int* rtab = (const int*)(lds + LDS_OTAB) + wid * 32;
    if (hi == 0) li_l[r32] = l_reg; asm volatile("s_waitcnt lgkmcnt(0)" ::: "memory");
#pragma unroll
    for (int r = 0; r < 16; ++r) { const int orow = crow(r, hi); const float rl = __builtin_amdgcn_rcpf(li_l[orow]);
        long drow = orow; if (!CONTIG) drow = rtab[orow];
#pragma unroll
        for (int d0 = 0; d0 < DV / 32; ++d0) { const float v = o[d0][r] * rl; const float vn = __shfl_xor(v, 1);
            if ((r32 & 1) == 0 && drow >= 0) *(unsigned*)(Ob + drow * ldo + d0 * 32 + r32) = cvtpk(v, vn); } }
}
#undef SBAR
}

#define GAS __attribute__((address_space(1)))
#define LAS __attribute__((address_space(3)))
typedef unsigned short bf16;
typedef unsigned v4u __attribute__((ext_vector_type(4)));
typedef float f32x4 __attribute__((ext_vector_type(4)));
typedef short bf16x8 __attribute__((ext_vector_type(8)));
typedef GAS unsigned gu32;
typedef GAS unsigned long long gu64;
#define RLX_AGENT __ATOMIC_RELAXED, __HIP_MEMORY_SCOPE_AGENT
#define LDS_WAIT() asm volatile("s_waitcnt lgkmcnt(0)" ::: "memory")
#define VM_WAIT() asm volatile("s_waitcnt vmcnt(0)" ::: "memory")
__device__ __forceinline__ unsigned long long rt() { return __builtin_amdgcn_s_memrealtime(); }
__device__ __forceinline__ unsigned f2bf(float f) { unsigned u = __builtin_bit_cast(unsigned, f); return (u + 0x7fffu + ((u >> 16) & 1u)) >> 16; }
__device__ __forceinline__ unsigned pk2(float lo, float hi) { return f2bf(lo) | (f2bf(hi) << 16); }

#define XB_TMO      128
#define XB_XCNT(j)  (256  + 64 * (j))
#define XB_XSUB(j)  (1280 + 64 * (j))
#define XB_XGEN(j)  (2304 + 64 * (j))
#define XB_TOP      3328
#define XB_TOPGEN   3392
#define XCD_BAR_WORDS 3456
#define XB_SPIN_CAP (1u << 18)

__device__ __forceinline__ unsigned xb_ld(unsigned* p)              { return __hip_atomic_load(p, __ATOMIC_RELAXED, __HIP_MEMORY_SCOPE_AGENT); }
__device__ __forceinline__ unsigned xb_add(unsigned* p, unsigned v) { return __hip_atomic_fetch_add(p, v, __ATOMIC_RELAXED, __HIP_MEMORY_SCOPE_AGENT); }
__device__ __forceinline__ unsigned xb_xcc_id() { return (unsigned)__builtin_amdgcn_s_getreg((3 << 11) | 20) & 0xFu; }
#define XB_SPIN(cond, bar) do { unsigned _sp = 0; while (cond) { __builtin_amdgcn_s_sleep(1); \
    if ((++_sp & 255u) == 0u) { if (xb_ld(&(bar)[XB_TMO])) break; if (_sp > XB_SPIN_CAP) { atomicAdd(&(bar)[XB_TMO], 1u); break; } } } } while (0)

struct XcdBarrier {
    unsigned* bar; unsigned x;
    volatile LAS unsigned* st;
};

__device__ __forceinline__ XcdBarrier xcd_barrier_post(unsigned* bar, volatile LAS unsigned* st) {
    XcdBarrier b; b.bar = bar; b.x = xb_xcc_id(); b.st = st;
    if (threadIdx.x == 0) (void)xb_add(&bar[XB_XCNT(b.x)], 1u);
    return b;
}
__device__ __forceinline__ void xcd_barrier_complete(unsigned* bar, unsigned x, unsigned& nloc, unsigned& nx) {
    const unsigned G = gridDim.x * gridDim.y * gridDim.z;
    unsigned sum, cnt, mine, sp = 0u;
    for (;;) {
        sum = 0u; cnt = 0u; mine = 0u;
#pragma unroll
        for (unsigned j = 0; j < 16; ++j) { const unsigned c = xb_ld(&bar[XB_XCNT(j)]); sum += c; cnt += (c > 0u) ? 1u : 0u; mine = (j == x) ? c : mine; }
        if (sum == G) break;
        __builtin_amdgcn_s_sleep(1);
        if ((++sp & 255u) == 0u) { if (xb_ld(&bar[XB_TMO])) break; if (sp > XB_SPIN_CAP) { atomicAdd(&bar[XB_TMO], 1u); break; } }
    }
    nloc = mine > 0u ? mine : 1u; nx = cnt > 0u ? cnt : 1u;
}

__device__ __forceinline__ void xcd_barrier(const XcdBarrier& b) {
    asm volatile("s_waitcnt vmcnt(0)" ::: "memory");
    __syncthreads();
    if (threadIdx.x == 0) {
        unsigned* bar = b.bar;
        __builtin_amdgcn_s_waitcnt(0);
        unsigned nloc = b.st[0], nx = b.st[1];
        if (nloc == 0u) { xcd_barrier_complete(bar, b.x, nloc, nx); b.st[0] = nloc; b.st[1] = nx; }
        const unsigned old = xb_add(&bar[XB_XSUB(b.x)], 1u);
        const unsigned gen = old / nloc;
        if (old + 1u == (gen + 1u) * nloc) {
            __builtin_amdgcn_fence(__ATOMIC_RELEASE, "agent");
            asm volatile("s_waitcnt vmcnt(0)" ::: "memory");
            const unsigned og = xb_add(&bar[XB_TOP], 1u);
            const unsigned tg = og / nx;
            if (og + 1u == (tg + 1u) * nx) xb_add(&bar[XB_TOPGEN], 1u);
            else XB_SPIN(xb_ld(&bar[XB_TOPGEN]) == tg, bar);
            __builtin_amdgcn_fence(__ATOMIC_ACQUIRE, "agent");
            xb_add(&bar[XB_XGEN(b.x)], 1u);
            asm volatile("s_waitcnt vmcnt(0)" ::: "memory");
        } else {
            XB_SPIN(xb_ld(&bar[XB_XGEN(b.x)]) == gen, bar);
            __builtin_amdgcn_fence(__ATOMIC_ACQUIRE, "agent");
            asm volatile("s_waitcnt vmcnt(0)" ::: "memory");
        }
    }
    __syncthreads();
}

constexpr int NWAVES = 8;
constexpr int S = 16384, DM = 2048, FF = 8192, PLED = 256;
constexpr int NIN_PAD = 2560;
constexpr int SWAW = 1344;
constexpr float NORM_EPS = 1e-6f;
#ifndef MK_N_LAUNCHES
#define MK_N_LAUNCHES 0
#endif
constexpr size_t MiB = 1u << 20;
constexpr size_t WS_CTL = 0, CTL_ZERO_BYTES = 1 * MiB;
constexpr size_t WS_CS64 = 1 * MiB, WS_CS128 = 5 * MiB, WS_SS = 13 * MiB, WS_KM = 15 * MiB, WS_LIST = 16 * MiB, WS_PLSE = 32 * MiB, WS_PB = 36 * MiB;
constexpr size_t WS_WB = 52 * MiB, WS_XN = 160 * MiB, WS_M = 224 * MiB, WS_AR = 288 * MiB, WS_END = 555 * MiB;
constexpr size_t WB_UP = 0, WB_DOWN = 32 * MiB, WB_GATE = 64 * MiB, WB_PROJ = 72 * MiB, WB_OUT = 73 * MiB, WB_MIX = 81 * MiB;
constexpr size_t WB_IN = WB_MIX, WB_QUP = WB_MIX + 10 * MiB, WB_KVUP = WB_QUP + 3 * MiB / 2, WB_QKV = WB_MIX;
constexpr size_t WS_CQKV = WS_AR, WS_SWAB = WS_AR + 32 * MiB, WS_Q = WS_AR + 74 * MiB, WS_KV = WS_AR + 122 * MiB;
constexpr size_t WS_HID = WS_AR, WS_PP = WS_AR + 128 * MiB;
constexpr size_t WS_QKV = WS_M, WS_PART = WS_M + 192 * MiB;
static_assert(WS_KV + 64 * MiB <= WS_END && WS_PP + 64 * MiB <= WS_END && WS_PART + 128 * MiB <= WS_END, "d_ws map");
constexpr int CW_TMO = 0, CW_BAR = 4096, CW_CNT = 131072;
constexpr int LIST_PER_HEAD = 516096;
__host__ __device__ __forceinline__ int list_off(int j) { return 256 * (63 * j - (j * (j - 1)) / 2); }
constexpr int RING_BYTES = 131072, LDSCTL_OFF = RING_BYTES, MISC_OFF = LDSCTL_OFF + 320, LDS_BYTES = 147456;
static_assert(att::LDS_END <= RING_BYTES, "attention scratch inside the ring region");

typedef unsigned v2u __attribute__((ext_vector_type(2)));
typedef float f32x2 __attribute__((ext_vector_type(2)));
__device__ __forceinline__ float bflo(unsigned w) { return __uint_as_float(w << 16); }
__device__ __forceinline__ float bfhi(unsigned w) { return __uint_as_float(w & 0xffff0000u); }

#define PH_TID() int tid_ = threadIdx.x; asm volatile("" : "+v"(tid_)); const int lane_ = tid_ & 63; const int wave_ = __builtin_amdgcn_readfirstlane(tid_ >> 6); (void)lane_; (void)wave_
struct Frame {
    LAS unsigned char* lds; unsigned char* ldsg; volatile LAS unsigned* MISC; gu32* ctl;
    int vcu, G;
    const void* const* in; float* out; unsigned char* ws;
};
__device__ __forceinline__ float wave_sum(float v) {
#pragma unroll
    for (int o = 1; o < 64; o <<= 1) v += __shfl_xor(v, o);
    return v;
}
__device__ __forceinline__ int remap_in(int n0) {
    if (n0 < 1024) return n0; if (n0 < 1088) return 2304 + (n0 - 1024); if (n0 < 2112) return 1024 + (n0 - 1088); if (n0 < 2240) return 2048 + (n0 - 2112); return 2176 + (n0 - 2240);
}
__device__ __forceinline__ void transpose_item(const float* W, int K, int N, bf16* WT, bool remap, LAS float* scr, int item, int lane) {
    const int nblk = N / 32, kb = item / nblk, nb = item % nblk, k0 = 64 * kb, n0 = 32 * nb; const int r0 = remap ? remap_in(n0) : n0;
#pragma unroll 8
    for (int i = 0; i < 32; ++i) { const int kk = 2 * i + (lane >> 5); scr[kk * 33 + (lane & 31)] = W[(size_t)(k0 + kk) * N + n0 + (lane & 31)]; }
    LDS_WAIT(); asm volatile("" ::: "memory");
    const int c = lane & 7;
#pragma unroll
    for (int j = 0; j < 4; ++j) { const int n = (lane >> 3) + 8 * j; const LAS float* s = scr + (8 * c) * 33 + n;
        v4u o; o.x = pk2(s[0 * 33], s[1 * 33]); o.y = pk2(s[2 * 33], s[3 * 33]); o.z = pk2(s[4 * 33], s[5 * 33]); o.w = pk2(s[6 * 33], s[7 * 33]);
        *(GAS v4u*)(WT + (size_t)(r0 + n) * K + k0 + 8 * c) = o; }
    LDS_WAIT(); asm volatile("" ::: "memory");
}
__device__ __forceinline__ void convert_weights(Frame& F, int layer) {
    PH_TID();
    LAS float* scr = (LAS float*)(F.lds + wave_ * 16384);
    const int gw = F.vcu * NWAVES + wave_, NGW = F.G * NWAVES;
    bf16* WB = (bf16*)(F.ws + WS_WB);
    const float* wup = (const float*)F.in[17] + (size_t)layer * DM * FF; const float* wdn = (const float*)F.in[18] + (size_t)layer * FF * DM;
    const float* wgt = (const float*)F.in[20] + (size_t)layer * DM * DM; const float* wpj = (const float*)F.in[22] + (size_t)layer * PLED * DM;
    constexpr int I_UP = (DM / 64) * (FF / 32), I_DN = (FF / 64) * (DM / 32), I_G = (DM / 64) * (DM / 32), I_PJ = (PLED / 64) * (DM / 32), I_O = I_G;
    constexpr int I_IN = (DM / 64) * (2368 / 32), I_QU = (512 / 64) * (1536 / 32), I_KVU = (512 / 64) * (2048 / 32), I_QKV = (DM / 64) * (6144 / 32);
    const int nmix = layer == 0 ? (I_IN + I_QU + I_KVU) : I_QKV;
    const int NITEMS = I_UP + I_DN + I_G + I_PJ + I_O + nmix;
    for (int it = gw; it < NITEMS; it += NGW) {
        int r = it;
        if (r < I_UP) { transpose_item(wup, DM, FF, (bf16*)((char*)WB + WB_UP), false, scr, r, lane_); continue; } r -= I_UP;
        if (r < I_DN) { transpose_item(wdn, FF, DM, (bf16*)((char*)WB + WB_DOWN), false, scr, r, lane_); continue; } r -= I_DN;
        if (r < I_G) { transpose_item(wgt, DM, DM, (bf16*)((char*)WB + WB_GATE), false, scr, r, lane_); continue; } r -= I_G;
        if (r < I_PJ) { transpose_item(wpj, PLED, DM, (bf16*)((char*)WB + WB_PROJ), false, scr, r, lane_); continue; } r -= I_PJ;
        if (r < I_O) { transpose_item((const float*)F.in[layer == 0 ? 10 : 14], DM, DM, (bf16*)((char*)WB + WB_OUT), false, scr, r, lane_); continue; } r -= I_O;
        if (layer == 0) {
            if (r < I_IN) { transpose_item((const float*)F.in[4], DM, 2368, (bf16*)((char*)WB + WB_IN), true, scr, r, lane_); continue; } r -= I_IN;
            if (r < I_QU) { transpose_item((const float*)F.in[6], 512, 1536, (bf16*)((char*)WB + WB_QUP), false, scr, r, lane_); continue; } r -= I_QU;
            transpose_item((const float*)F.in[8], 512, 2048, (bf16*)((char*)WB + WB_KVUP), false, scr, r, lane_);
        } else {
            transpose_item((const float*)F.in[13], DM, 6144, (bf16*)((char*)WB + WB_QKV), false, scr, r, lane_);
        }
    }
    if (layer == 0) {
        GAS v4u* z = (GAS v4u*)((char*)WB + WB_IN + (size_t)2368 * DM * 2); const int nz = 192 * DM * 2 / 16;
        for (int i = (F.vcu * NWAVES + wave_) * 64 + lane_; i < nz; i += F.G * NWAVES * 64) z[i] = (v4u){0u, 0u, 0u, 0u};
    }
}
__device__ __forceinline__ void sincos_acc(float ang, float& sn, float& cs) {
    const double x = (double)ang, k = __builtin_rint(x * 0.6366197723675814);
    double r = __builtin_fma(-k, 1.5707963267948966, x); r = __builtin_fma(-k, 6.123233995736766e-17, r);
    const double r2 = r * r;
    double sp = -1.0 / 1307674368000.0; sp = sp * r2 + 1.0 / 6227020800.0; sp = sp * r2 - 1.0 / 39916800.0; sp = sp * r2 + 1.0 / 362880.0; sp = sp * r2 - 1.0 / 5040.0; sp = sp * r2 + 1.0 / 120.0; sp = sp * r2 - 1.0 / 6.0; sp = sp * r2 * r + r;
    double cp = 1.0 / 20922789888000.0; cp = cp * r2 - 1.0 / 87178291200.0; cp = cp * r2 + 1.0 / 479001600.0; cp = cp * r2 - 1.0 / 3628800.0; cp = cp * r2 + 1.0 / 40320.0; cp = cp * r2 - 1.0 / 720.0; cp = cp * r2 + 1.0 / 24.0; cp = cp * r2 - 0.5; cp = cp * r2 + 1.0;
    const int q = (int)(long long)k & 3;
    const double s_ = (q & 1) ? cp : sp, c_ = (q & 1) ? sp : cp;
    sn = (float)((q & 2) ? -s_ : s_); cs = (float)(((q + 1) & 2) ? -c_ : c_);
}
__device__ __forceinline__ void rms_row_to_bf16(int lane_, const float* xrow, const float* g, bf16* orow) {
    const GAS f32x4* xr = (const GAS f32x4*)xrow + lane_; const GAS f32x4* gr = (const GAS f32x4*)g + lane_;
    f32x4 v[8]; float s = 0.f;
#pragma unroll
    for (int j = 0; j < 8; ++j) { v[j] = xr[64 * j]; s += (v[j].x * v[j].x + v[j].y * v[j].y) + (v[j].z * v[j].z + v[j].w * v[j].w); }
    const float rstd = 1.f / sqrtf(wave_sum(s) * (1.f / DM) + NORM_EPS);
    GAS v2u* o8 = (GAS v2u*)orow + lane_;
#pragma unroll
    for (int j = 0; j < 8; ++j) { const f32x4 gg = gr[64 * j]; v2u w; w.x = pk2(v[j].x * rstd * gg.x, v[j].y * rstd * gg.y); w.y = pk2(v[j].z * rstd * gg.z, v[j].w * rstd * gg.w); o8[64 * j] = w; }
}
__device__ __forceinline__ void p_prologue(Frame& F) {
    PH_TID();
    convert_weights(F, 0);
    const int gt = (F.vcu * NWAVES + wave_) * 64 + lane_, NGT = F.G * NWAVES * 64;
    {
        const GAS f32x4* p4 = (const GAS f32x4*)F.in[1]; GAS v4u* o = (GAS v4u*)(F.ws + WS_PB); const int n = 2 * S * PLED / 8;
        for (int i = gt; i < n; i += NGT) { const f32x4 a = p4[2 * i], b = p4[2 * i + 1]; v4u w; w.x = pk2(a.x, a.y); w.y = pk2(a.z, a.w); w.z = pk2(b.x, b.y); w.w = pk2(b.z, b.w); o[i] = w; }
    }
    {
        const int* pos = (const int*)F.in[2]; GAS f32x2* c64 = (GAS f32x2*)(F.ws + WS_CS64); GAS f32x2* c128 = (GAS f32x2*)(F.ws + WS_CS128);
        for (int i = gt; i < S * 96; i += NGT) { const int s = i / 96, r = i % 96; const float pf = (float)pos[s]; float sn, cs;
            if (r < 32) { const float inv = exp2f(-(float)r * (2.0f / 64.f) * 13.287712379549449f); sincos_acc(pf * inv, sn, cs); c64[s * 32 + r] = (f32x2){cs, sn}; }
            else { const int q = r - 32; const float inv = exp2f(-(float)q * (2.0f / 128.f) * 13.287712379549449f); sincos_acc(pf * inv, sn, cs); c128[s * 64 + q] = (f32x2){cs, sn}; } }
    }
    {
        const int gw = F.vcu * NWAVES + wave_, NGW = F.G * NWAVES;
        for (int m = gw; m < S; m += NGW) rms_row_to_bf16(lane_, (const float*)F.in[0] + (size_t)m * DM, (const float*)F.in[3], (bf16*)(F.ws + WS_XN) + (size_t)m * DM);
    }
}
__device__ __forceinline__ void p_l0_rows(Frame& F) {
    PH_TID();
    const int gw = F.vcu * NWAVES + wave_, NGW = F.G * NWAVES;
    bf16* CQ = (bf16*)(F.ws + WS_CQKV); bf16* SW = (bf16*)(F.ws + WS_SWAB); const GAS f32x2* c64 = (const GAS f32x2*)(F.ws + WS_CS64);
    const float* gq = (const float*)F.in[5]; const float* gkv = (const float*)F.in[7];
    for (int s = gw; s < S; s += NGW) {
#pragma unroll
        for (int j = 0; j < 2; ++j) {
            GAS v4u* p = (GAS v4u*)(CQ + (size_t)s * 1024 + j * 512) + lane_; const v4u w = *p; const float* g = (j == 0 ? gq : gkv) + 8 * lane_;
            float x[8] = {bflo(w.x), bfhi(w.x), bflo(w.y), bfhi(w.y), bflo(w.z), bfhi(w.z), bflo(w.w), bfhi(w.w)}; float ss = 0.f;
#pragma unroll
            for (int e = 0; e < 8; ++e) ss += x[e] * x[e];
            const float rstd = 1.f / sqrtf(wave_sum(ss) * (1.f / 512.f) + NORM_EPS);
            v4u o; o.x = pk2(x[0] * rstd * g[0], x[1] * rstd * g[1]); o.y = pk2(x[2] * rstd * g[2], x[3] * rstd * g[3]); o.z = pk2(x[4] * rstd * g[4], x[5] * rstd * g[5]); o.w = pk2(x[6] * rstd * g[6], x[7] * rstd * g[7]);
            *p = o;
        }
        const f32x2 cs = c64[s * 32 + (lane_ & 31)]; GAS bf16* row = (GAS bf16*)(SW + (size_t)s * SWAW);
#pragma unroll
        for (int t = 0; t < 10; ++t) { const int b = 2 * t + (lane_ >> 5);
            if (b < 19) { const int col = (b < 18 ? b * 64 : 1280) + (lane_ & 31); const float x1 = __uint_as_float((unsigned)row[col] << 16), x2 = __uint_as_float((unsigned)row[col + 32] << 16);
                row[col] = (bf16)f2bf(x1 * cs.x - x2 * cs.y); row[col + 32] = (bf16)f2bf(x2 * cs.x + x1 * cs.y); } }
    }
}
template <int MODE>
__device__ __forceinline__ void p_rows(Frame& F, const float* hprev, const float* gpost, const float* gnext) {
    PH_TID();
    const int gw = F.vcu * NWAVES + wave_, NGW = F.G * NWAVES;
    const bf16* Mb = (const bf16*)(F.ws + WS_M); const float* SS = (const float*)(F.ws + WS_SS); bf16* XN = (bf16*)(F.ws + WS_XN);
    for (int s = gw; s < S; s += NGW) {
        const GAS f32x4* hr = (const GAS f32x4*)(hprev + (size_t)s * DM) + lane_; GAS f32x4* orow = (GAS f32x4*)(F.out + (size_t)s * DM) + lane_;
        f32x4 v[8];
#pragma unroll
        for (int j = 0; j < 8; ++j) v[j] = hr[64 * j];
        if (MODE != 2) {
            float t = SS[(size_t)s * 32 + (lane_ & 31)];
#pragma unroll
            for (int o = 1; o < 32; o <<= 1) t += __shfl_xor(t, o);
            const float rstd = 1.f / sqrtf(t * (1.f / DM) + NORM_EPS);
            const GAS v2u* mr = (const GAS v2u*)(Mb + (size_t)s * DM) + lane_; const GAS f32x4* gp = (const GAS f32x4*)gpost + lane_;
#pragma unroll
            for (int j = 0; j < 8; ++j) { const v2u w = mr[64 * j]; const f32x4 g = gp[64 * j];
                v[j].x += bflo(w.x) * rstd * g.x; v[j].y += bfhi(w.x) * rstd * g.y; v[j].z += bflo(w.y) * rstd * g.z; v[j].w += bfhi(w.y) * rstd * g.w; orow[64 * j] = v[j]; }
        }
        GAS v2u* o8 = (GAS v2u*)(XN + (size_t)s * DM) + lane_;
        if (MODE == 1) {
#pragma unroll
            for (int j = 0; j < 8; ++j) { v2u w; w.x = pk2(v[j].x, v[j].y); w.y = pk2(v[j].z, v[j].w); o8[64 * j] = w; }
        } else {
            float ss = 0.f;
#pragma unroll
            for (int j = 0; j < 8; ++j) ss += (v[j].x * v[j].x + v[j].y * v[j].y) + (v[j].z * v[j].z + v[j].w * v[j].w);
            const float r2 = 1.f / sqrtf(wave_sum(ss) * (1.f / DM) + NORM_EPS); const GAS f32x4* gn = (const GAS f32x4*)gnext + lane_;
#pragma unroll
            for (int j = 0; j < 8; ++j) { const f32x4 g = gn[64 * j]; v2u w; w.x = pk2(v[j].x * r2 * g.x, v[j].y * r2 * g.y); w.y = pk2(v[j].z * r2 * g.z, v[j].w * r2 * g.w); o8[64 * j] = w; }
        }
    }
}
__device__ __forceinline__ void p_l0_attn(Frame& F) {
    PH_TID();
    char* lds = (char*)F.ldsg; const int r32 = lane_ & 31, hi = lane_ >> 5;
    const bf16* Q = (const bf16*)(F.ws + WS_Q); const bf16* KV = (const bf16*)(F.ws + WS_KV); const bf16* SW = (const bf16*)(F.ws + WS_SWAB); bf16* ATT = (bf16*)(F.ws + WS_XN);
    const f32x2* c64 = (const f32x2*)(F.ws + WS_CS64);
    for (int it = F.vcu; it < 256; it += F.G) {
        const int hm = it >> 5, x = it & 31;
        for (int pass = 0; pass < 2; ++pass) {
            const int qb = pass ? 63 - x : x, P0 = qb * 256, s = P0 + wave_ * 32 + r32;
            att::bf16x8 qr[12]; const bf16* qrow = Q + (size_t)s * 1536 + hm * 192 + hi * 8;
#pragma unroll
            for (int d0 = 0; d0 < 12; ++d0) qr[d0] = *(const att::bf16x8*)(qrow + d0 * 16);
#pragma unroll
            for (int g = 0; g < 2; ++g) {
                const f32x2* cp = c64 + (size_t)s * 32 + 16 * g + 8 * hi; att::bf16x8 a = qr[8 + g], b = qr[10 + g];
#pragma unroll
                for (int e = 0; e < 8; ++e) { const f32x2 cs = cp[e]; const float x1 = att::bf2f((unsigned short)a[e]), x2 = att::bf2f((unsigned short)b[e]);
                    a[e] = (short)f2bf(x1 * cs.x - x2 * cs.y); b[e] = (short)f2bf(x2 * cs.x + x1 * cs.y); }
                qr[8 + g] = a; qr[10 + g] = b; }
            att::Job J; J.K = KV + hm * 256; J.ldk = 2048; J.K2 = SW + 1280; J.ldk2 = SWAW; J.V = KV + hm * 256 + 128; J.ldv = 2048;
            J.j_lo = 0; J.j_hi = 4 * qb + 4; J.wq_lo = P0 + wave_ * 32; J.qpos = s; J.W = 1u << 30; J.nomask = 0; J.m0 = -1e30f; J.l0 = 0.f;
            J.sc = 0.07216878364870322f; J.c2 = 0.07216878364870322f * 1.4426950408889634f;
            att::f32x16 o[4]; float m_reg, l_reg;
            att::attn_core<192, 128>(F.lds, J, qr, o, m_reg, l_reg);
            att::store_o<128, true>(F.lds, o, l_reg, ATT + (size_t)(P0 + wave_ * 32) * DM + hm * 128, DM);
            __syncthreads();
        }
    }
    const float* sinks = (const float*)F.in[9];
    for (int u = F.vcu; u < 1024; u += F.G) {
        const int h = u >> 6, qb = u & 63, P0 = qb * 256, s = P0 + wave_ * 32 + r32, kvh = h >> 3;
        att::bf16x8 qr[4]; const bf16* qrow = SW + (size_t)s * SWAW + h * 64 + hi * 8;
#pragma unroll
        for (int d0 = 0; d0 < 4; ++d0) qr[d0] = *(const att::bf16x8*)(qrow + d0 * 16);
        att::Job J; J.K = SW + 1024 + kvh * 64; J.ldk = SWAW; J.K2 = J.K; J.ldk2 = SWAW; J.V = SW + 1152 + kvh * 64; J.ldv = SWAW;
        J.j_lo = qb == 0 ? 0 : 4 * qb - 2; J.j_hi = 4 * qb + 4; J.wq_lo = P0 + wave_ * 32; J.qpos = s; J.W = 128u; J.nomask = 0; J.m0 = sinks[h] * 8.f; J.l0 = 1.f;
        J.sc = 0.125f; J.c2 = 0.125f * 1.4426950408889634f;
        att::f32x16 o[2]; float m_reg, l_reg;
        att::attn_core<64, 64>(F.lds, J, qr, o, m_reg, l_reg);
        att::store_o<64, true>(F.lds, o, l_reg, ATT + (size_t)(P0 + wave_ * 32) * DM + 1024 + h * 64, DM);
        __syncthreads();
    }
}
__device__ __forceinline__ void p_l1_rope(Frame& F) {
    PH_TID();
    bf16* QKV = (bf16*)(F.ws + WS_QKV); const GAS f32x2* c128 = (const GAS f32x2*)(F.ws + WS_CS128); float* KM = (float*)(F.ws + WS_KM);
    LAS float* red = (LAS float*)F.lds;
    for (int u = F.vcu; u < 256; u += F.G) {
        const int j = u >> 2, hg = u & 3; float ks1[4] = {0.f, 0.f, 0.f, 0.f}, ks2[4] = {0.f, 0.f, 0.f, 0.f};
        for (int rr = 0; rr < 32; ++rr) { const int s = 256 * j + 32 * wave_ + rr; const f32x2 cs = c128[s * 64 + lane_]; GAS bf16* row = (GAS bf16*)(QKV + (size_t)s * 6144);
#pragma unroll
            for (int hh = 0; hh < 4; ++hh) { const int cq = (hg * 4 + hh) * 128 + lane_, ck = 2048 + cq;
                { const float x1 = __uint_as_float((unsigned)row[cq] << 16), x2 = __uint_as_float((unsigned)row[cq + 64] << 16); row[cq] = (bf16)f2bf(x1 * cs.x - x2 * cs.y); row[cq + 64] = (bf16)f2bf(x2 * cs.x + x1 * cs.y); }
                { const float x1 = __uint_as_float((unsigned)row[ck] << 16), x2 = __uint_as_float((unsigned)row[ck + 64] << 16); const float y1 = x1 * cs.x - x2 * cs.y, y2 = x2 * cs.x + x1 * cs.y;
                  row[ck] = (bf16)f2bf(y1); row[ck + 64] = (bf16)f2bf(y2); ks1[hh] += y1; ks2[hh] += y2; } } }
#pragma unroll
        for (int hh = 0; hh < 4; ++hh) { red[(wave_ * 4 + hh) * 128 + lane_] = ks1[hh]; red[(wave_ * 4 + hh) * 128 + 64 + lane_] = ks2[hh]; }
        __syncthreads();
        { const int hh = tid_ >> 7, c = tid_ & 127; float t = 0.f;
#pragma unroll
          for (int w = 0; w < 8; ++w) t += red[(w * 4 + hh) * 128 + c];
          KM[((size_t)(hg * 4 + hh) * 64 + j) * 128 + c] = t * (1.f / 256.f); }
        __syncthreads();
    }
}
__device__ __forceinline__ void p_l1_gate(Frame& F) {
    PH_TID();
    const bf16* QKV = (const bf16*)(F.ws + WS_QKV); const float* KM = (const float*)(F.ws + WS_KM); unsigned short* LIST = (unsigned short*)(F.ws + WS_LIST);
    unsigned* CNT = (unsigned*)(F.ctl + CW_CNT); LAS f32x4* km4 = (LAS f32x4*)F.lds;
    for (int u = F.vcu; u < 512; u += F.G) {
        const int h = u >> 5, c = u & 31, nrows = 2 * c + 1;
        const GAS f32x4* src = (const GAS f32x4*)(KM + (size_t)h * 64 * 128);
        for (int i = tid_; i < nrows * 32; i += NWAVES * 64) km4[i] = src[i];
        __syncthreads();
        const int s = c * 512 + tid_, qb = __builtin_amdgcn_readfirstlane(s >> 8);
        float q[128]; const GAS v4u* qp = (const GAS v4u*)(QKV + (size_t)s * 6144 + h * 128);
#pragma unroll
        for (int i = 0; i < 16; ++i) { const v4u w = qp[i]; q[8 * i] = bflo(w.x); q[8 * i + 1] = bfhi(w.x); q[8 * i + 2] = bflo(w.y); q[8 * i + 3] = bfhi(w.y); q[8 * i + 4] = bflo(w.z); q[8 * i + 5] = bfhi(w.z); q[8 * i + 6] = bflo(w.w); q[8 * i + 7] = bfhi(w.w); }
        float t0 = -__builtin_inff(), t1 = t0, t2 = t0; int i0 = 0, i1 = 0, i2 = 0;
        for (int n = 0; n < qb; ++n) { float a0 = 0.f, a1 = 0.f, a2 = 0.f, a3 = 0.f;
#pragma unroll
            for (int i = 0; i < 32; ++i) { const f32x4 k = km4[n * 32 + i]; a0 = fmaf(q[4 * i], k.x, a0); a1 = fmaf(q[4 * i + 1], k.y, a1); a2 = fmaf(q[4 * i + 2], k.z, a2); a3 = fmaf(q[4 * i + 3], k.w, a3); }
            const float a = (a0 + a1) + (a2 + a3);
            if (a > t0) { t2 = t1; i2 = i1; t1 = t0; i1 = i0; t0 = a; i0 = n; } else if (a > t1) { t2 = t1; i2 = i1; t1 = a; i1 = n; } else if (a > t2) { t2 = a; i2 = n; } }
        const int nvalid = qb < 3 ? qb : 3;
#pragma unroll
        for (int r = 0; r < 3; ++r) if (r < nvalid) { const int jsel = r == 0 ? i0 : (r == 1 ? i1 : i2);
            const unsigned pos = atomicAdd(CNT + h * 64 + jsel, 1u); LIST[(size_t)h * LIST_PER_HEAD + list_off(jsel) + pos] = (unsigned short)(s | (r << 14)); }
        __syncthreads();
    }
}
__device__ __forceinline__ void p_l1_items(Frame& F, int g) {
    PH_TID();
    char* lds = (char*)F.ldsg; const int r32 = lane_ & 31, hi = lane_ >> 5;
    const bf16* QKV = (const bf16*)(F.ws + WS_QKV); const unsigned short* LIST = (const unsigned short*)(F.ws + WS_LIST); const unsigned* CNT = (const unsigned*)(F.ctl + CW_CNT);
    bf16* PART = (bf16*)(F.ws + WS_PART); float* PLSE = (float*)(F.ws + WS_PLSE);
    LAS int* pfx = (LAS int*)(F.lds + att::LDS_PFX); LAS int* cn = pfx + 520;
    {
        const int cnt = (int)__hip_atomic_load(CNT + (8 * g) * 64 + tid_, __ATOMIC_RELAXED, __HIP_MEMORY_SCOPE_AGENT); int v = 1 + (cnt + 255) / 256; cn[tid_] = cnt;
#pragma unroll
        for (int o = 1; o < 64; o <<= 1) { const int t = __shfl_up(v, o); if (lane_ >= o) v += t; }
        LAS int* wt = pfx + 1040; if (lane_ == 63) wt[wave_] = v;
        __syncthreads();
        int base = 0; for (int w = 0; w < wave_; ++w) base += wt[w];
        pfx[tid_ + 1] = base + v; if (tid_ == 0) pfx[0] = 0;
        __syncthreads();
    }
    const int total = pfx[512]; int* rtab = (int*)(lds + att::LDS_OTAB) + wave_ * 32;
    for (int it = F.vcu; it < total; it += F.G) {
        int lo = 0, hi_ = 512;
        while (hi_ - lo > 1) { const int mid = (lo + hi_) >> 1; if (pfx[mid] <= it) lo = mid; else hi_ = mid; }
        const int e = lo, hl = e >> 6, j = e & 63, t = it - pfx[e], h = 8 * g + hl, cnt = cn[e];
        int s, slot; bool valid = true;
        if (t == 0) { s = 256 * j + 32 * wave_ + r32; slot = 3; }
        else { const int base = (t - 1) * 256, n = (cnt - base) < 256 ? (cnt - base) : 256, rw = 32 * wave_ + r32; valid = rw < n;
            const unsigned ent = LIST[(size_t)h * LIST_PER_HEAD + list_off(j) + base + (valid ? rw : n - 1)]; s = ent & 16383; slot = ent >> 14; }
        const int didx = (s * 8 + hl) * 4 + slot;
        if (hi == 0) rtab[r32] = valid ? didx : -1;
        att::bf16x8 qr[8]; const bf16* qrow = QKV + (size_t)s * 6144 + h * 128 + hi * 8;
#pragma unroll
        for (int d0 = 0; d0 < 8; ++d0) qr[d0] = *(const att::bf16x8*)(qrow + d0 * 16);
        att::Job J; J.K = QKV + 2048 + h * 128; J.ldk = 6144; J.K2 = J.K; J.ldk2 = 6144; J.V = QKV + 4096 + h * 128; J.ldv = 6144;
        J.j_lo = 4 * j; J.j_hi = 4 * j + 4; J.wq_lo = 256 * j + 32 * wave_; J.qpos = s; J.W = 1u << 30; J.nomask = (t != 0) ? 1 : 0; J.m0 = -1e30f; J.l0 = 0.f;
        J.sc = 0.08838834764831845f; J.c2 = 0.08838834764831845f * 1.4426950408889634f;
        att::f32x16 o[4]; float m_reg, l_reg;
        att::attn_core<128, 128>(F.lds, J, qr, o, m_reg, l_reg);
        att::store_o<128, false>(F.lds, o, l_reg, PART, 128);
        if (hi == 0 && valid) PLSE[didx] = m_reg * J.c2 + __builtin_amdgcn_logf(l_reg);
        __syncthreads();
    }
}
__device__ __forceinline__ void p_l1_combine(Frame& F, int g) {
    PH_TID();
    const int gw = F.vcu * NWAVES + wave_, NGW = F.G * NWAVES;
    const bf16* PART = (const bf16*)(F.ws + WS_PART); const float* PLSE = (const float*)(F.ws + WS_PLSE); bf16* ATT = (bf16*)(F.ws + WS_XN);
    const int slot = lane_ >> 4, dch = lane_ & 15;
    for (int s = gw; s < S; s += NGW) {
        const int qb = s >> 8, nvalid = qb < 3 ? qb : 3; const bool valid = (slot == 3) || (slot < nvalid);
#pragma unroll
        for (int i = 0; i < 8; ++i) { const int idx = (s * 8 + i) * 4 + slot;
            const float lse = valid ? PLSE[idx] : -__builtin_inff(); float mx = fmaxf(lse, __shfl_xor(lse, 16)); mx = fmaxf(mx, __shfl_xor(mx, 32));
            const float w = valid ? __builtin_amdgcn_exp2f(lse - mx) : 0.f; float wsum = w + __shfl_xor(w, 16); wsum += __shfl_xor(wsum, 32);
            v4u pw = (v4u){0u, 0u, 0u, 0u}; if (valid) pw = *(const GAS v4u*)(PART + (size_t)idx * 128 + dch * 8);
            float a[8] = {bflo(pw.x) * w, bfhi(pw.x) * w, bflo(pw.y) * w, bfhi(pw.y) * w, bflo(pw.z) * w, bfhi(pw.z) * w, bflo(pw.w) * w, bfhi(pw.w) * w};
#pragma unroll
            for (int e = 0; e < 8; ++e) { a[e] += __shfl_xor(a[e], 16); a[e] += __shfl_xor(a[e], 32); }
            if (slot == 0) { const float rw = 1.f / wsum; v4u o; o.x = pk2(a[0] * rw, a[1] * rw); o.y = pk2(a[2] * rw, a[3] * rw); o.z = pk2(a[4] * rw, a[5] * rw); o.w = pk2(a[6] * rw, a[7] * rw);
                *(GAS v4u*)(ATT + (size_t)s * DM + (8 * g + i) * 128 + dch * 8) = o; } }
    }
}

struct Args { const void* in[23]; float* out; unsigned char* ws; int ph_lo, ph_hi, li, pad; };
constexpr int NPH = 29;
__global__ void __launch_bounds__(NWAVES * 64, 2) fwd(Args args) {
    extern __shared__ __attribute__((aligned(16))) unsigned char lds[];
    Frame F;
    F.lds = (LAS unsigned char*)lds; F.ldsg = lds; F.MISC = (volatile LAS unsigned*)(F.lds + MISC_OFF);
    F.G = gridDim.x; { const int bx = blockIdx.x; F.vcu = (F.G % 8 == 0) ? (bx % 8) * (F.G / 8) + bx / 8 : bx; }
    F.in = args.in; F.out = args.out; F.ws = args.ws; F.ctl = (gu32*)(args.ws + WS_CTL);
    for (int u = threadIdx.x; u < (LDS_BYTES - LDSCTL_OFF) / 4; u += NWAVES * 64) ((LAS unsigned*)(F.lds + LDSCTL_OFF))[u] = 0u;
    __syncthreads();
    XcdBarrier bar = xcd_barrier_post((unsigned*)(F.ctl + CW_BAR) + args.li * XCD_BAR_WORDS, F.MISC + 8);
    const int lo = args.ph_lo, hi = args.ph_hi;
#ifndef KMASK
#define KMASK 0xfffff
#endif
#define KIND(k) (((KMASK) >> (k)) & 1)
#define IN(k) (lo <= (k) && (k) < hi)
#define SEAM(k) do { if (IN(k) && IN((k) + 1)) xcd_barrier(bar); } while (0)
    unsigned char* ws = args.ws;
    bf16* WB = (bf16*)(ws + WS_WB); bf16* XN = (bf16*)(ws + WS_XN); bf16* Mb = (bf16*)(ws + WS_M); float* SS = (float*)(ws + WS_SS);
#define WBP(off) ((const pg8::bf16_t*)((const char*)WB + (off)))
#define RUN_GEMM(EPI_T, Ap, lda_, Bp, M_, N_, K_, Eobj) do { pg8::Gemm g_{(const pg8::bf16_t*)(Ap), (Bp), (M_), (N_), (K_), (lda_)}; pg8::StaticOrder S_; S_.init((M_), (N_), F.G, (int)blockIdx.x); \
        pg8::gemm_phase<EPI_T, pg8::StaticOrder, true, true>(F.lds, g_, S_, Eobj); } while (0)

    if (KIND(0) && IN(0)) { p_prologue(F); } SEAM(0);
#pragma unroll 1
    for (int l = 0; l < 2; ++l) {
        if (l == 0) {
            if (KIND(1) && IN(1)) {
                pg8::EpiStore<0, false> E{(pg8::bf16_t*)(ws + WS_CQKV), 1024, 4, (pg8::bf16_t*)(ws + WS_SWAB), SWAW, SWAW, nullptr};
                RUN_GEMM(decltype(E), XN, DM, WBP(WB_IN), S, NIN_PAD, DM, E); } SEAM(1);
            if (KIND(2) && IN(2)) { p_l0_rows(F); } SEAM(2);
            if (KIND(3) && IN(3)) {
                { pg8::EpiStore<0, false> E{(pg8::bf16_t*)(ws + WS_Q), 1536, 1 << 20, nullptr, 0, 0, nullptr}; RUN_GEMM(decltype(E), ws + WS_CQKV, 1024, WBP(WB_QUP), S, 1536, 512, E); }
                { pg8::EpiStore<0, false> E{(pg8::bf16_t*)(ws + WS_KV), 2048, 1 << 20, nullptr, 0, 0, nullptr}; RUN_GEMM(decltype(E), ws + WS_CQKV + 1024, 1024, WBP(WB_KVUP), S, 2048, 512, E); } } SEAM(3);
            if (KIND(4) && IN(4)) { p_l0_attn(F); } SEAM(4);
        } else {
            if (KIND(12) && IN(14)) { pg8::EpiStore<0, false> E{(pg8::bf16_t*)(ws + WS_QKV), 6144, 1 << 20, nullptr, 0, 0, nullptr}; RUN_GEMM(decltype(E), XN, DM, WBP(WB_QKV), S, 6144, DM, E); } SEAM(14);
            if (KIND(13) && IN(15)) { p_l1_rope(F); } SEAM(15);
            if (KIND(14) && IN(16)) { p_l1_gate(F); } SEAM(16);
            if (KIND(15) && IN(17)) { p_l1_items(F, 0); } SEAM(17);
            if (KIND(16) && IN(18)) { p_l1_combine(F, 0); } SEAM(18);
            if (KIND(15) && IN(19)) { p_l1_items(F, 1); } SEAM(19);
            if (KIND(16) && IN(20)) { p_l1_combine(F, 1); } SEAM(20);
        }
        const int tb = l ? 21 : 5;
        if (KIND(5) && IN(tb + 0)) {
            pg8::EpiStore<0, true> E{(pg8::bf16_t*)Mb, DM, 1 << 20, nullptr, 0, 0, SS}; RUN_GEMM(decltype(E), XN, DM, WBP(WB_OUT), S, DM, DM, E); } SEAM(tb + 0);
        if (KIND(6) && IN(tb + 1)) { p_rows<0>(F, l == 0 ? (const float*)args.in[0] : (const float*)args.out, (const float*)args.in[l == 0 ? 11 : 15], (const float*)args.in[16] + l * DM); } SEAM(tb + 1);
#pragma unroll 1
        for (int hf = 0; hf < 2; ++hf) {
            if (KIND(7) && IN(tb + 2 + 2 * hf)) {
                pg8::EpiStore<1, false> E{(pg8::bf16_t*)(ws + WS_HID), FF, 1 << 20, nullptr, 0, 0, nullptr}; RUN_GEMM(decltype(E), XN + (size_t)hf * 8192 * DM, DM, WBP(WB_UP), 8192, FF, DM, E); } SEAM(tb + 2 + 2 * hf);
            if (KIND(8) && IN(tb + 3 + 2 * hf)) {
                pg8::EpiStore<0, true> E{(pg8::bf16_t*)Mb + (size_t)hf * 8192 * DM, DM, 1 << 20, nullptr, 0, 0, SS + (size_t)hf * 8192 * 32}; RUN_GEMM(decltype(E), ws + WS_HID, FF, WBP(WB_DOWN), 8192, DM, FF, E); } SEAM(tb + 3 + 2 * hf);
        }
        if (KIND(9) && IN(tb + 6)) {
            p_rows<1>(F, (const float*)args.out, (const float*)args.in[19] + l * DM, nullptr);
            pg8::EpiStore<0, false> E{(pg8::bf16_t*)(ws + WS_PP), DM, 1 << 20, nullptr, 0, 0, nullptr}; RUN_GEMM(decltype(E), ws + WS_PB + (size_t)l * S * PLED * 2, PLED, WBP(WB_PROJ), S, DM, PLED, E); } SEAM(tb + 6);
        if (KIND(10) && IN(tb + 7)) {
            pg8::EpiPle E{args.out, (const pg8::bf16_t*)(ws + WS_PP), (const float*)args.in[21] + l * DM, DM}; RUN_GEMM(pg8::EpiPle, XN, DM, WBP(WB_GATE), S, DM, DM, E); }
        if (l == 0) { SEAM(tb + 7);
            if (KIND(11) && IN(tb + 8)) { p_rows<2>(F, (const float*)args.out, nullptr, (const float*)args.in[12]); convert_weights(F, 1); } SEAM(tb + 8); }
    }
#undef IN
#undef SEAM
}

extern "C" void kernel_launch(void* const* d_in, const int* in_sizes, int n_in, void* d_out, int out_size, void* d_ws, size_t ws_size, hipStream_t stream) {
    static int grid = 0;
    if (grid == 0) {
        if (n_in != 23 || in_sizes[0] != S * DM || out_size != S * DM || ws_size < WS_END) { fprintf(stderr, "kernel_launch: unexpected shapes / workspace (%d inputs, ws %zu)\n", n_in, ws_size); grid = -1; return; }
        int dev = 0, cus = 0, per_cu = 0;
        if (hipGetDevice(&dev) != hipSuccess || hipDeviceGetAttribute(&cus, hipDeviceAttributeMultiprocessorCount, dev) != hipSuccess) { grid = -1; return; }
        if (hipFuncSetAttribute((const void*)fwd, hipFuncAttributeMaxDynamicSharedMemorySize, LDS_BYTES) != hipSuccess) { grid = -1; return; }
        if (hipOccupancyMaxActiveBlocksPerMultiprocessor(&per_cu, (const void*)fwd, NWAVES * 64, LDS_BYTES) != hipSuccess || per_cu < 1) { fprintf(stderr, "kernel_launch: occupancy query says %d\n", per_cu); }
        (void)hipGetLastError();
        grid = cus;
    }
    if (grid < 0) return;
    if (hipMemsetAsync((char*)d_ws + WS_CTL, 0, CTL_ZERO_BYTES, stream) != hipSuccess) return;
    Args a{};
    for (int i = 0; i < 23; ++i) a.in[i] = d_in[i];
    a.out = (float*)d_out; a.ws = (unsigned char*)d_ws; a.pad = 0;
#if MK_N_LAUNCHES == 1
    a.ph_lo = 0; a.ph_hi = NPH; a.li = 0;
    hipLaunchKernelGGL(fwd, dim3(grid), dim3(NWAVES * 64), LDS_BYTES, stream, a);
#else
    for (int ph = 0; ph < NPH; ++ph) { a.ph_lo = ph; a.ph_hi = ph + 1; a.li = ph; hipLaunchKernelGGL(fwd, dim3(grid), dim3(NWAVES * 64), LDS_BYTES, stream, a); }
#endif
}
```

```cpp
#include <hip/hip_runtime.h>
#include <cstdio>
#include <cstdint>
#ifndef PROJ_I8
#define PROJ_I8 1
#endif
#ifndef OUT1_I8
#define OUT1_I8 1
#endif
#ifndef CONV_UNROLL
#define CONV_UNROLL 8
#endif
#ifndef ROWS_X16
#define ROWS_X16 1
#endif
#ifndef GATE_MFMA
#define GATE_MFMA 1
#endif
#ifndef QKV_I8
#define QKV_I8 1
#endif

__device__ __forceinline__ int lane_id() { int l; asm volatile("v_mbcnt_lo_u32_b32 %0, -1, 0\n\tv_mbcnt_hi_u32_b32 %0, -1, %0" : "=v"(l)); return l; }
template <int K> __device__ __forceinline__ float shx(float v) {
    static_assert(K == 1 || K == 2 || K == 4 || K == 8 || K == 16, "shx: xor mask inside a 32-lane half");
    if constexpr (K == 1) return __uint_as_float((unsigned)__builtin_amdgcn_mov_dpp((int)__float_as_uint(v), 0xB1, 0xf, 0xf, true));
    else if constexpr (K == 2) return __uint_as_float((unsigned)__builtin_amdgcn_mov_dpp((int)__float_as_uint(v), 0x4E, 0xf, 0xf, true));
    else return __uint_as_float((unsigned)__builtin_amdgcn_ds_swizzle((int)__float_as_uint(v), 0x1F | (K << 10)));
}
__device__ __forceinline__ float sum32(float v) { auto r = __builtin_amdgcn_permlane32_swap(__float_as_uint(v), __float_as_uint(v), false, false); return __uint_as_float(r[0]) + __uint_as_float(r[1]); }
__device__ __forceinline__ float max32(float v) { auto r = __builtin_amdgcn_permlane32_swap(__float_as_uint(v), __float_as_uint(v), false, false); return fmaxf(__uint_as_float(r[0]), __uint_as_float(r[1])); }
namespace pg8 {
#define PG8_LAS __attribute__((address_space(3)))
typedef unsigned short bf16_t;
typedef short bf16x8 __attribute__((ext_vector_type(8)));
typedef float f32x4 __attribute__((ext_vector_type(4)));
typedef unsigned u32x4 __attribute__((ext_vector_type(4)));
typedef int i32x4 __attribute__((ext_vector_type(4)));
typedef unsigned u32x2 __attribute__((ext_vector_type(2)));
constexpr int BM = 256, BK = 64, HALF = 128, HTB = HALF * BK * 2  , STAGE_BYTES = 8 * HTB, NXCD = 8, WGM = 8;

__host__ __device__ __forceinline__ int lds_byte(int r, int c) { const int st = (r >> 4) * 2 + (c >> 5), rr = r & 15, cc = c & 31, ob = rr * 64 + cc * 2; return st * 1024 + (ob ^ (((ob >> 9) & 1) << 5)); }
__host__ __device__ __forceinline__ void stage_rc(int b, int& R, int& C) { const int st = b / 1024, sb = b % 1024, swz = sb ^ (((sb >> 9) & 1) << 5); R = (st >> 1) * 16 + swz / 64; C = (st & 1) * 32 + (swz % 64) / 2; }
__host__ __device__ __forceinline__ int perm32(int rho) { const int n = rho >> 4, i = rho & 15; return 8 * (i >> 2) + 4 * n + (i & 3); }

struct Unit { int pm, pn; };
struct Gemm { const bf16_t* A; const bf16_t* Bt; int M, N, K, lda, wave; };

struct StaticOrder {
    int nM, nN, nwg, G, c;
    __host__ __device__ void init(int M, int N, int G_, int c_) { nM = M / BM; nN = N / BM; nwg = nM * nN; G = G_; c = c_; }
    __host__ __device__ bool next(int i, Unit& u) const {
        const long L = (long)i * G + c; if (L >= nwg) return false;
        int wgid = (int)L; { const int q = nwg / NXCD, r = nwg % NXCD, xcd = wgid % NXCD, off = wgid / NXCD; wgid = (xcd < r ? xcd * (q + 1) : r * (q + 1) + (xcd - r) * q) + off; }
        const int nig = WGM * nN, gid = wgid / nig, fm = gid * WGM, gsz = (nM - fm) < WGM ? (nM - fm) : WGM;
        u.pm = fm + ((wgid % nig) % gsz); u.pn = (wgid % nig) / gsz; return true;
    }
    __device__ __forceinline__ void a_ready(const Unit&) const {}
    __device__ __forceinline__ void done(const Unit&) const {}
};

__device__ __forceinline__ unsigned cvt_pk_bf16(float lo, float hi) { unsigned r; asm volatile("v_cvt_pk_bf16_f32 %0, %1, %2" : "=v"(r) : "v"(lo), "v"(hi)); return r; }
typedef float f32x2 __attribute__((ext_vector_type(2)));

template <int ACT, bool SUMSQ> struct EpiStore {
    static constexpr bool PERM = true, AFTER_DRAIN = false;
    bf16_t* O0; int ld0; int nt0; bf16_t* O1; int ld1; int nc1; float* SS;
    __device__ __forceinline__ void operator()(const f32x4 (&acc)[2][2][4][2], const Unit& u, int wr, int wc, int fr, int fq) const {
        const int row0 = u.pm * BM + wr * 64 + fr;
        bf16_t* base; int ld, colt, lim;
        if (u.pn < nt0) { base = O0; ld = ld0; colt = u.pn * BM; lim = 0x7fffffff; } else { base = O1; ld = ld1; colt = (u.pn - nt0) * BM; lim = nc1; }
        const int col0 = colt + wc * 32 + 8 * fq;
#pragma unroll
        for (int ai = 0; ai < 2; ++ai)
#pragma unroll
            for (int m = 0; m < 4; ++m) { const int row = row0 + ai * HALF + m * 16; bf16_t* rowp = base + (size_t)row * ld + col0; float ss = 0.f;
#pragma unroll
                for (int bj = 0; bj < 2; ++bj) { f32x4 v0 = acc[ai][bj][m][0], v1 = acc[ai][bj][m][1];
                    if (ACT == 1) {
#pragma unroll
                        for (int e = 0; e < 4; ++e) { const float a = fmaxf(v0[e], 0.f), b = fmaxf(v1[e], 0.f); v0[e] = a * a; v1[e] = b * b; } }
                    if (SUMSQ) ss += (v0[0] * v0[0] + v0[1] * v0[1]) + (v0[2] * v0[2] + v0[3] * v0[3]) + (v1[0] * v1[0] + v1[1] * v1[1]) + (v1[2] * v1[2] + v1[3] * v1[3]);
                    u32x4 w; w.x = cvt_pk_bf16(v0[0], v0[1]); w.y = cvt_pk_bf16(v0[2], v0[3]); w.z = cvt_pk_bf16(v1[0], v1[1]); w.w = cvt_pk_bf16(v1[2], v1[3]);
                    if (col0 + bj * HALF < lim) *(u32x4*)(rowp + bj * HALF) = w; }
                if (SUMSQ) { ss += shx<16>(ss); ss = sum32(ss); if (fq == 0) SS[(size_t)row * 32 + u.pn * 4 + wc] = ss; } }
    }
};
__device__ __forceinline__ unsigned pk4_fp8(float a, float b, float c, float d) { int w = __builtin_amdgcn_cvt_pk_fp8_f32(a, b, 0, false); w = __builtin_amdgcn_cvt_pk_fp8_f32(c, d, w, true); return (unsigned)w; }
template <class C> struct EpiX {
    static constexpr bool PERM = true, AFTER_DRAIN = false;
    static constexpr bool ROWSCALE = C::ROWSCALE, GAINSS = C::GAINSS, COLSUM = C::COLSUM; static constexpr int NSS = C::NSS, ROPE = C::ROPE;
    unsigned char* ws; const float* gcol; const float* gcol2;
    __device__ __forceinline__ void operator()(const f32x4 (&acc)[2][2][4][2], const Unit& u, int wr, int wc, int fr, int fq) const {
        bf16_t* const O0 = (bf16_t*)(ws + C::O0_OFF); bf16_t* const O1 = (bf16_t*)(ws + C::O1_OFF); constexpr int ld0 = C::LD0, nt0 = C::NT0, ld1 = C::LD1, nc1 = C::NC1;
        const float* const SSin = (const float*)(ws + C::SSIN_OFF); constexpr int ssin_stride = C::SSIN_STRIDE, ssin_off = C::SSIN_IDX; constexpr float inv_n = C::INV_N;
        float* const SSout = (float*)(ws + C::SSOUT_OFF); constexpr int ssout_stride = C::SSOUT_STRIDE, gsplit = C::GSPLIT;
        const float* const cs = (const float*)(ws + C::CS_OFF); constexpr int rope_kind = C::ROPE_KIND;
        float* const KMP = (float*)(ws + C::KMP_OFF); constexpr int cs_lo = C::CS_LO, cs_hi = C::CS_HI, cs_ld = C::CS_LD;
        const int row0 = u.pm * BM + wr * 64 + fr;
        bf16_t* base; int ld, colt, lim; const bool first = u.pn < nt0;
        if (first) { base = O0; ld = ld0; colt = u.pn * BM; lim = 0x7fffffff; } else { base = O1; ld = ld1; colt = (u.pn - nt0) * BM; lim = nc1; }
        const int col0 = colt + wc * 32 + 8 * fq;
        const int gc0 = u.pn * BM + wc * 32 + 8 * fq;
        const bool docs = COLSUM && u.pn >= cs_lo && u.pn < cs_hi;
        float csum[2][8];
#pragma unroll
        for (int bj = 0; bj < 2; ++bj)
#pragma unroll
            for (int e = 0; e < 8; ++e) csum[bj][e] = 0.f;
        f32x4 wsv[2][2];
        if constexpr (C::I8IN) {
#pragma unroll
            for (int bj = 0; bj < 2; ++bj) { const float* wp = (const float*)(ws + C::WSC_OFF) + gc0 + bj * HALF; wsv[bj][0] = *(const f32x4*)wp; wsv[bj][1] = *(const f32x4*)(wp + 4); } }
        f32x4 gv[2][2];
        if (GAINSS) {
#pragma unroll
            for (int bj = 0; bj < 2; ++bj) { const int gc = gc0 + bj * HALF; const float* gp = gc < gsplit ? gcol + gc : gcol2 + (gc - gsplit);
                gv[bj][0] = first ? *(const f32x4*)gp : (f32x4){1.f, 1.f, 1.f, 1.f}; gv[bj][1] = first ? *(const f32x4*)(gp + 4) : (f32x4){1.f, 1.f, 1.f, 1.f}; } }
#pragma unroll
        for (int ai = 0; ai < 2; ++ai)
#pragma unroll
            for (int m = 0; m < 4; ++m) { const int row = row0 + ai * HALF + m * 16; bf16_t* rowp = base + (size_t)row * ld + col0;
                float rs = 1.f;
                if (ROWSCALE) { const f32x4* sp = (const f32x4*)(SSin + (size_t)row * ssin_stride + ssin_off); f32x4 t = sp[0];
#pragma unroll
                    for (int i = 1; i < NSS / 4; ++i) t += sp[i];
                    rs = 1.f / sqrtf(((t[0] + t[1]) + (t[2] + t[3])) * inv_n + 1e-6f); }
                if constexpr (C::I8IN) rs = ((const float*)(ws + C::ASC_OFF))[row];
                float ss = 0.f;
#pragma unroll
                for (int bj = 0; bj < 2; ++bj) { f32x4 v0 = acc[ai][bj][m][0], v1 = acc[ai][bj][m][1];
                    if constexpr (C::I8IN) { const i32x4 i0 = __builtin_bit_cast(i32x4, v0), i1 = __builtin_bit_cast(i32x4, v1);
#pragma unroll
                        for (int e = 0; e < 4; ++e) { v0[e] = (float)i0[e] * rs * wsv[bj][0][e]; v1[e] = (float)i1[e] * rs * wsv[bj][1][e]; } }
                    if (ROWSCALE) { v0 = v0 * rs; v1 = v1 * rs; }
                    if (GAINSS) { ss += (v0[0] * v0[0] + v0[1] * v0[1]) + (v0[2] * v0[2] + v0[3] * v0[3]) + (v1[0] * v1[0] + v1[1] * v1[1]) + (v1[2] * v1[2] + v1[3] * v1[3]); v0 = v0 * gv[bj][0]; v1 = v1 * gv[bj][1]; }
                    if (ROPE != 0) { const int dc = col0 + bj * HALF, gc = gc0 + bj * HALF;
                        const bool rot = rope_kind == 1 ? (!first && (dc < 1152 || dc >= 1280)) : (rope_kind == 2 ? ((gc % 192) >= 128) : (u.pn < 16));
                        if (rot) { const int i0 = (rope_kind == 2 ? ((gc % 192) - 128) : (gc % ROPE)) >> 1; const f32x4* cp = (const f32x4*)(cs + ((size_t)row * (ROPE / 2) + i0) * 2); const f32x4 c01 = cp[0], c23 = cp[1];
                            const float a0 = v0[0] * c01[0] - v0[1] * c01[1], b0 = v0[1] * c01[0] + v0[0] * c01[1], a1 = v0[2] * c01[2] - v0[3] * c01[3], b1 = v0[3] * c01[2] + v0[2] * c01[3];
                            const float a2 = v1[0] * c23[0] - v1[1] * c23[1], b2 = v1[1] * c23[0] + v1[0] * c23[1], a3 = v1[2] * c23[2] - v1[3] * c23[3], b3 = v1[3] * c23[2] + v1[2] * c23[3];
                            v0 = (f32x4){a0, b0, a1, b1}; v1 = (f32x4){a2, b2, a3, b3}; } }
                    if (COLSUM) {
#pragma unroll
                        for (int e = 0; e < 4; ++e) { csum[bj][e] += v0[e]; csum[bj][4 + e] += v1[e]; } }
                    if constexpr (C::F8MODE == 1) {
                        u32x2 w8; w8.x = pk4_fp8(v0[0], v0[1], v0[2], v0[3]); w8.y = pk4_fp8(v1[0], v1[1], v1[2], v1[3]);
                        *(u32x2*)((unsigned char*)O0 + (size_t)row * ld0 + col0 + bj * HALF) = w8;
                    } else {
                        u32x4 w; w.x = cvt_pk_bf16(v0[0], v0[1]); w.y = cvt_pk_bf16(v0[2], v0[3]); w.z = cvt_pk_bf16(v1[0], v1[1]); w.w = cvt_pk_bf16(v1[2], v1[3]);
                        if ((C::BF16_NT >= (1 << 20) || u.pn < C::BF16_NT) && col0 + bj * HALF < lim) *(u32x4*)(rowp + bj * HALF) = w;
                        if constexpr (C::F8MODE == 2) { u32x2 w8; w8.x = pk4_fp8(v0[0], v0[1], v0[2], v0[3]); w8.y = pk4_fp8(v1[0], v1[1], v1[2], v1[3]);
                            if (bj == 0) {
                                *(u32x2*)(ws + C::K8_OFF + (size_t)row * 1024 + u.pn * 128 + wc * 32 + 8 * fq) = w8; }
                            else {
                                const int k = row & 63, pi = 32 * ((k >> 2) & 1) + ((k & 3) | (((k >> 3) & 3) << 2) | ((k >> 5) << 4));
                                unsigned char* vt = ws + C::VT8_OFF + (size_t)(u.pn * 128 + wc * 32 + 8 * fq) * C::SROWS + (row & ~63) + pi;
#pragma unroll
                                for (int e = 0; e < 4; ++e) { vt[(size_t)e * C::SROWS] = (unsigned char)(w8.x >> (8 * e)); vt[(size_t)(4 + e) * C::SROWS] = (unsigned char)(w8.y >> (8 * e)); } } }
                        if constexpr (C::F8MODE == 4) { if (u.pn >= 16) {
                            u32x2 w8; w8.x = pk4_fp8(v0[0], v0[1], v0[2], v0[3]); w8.y = pk4_fp8(v1[0], v1[1], v1[2], v1[3]);
                            const int k = row & 63, pi = 32 * ((k >> 2) & 1) + ((k & 3) | (((k >> 3) & 3) << 2) | ((k >> 5) << 4));
                            unsigned char* vt = ws + C::VT8_OFF + (size_t)(gc0 + bj * HALF - 4096) * C::SROWS + (row & ~63) + pi;
#pragma unroll
                            for (int e = 0; e < 4; ++e) { vt[(size_t)e * C::SROWS] = (unsigned char)(w8.x >> (8 * e)); vt[(size_t)(4 + e) * C::SROWS] = (unsigned char)(w8.y >> (8 * e)); } } }
                        if constexpr (C::F8MODE == 4) { if (u.pn < 16) {
                            u32x2 w8; w8.x = pk4_fp8(v0[0], v0[1], v0[2], v0[3]); w8.y = pk4_fp8(v1[0], v1[1], v1[2], v1[3]);
                            *(u32x2*)(ws + C::K8_OFF + (size_t)row * 4096 + gc0 + bj * HALF) = w8; } }
                        if constexpr (C::F8MODE == 3) { const int dc = col0 + bj * HALF; if (!first && dc >= 1280 && dc < 1344) {
                            u32x2 w8; w8.x = pk4_fp8(v0[0], v0[1], v0[2], v0[3]); w8.y = pk4_fp8(v1[0], v1[1], v1[2], v1[3]);
                            *(u32x2*)(ws + C::KR8_OFF + (size_t)row * 64 + (dc - 1280)) = w8; } }
                    } }
                if (GAINSS) { ss += shx<16>(ss); ss = sum32(ss); if (fq == 0 && first) SSout[(size_t)row * ssout_stride + u.pn * 4 + wc] = ss; } }
        if (COLSUM) { if (docs) {
#pragma unroll
            for (int bj = 0; bj < 2; ++bj)
#pragma unroll
                for (int e = 0; e < 8; ++e) { float t = csum[bj][e]; t += shx<1>(t); t += shx<2>(t); t += shx<4>(t); t += shx<8>(t); csum[bj][e] = t; }
            if (fr == 0) {
#pragma unroll
                for (int bj = 0; bj < 2; ++bj) { float* kp = KMP + (size_t)(u.pm * 2 + wr) * cs_ld + (gc0 + bj * HALF - cs_lo * BM);
                    *(f32x4*)kp = (f32x4){csum[bj][0], csum[bj][1], csum[bj][2], csum[bj][3]}; *(f32x4*)(kp + 4) = (f32x4){csum[bj][4], csum[bj][5], csum[bj][6], csum[bj][7]}; } } } }
    }
};
struct EpiUp8 {
    static constexpr bool PERM = true, AFTER_DRAIN = false;
    unsigned char* O; int ld;
    __device__ __forceinline__ void operator()(const f32x4 (&acc)[2][2][4][2], const Unit& u, int wr, int wc, int fr, int fq) const {
        const int row0 = u.pm * BM + wr * 64 + fr, col0 = u.pn * BM + wc * 32 + 8 * fq;
#pragma unroll
        for (int ai = 0; ai < 2; ++ai)
#pragma unroll
            for (int m = 0; m < 4; ++m) { unsigned char* rowp = O + (size_t)(row0 + ai * HALF + m * 16) * ld + col0;
#pragma unroll
                for (int bj = 0; bj < 2; ++bj) { f32x4 v0 = acc[ai][bj][m][0], v1 = acc[ai][bj][m][1];
#pragma unroll
                    for (int e = 0; e < 4; ++e) { const float a = fmaxf(v0[e], 0.f), b = fmaxf(v1[e], 0.f); v0[e] = fminf(a * a, 448.f); v1[e] = fminf(b * b, 448.f); }
                    u32x2 w; w.x = pk4_fp8(v0[0], v0[1], v0[2], v0[3]); w.y = pk4_fp8(v1[0], v1[1], v1[2], v1[3]);
                    *(u32x2*)(rowp + bj * HALF) = w; } }
    }
};
struct EpiStore8 {
    static constexpr bool PERM = true, AFTER_DRAIN = false;
    unsigned char* O; int ld;
    __device__ __forceinline__ void operator()(const f32x4 (&acc)[2][2][4][2], const Unit& u, int wr, int wc, int fr, int fq) const {
        const int row0 = u.pm * BM + wr * 64 + fr, col0 = u.pn * BM + wc * 32 + 8 * fq;
#pragma unroll
        for (int ai = 0; ai < 2; ++ai)
#pragma unroll
            for (int m = 0; m < 4; ++m) { unsigned char* rowp = O + (size_t)(row0 + ai * HALF + m * 16) * ld + col0;
#pragma unroll
                for (int bj = 0; bj < 2; ++bj) { const f32x4 v0 = acc[ai][bj][m][0], v1 = acc[ai][bj][m][1];
                    u32x2 w; w.x = pk4_fp8(v0[0], v0[1], v0[2], v0[3]); w.y = pk4_fp8(v1[0], v1[1], v1[2], v1[3]);
                    *(u32x2*)(rowp + bj * HALF) = w; } }
    }
};
struct EpiUpI8 {
    static constexpr bool PERM = true, AFTER_DRAIN = false;
    unsigned char* O; int ld; const float* ascale; const float* wscale;
    __device__ __forceinline__ void operator()(const f32x4 (&acc)[2][2][4][2], const Unit& u, int wr, int wc, int fr, int fq) const {
        const int row0 = u.pm * BM + wr * 64 + fr, col0 = u.pn * BM + wc * 32 + 8 * fq;
        f32x4 wsv[2][2];
#pragma unroll
        for (int bj = 0; bj < 2; ++bj) { wsv[bj][0] = *(const f32x4*)(wscale + col0 + bj * HALF); wsv[bj][1] = *(const f32x4*)(wscale + col0 + bj * HALF + 4); }
#pragma unroll
        for (int ai = 0; ai < 2; ++ai)
#pragma unroll
            for (int m = 0; m < 4; ++m) { const int row = row0 + ai * HALF + m * 16; unsigned char* rowp = O + (size_t)row * ld + col0; const float as = ascale[row];
#pragma unroll
                for (int bj = 0; bj < 2; ++bj) { const i32x4 i0 = __builtin_bit_cast(i32x4, acc[ai][bj][m][0]), i1 = __builtin_bit_cast(i32x4, acc[ai][bj][m][1]); f32x4 v0, v1;
#pragma unroll
                    for (int e = 0; e < 4; ++e) { const float a = fmaxf((float)i0[e] * as * wsv[bj][0][e], 0.f), b = fmaxf((float)i1[e] * as * wsv[bj][1][e], 0.f); v0[e] = fminf(a * a, 448.f); v1[e] = fminf(b * b, 448.f); }
                    u32x2 w; w.x = pk4_fp8(v0[0], v0[1], v0[2], v0[3]); w.y = pk4_fp8(v1[0], v1[1], v1[2], v1[3]);
                    *(u32x2*)(rowp + bj * HALF) = w; } }
    }
};
template <class C> struct EpiOutI8 {
    static constexpr bool PERM = true, AFTER_DRAIN = false;
    unsigned char* ws;
    __device__ __forceinline__ void operator()(const f32x4 (&acc)[2][2][4][2], const Unit& u, int wr, int wc, int fr, int fq) const {
        bf16_t* const O = (bf16_t*)(ws + C::O_OFF); float* const SS = (float*)(ws + C::SS_OFF); const float* const ascale = (const float*)(ws + C::ASC_OFF); const float* const wscale = (const float*)(ws + C::WSC_OFF); constexpr int ld = C::LD;
        const int row0 = u.pm * BM + wr * 64 + fr, col0 = u.pn * BM + wc * 32 + 8 * fq;
        f32x4 wsv[2][2];
#pragma unroll
        for (int bj = 0; bj < 2; ++bj) { wsv[bj][0] = *(const f32x4*)(wscale + col0 + bj * HALF); wsv[bj][1] = *(const f32x4*)(wscale + col0 + bj * HALF + 4); }
#pragma unroll
        for (int ai = 0; ai < 2; ++ai)
#pragma unroll
            for (int m = 0; m < 4; ++m) { const int row = row0 + ai * HALF + m * 16; bf16_t* rowp = O + (size_t)row * ld + col0; const float as = ascale[row]; float ss = 0.f;
#pragma unroll
                for (int bj = 0; bj < 2; ++bj) { const i32x4 i0 = __builtin_bit_cast(i32x4, acc[ai][bj][m][0]), i1 = __builtin_bit_cast(i32x4, acc[ai][bj][m][1]); f32x4 v0, v1;
#pragma unroll
                    for (int e = 0; e < 4; ++e) { v0[e] = (float)i0[e] * as * wsv[bj][0][e]; v1[e] = (float)i1[e] * as * wsv[bj][1][e]; }
                    ss += (v0[0] * v0[0] + v0[1] * v0[1]) + (v0[2] * v0[2] + v0[3] * v0[3]) + (v1[0] * v1[0] + v1[1] * v1[1]) + (v1[2] * v1[2] + v1[3] * v1[3]);
                    u32x4 w; w.x = cvt_pk_bf16(v0[0], v0[1]); w.y = cvt_pk_bf16(v0[2], v0[3]); w.z = cvt_pk_bf16(v1[0], v1[1]); w.w = cvt_pk_bf16(v1[2], v1[3]);
                    *(u32x4*)(rowp + bj * HALF) = w; }
                ss += shx<16>(ss); ss = sum32(ss); if (fq == 0) SS[(size_t)row * 32 + u.pn * 4 + wc] = ss; }
    }
};
struct EpiDown8 {
    static constexpr bool PERM = true, AFTER_DRAIN = false;
    bf16_t* O; int ld; float* SS; float sc;
    __device__ __forceinline__ void operator()(const f32x4 (&acc)[2][2][4][2], const Unit& u, int wr, int wc, int fr, int fq) const {
        const int row0 = u.pm * BM + wr * 64 + fr, col0 = u.pn * BM + wc * 32 + 8 * fq;
#pragma unroll
        for (int ai = 0; ai < 2; ++ai)
#pragma unroll
            for (int m = 0; m < 4; ++m) { const int row = row0 + ai * HALF + m * 16; bf16_t* rowp = O + (size_t)row * ld + col0; float ss = 0.f;
#pragma unroll
                for (int bj = 0; bj < 2; ++bj) { const f32x4 v0 = acc[ai][bj][m][0] * sc, v1 = acc[ai][bj][m][1] * sc;
                    ss += (v0[0] * v0[0] + v0[1] * v0[1]) + (v0[2] * v0[2] + v0[3] * v0[3]) + (v1[0] * v1[0] + v1[1] * v1[1]) + (v1[2] * v1[2] + v1[3] * v1[3]);
                    u32x4 w; w.x = cvt_pk_bf16(v0[0], v0[1]); w.y = cvt_pk_bf16(v0[2], v0[3]); w.z = cvt_pk_bf16(v1[0], v1[1]); w.w = cvt_pk_bf16(v1[2], v1[3]);
                    *(u32x4*)(rowp + bj * HALF) = w; }
                ss += shx<16>(ss); ss = sum32(ss); if (fq == 0) SS[(size_t)row * 32 + u.pn * 4 + wc] = ss; }
    }
};
template <bool NEXT> struct EpiPle {
    static constexpr bool PERM = true, AFTER_DRAIN = false, HGOUT = NEXT && !(QKV_I8);
    bf16_t* H16; float* OUT; const unsigned char* PP; const float* bias; int ld; bf16_t* HG; const float* gnext; float* SS; float asc;
    __device__ __forceinline__ void operator()(const f32x4 (&acc)[2][2][4][2], const Unit& u, int wr, int wc, int fr, int fq) const {
        const int row0 = u.pm * BM + wr * 64 + fr, col0 = u.pn * BM + wc * 32 + 8 * fq;
        float ssq[2][4];
#pragma unroll
        for (int ai = 0; ai < 2; ++ai)
#pragma unroll
            for (int m = 0; m < 4; ++m) ssq[ai][m] = 0.f;
#pragma unroll
        for (int bj = 0; bj < 2; ++bj) { const f32x4 b0 = *(const f32x4*)(bias + col0 + bj * HALF), b1 = *(const f32x4*)(bias + col0 + bj * HALF + 4);
            f32x4 g0 = (f32x4){0.f, 0.f, 0.f, 0.f}, g1 = g0; if (HGOUT) { g0 = *(const f32x4*)(gnext + col0 + bj * HALF); g1 = *(const f32x4*)(gnext + col0 + bj * HALF + 4); }
#pragma unroll
            for (int ai = 0; ai < 2; ++ai)
#pragma unroll
                for (int m = 0; m < 4; ++m) { const size_t off = (size_t)(row0 + ai * HALF + m * 16) * ld + col0 + bj * HALF;
                    const u32x2 pw8 = *(const u32x2*)(PP + off); const u32x4 hw = *(const u32x4*)(H16 + off);
                    f32x4 h0 = (f32x4){__uint_as_float(hw.x << 16), __uint_as_float(hw.x & 0xffff0000u), __uint_as_float(hw.y << 16), __uint_as_float(hw.y & 0xffff0000u)}, h1 = (f32x4){__uint_as_float(hw.z << 16), __uint_as_float(hw.z & 0xffff0000u), __uint_as_float(hw.w << 16), __uint_as_float(hw.w & 0xffff0000u)};
                    const f32x4 a0 = acc[ai][bj][m][0] * asc + b0, a1 = acc[ai][bj][m][1] * asc + b1;
                    { const f32x2 q0 = __builtin_amdgcn_cvt_pk_f32_fp8((int)pw8.x, false), q1 = __builtin_amdgcn_cvt_pk_f32_fp8((int)pw8.x, true), q2 = __builtin_amdgcn_cvt_pk_f32_fp8((int)pw8.y, false), q3 = __builtin_amdgcn_cvt_pk_f32_fp8((int)pw8.y, true);
                      const f32x4 pA = (f32x4){q0.x, q0.y, q1.x, q1.y}, pB = (f32x4){q2.x, q2.y, q3.x, q3.y};
#pragma unroll
                      for (int e = 0; e < 4; ++e) { h0[e] += pA[e] / (1.f + __expf(-a0[e])); h1[e] += pB[e] / (1.f + __expf(-a1[e])); } }
                    if (NEXT) { u32x4 ho; ho.x = cvt_pk_bf16(h0[0], h0[1]); ho.y = cvt_pk_bf16(h0[2], h0[3]); ho.z = cvt_pk_bf16(h1[0], h1[1]); ho.w = cvt_pk_bf16(h1[2], h1[3]); *(u32x4*)(H16 + off) = ho; }
                    else { *(f32x4*)(OUT + off) = h0; *(f32x4*)(OUT + off + 4) = h1; }
                    if (HGOUT) { ssq[ai][m] += (h0[0] * h0[0] + h0[1] * h0[1]) + (h0[2] * h0[2] + h0[3] * h0[3]) + (h1[0] * h1[0] + h1[1] * h1[1]) + (h1[2] * h1[2] + h1[3] * h1[3]);
                        const f32x4 x0 = h0 * g0, x1 = h1 * g1; u32x4 w; w.x = cvt_pk_bf16(x0[0], x0[1]); w.y = cvt_pk_bf16(x0[2], x0[3]); w.z = cvt_pk_bf16(x1[0], x1[1]); w.w = cvt_pk_bf16(x1[2], x1[3]);
                        *(u32x4*)(HG + off) = w; } } }
        if (HGOUT) {
#pragma unroll
            for (int ai = 0; ai < 2; ++ai)
#pragma unroll
                for (int m = 0; m < 4; ++m) { float t = ssq[ai][m]; t += shx<16>(t); t = sum32(t); if (fq == 0) SS[(size_t)(row0 + ai * HALF + m * 16) * 32 + u.pn * 4 + wc] = t; } }
    }
};
template <class Epi, class Sched, bool ALIGN_EPI = false, bool SP2 = false, int F8 = 0>
__device__ __forceinline__ void gemm_phase(PG8_LAS unsigned char* lds, const Gemm g, const Sched& S, const Epi& E) {
    int wid = g.wave; asm volatile("" : "+s"(wid));
    int tid = wid * 64 + lane_id(); asm volatile("" : "+v"(tid));
    const int lane = tid & 63, wr = wid >> 2, wc = wid & 3, fr = lane & 15, fq = lane >> 4;
    const int K = g.K, nt = K / BK;
    unsigned voffA[2], voffB[2];
#pragma unroll
    for (int i = 0; i < 2; ++i) { int R, C; stage_rc(tid * 16 + i * 8192, R, C); const int Rb = Epi::PERM ? ((R & ~31) + perm32(R & 31)) : R;
        voffA[i] = (unsigned)(R * g.lda + C) * 2u; voffB[i] = (unsigned)(Rb * K + C) * 2u; }
    const size_t kstep = (size_t)(BK * 2);
    const size_t hstepA = (size_t)HALF * g.lda * 2, hstepB = (size_t)HALF * K * 2;
    const size_t tstepA = 2 * hstepA, tstepB = 2 * hstepB;
    const unsigned ldsw = (unsigned)wid * 1024u;
    const int aoff = lds_byte(wr * 64 + fr, fq * 8), boff = lds_byte(wc * 32 + fr, fq * 8);
#define PG8_SA(b, h) (((b) * 2 + (h)) * HTB)
#define PG8_SB(b, h) ((4 + (b) * 2 + (h)) * HTB)
#define PG8_STAGE(bufoff, gbase, voff) do { _Pragma("unroll") for (int _i = 0; _i < 2; ++_i) { unsigned vo_ = (voff)[_i]; asm volatile("" : "+v"(vo_));     \
        __builtin_amdgcn_global_load_lds((const unsigned*)((const char*)(gbase) + vo_), (PG8_LAS unsigned*)(lds + (bufoff) + ldsw + _i * 8192), 16, 0, 0); } } while (0)
#define PG8_LDA(dst, b, h) do { _Pragma("unroll") for (int m = 0; m < 4; ++m) _Pragma("unroll") for (int k = 0; k < 2; ++k) dst[m][k] = *(const PG8_LAS bf16x8*)(lds + PG8_SA(b, h) + aoff + m * 2048 + k * 1024); } while (0)
#define PG8_LDB(dst, b, h) do { _Pragma("unroll") for (int n = 0; n < 2; ++n) _Pragma("unroll") for (int k = 0; k < 2; ++k) dst[n][k] = *(const PG8_LAS bf16x8*)(lds + PG8_SB(b, h) + boff + n * 2048 + k * 1024); } while (0)
#define PG8_CAT8(x, y) __builtin_shufflevector(__builtin_bit_cast(i32x4, x), __builtin_bit_cast(i32x4, y), 0, 1, 2, 3, 4, 5, 6, 7)
#define PG8_MMA(ai, bj, At, Bt) do { __builtin_amdgcn_s_setprio(1); \
        if constexpr (F8 == 2) { _Pragma("unroll") for (int m = 0; m < 4; ++m) _Pragma("unroll") for (int n = 0; n < 2; ++n) _Pragma("unroll") for (int k = 0; k < 2; ++k) \
            acc[ai][bj][m][n] = __builtin_bit_cast(f32x4, __builtin_amdgcn_mfma_i32_16x16x64_i8(__builtin_bit_cast(i32x4, Bt[n][k]), __builtin_bit_cast(i32x4, At[m][k]), __builtin_bit_cast(i32x4, acc[ai][bj][m][n]), 0, 0, 0)); } \
        else if constexpr (F8 == 1) { _Pragma("unroll") for (int m = 0; m < 4; ++m) _Pragma("unroll") for (int n = 0; n < 2; ++n) \
            acc[ai][bj][m][n] = __builtin_amdgcn_mfma_scale_f32_16x16x128_f8f6f4(PG8_CAT8(Bt[n][0], Bt[n][1]), PG8_CAT8(At[m][0], At[m][1]), acc[ai][bj][m][n], 0, 0, 0, 0x7f7f7f7f, 0, 0x7f7f7f7f); } \
        else { _Pragma("unroll") for (int m = 0; m < 4; ++m) _Pragma("unroll") for (int n = 0; n < 2; ++n) _Pragma("unroll") for (int k = 0; k < 2; ++k) \
            acc[ai][bj][m][n] = __builtin_amdgcn_mfma_f32_16x16x32_bf16(Bt[n][k], At[m][k], acc[ai][bj][m][n], 0, 0, 0); } \
        __builtin_amdgcn_s_setprio(0); } while (0)
#define PG8_WAIT_V(n) asm volatile("s_waitcnt vmcnt(" #n ")" ::: "memory")
#define PG8_WAIT_L(n) asm volatile("s_waitcnt lgkmcnt(" #n ")" ::: "memory")
#define PG8_BAR __builtin_amdgcn_s_barrier()
#define PG8_SCHED __builtin_amdgcn_sched_barrier(0)
    Unit cur, nxt; int ui = 0;
    if (!S.next(0, cur)) return;
    f32x4 acc[2][2][4][2];
#pragma unroll
    for (int a = 0; a < 2; ++a)
#pragma unroll
        for (int b = 0; b < 2; ++b)
#pragma unroll
            for (int m = 0; m < 4; ++m)
#pragma unroll
                for (int n = 0; n < 2; ++n) acc[a][b][m][n] = (f32x4){0.f, 0.f, 0.f, 0.f};
    bf16x8 At[4][2], B0[2][2], B1[2][2];
    const char* cA = (const char*)g.A + (size_t)cur.pm * tstepA; const char* cB = (const char*)g.Bt + (size_t)cur.pn * tstepB;
    S.a_ready(cur);
    if constexpr (SP2) {
        PG8_STAGE(PG8_SB(0, 0), cB, voffB); PG8_STAGE(PG8_SB(0, 1), cB + hstepB, voffB); PG8_STAGE(PG8_SA(0, 0), cA, voffA); PG8_STAGE(PG8_SA(0, 1), cA + hstepA, voffA);
        if (wr == 1) PG8_BAR;
        PG8_WAIT_V(2); PG8_BAR;
        PG8_STAGE(PG8_SB(1, 0), cB + kstep, voffB); PG8_STAGE(PG8_SA(1, 0), cA + kstep, voffA); PG8_STAGE(PG8_SB(1, 1), cB + hstepB + kstep, voffB);
        PG8_WAIT_V(6); PG8_BAR;
    } else {
        PG8_STAGE(PG8_SB(0, 0), cB, voffB); PG8_STAGE(PG8_SA(0, 0), cA, voffA); PG8_STAGE(PG8_SB(0, 1), cB + hstepB, voffB); PG8_STAGE(PG8_SA(0, 1), cA + hstepA, voffA);
        if (wr == 1) PG8_BAR;
        PG8_WAIT_V(4); PG8_BAR;
        PG8_STAGE(PG8_SB(1, 0), cB + kstep, voffB); PG8_STAGE(PG8_SA(1, 0), cA + kstep, voffA); PG8_STAGE(PG8_SB(1, 1), cB + hstepB + kstep, voffB);
        PG8_WAIT_V(6); PG8_BAR;
    }
    for (;;) {
        const bool has_next = S.next(ui + 1, nxt);
        const char* nA = has_next ? (const char*)g.A + (size_t)nxt.pm * tstepA : cA; const char* nB = has_next ? (const char*)g.Bt + (size_t)nxt.pn * tstepB : cB;
        for (int t = 0; t < nt; t += 2) {
            const bool last = (t == nt - 2);
            const char* a1 = cA + (size_t)(t + 1) * kstep;
            const char* a2 = last ? nA : cA + (size_t)(t + 2) * kstep; const char* b2 = last ? nB : cB + (size_t)(t + 2) * kstep;
            const char* a3 = a2 + kstep; const char* b3 = b2 + kstep;
            if (last && has_next) S.a_ready(nxt);
            if constexpr (SP2) {
            PG8_LDB(B0, 0, 0); PG8_LDB(B1, 0, 1); PG8_SCHED; PG8_LDA(At, 0, 0); PG8_STAGE(PG8_SA(1, 1), a1 + hstepA, voffA);
            PG8_WAIT_V(8); PG8_WAIT_L(0); PG8_BAR; PG8_MMA(0, 0, At, B0); PG8_MMA(0, 1, At, B1); PG8_BAR; PG8_SCHED;
            PG8_LDA(At, 0, 1); PG8_STAGE(PG8_SB(0, 0), b2, voffB); PG8_STAGE(PG8_SB(0, 1), b2 + hstepB, voffB); PG8_STAGE(PG8_SA(0, 0), a2, voffA);
            PG8_WAIT_V(8); PG8_WAIT_L(0); PG8_BAR; PG8_MMA(1, 0, At, B0); PG8_MMA(1, 1, At, B1); PG8_BAR; PG8_SCHED;
            PG8_LDB(B0, 1, 0); PG8_LDB(B1, 1, 1); PG8_SCHED; PG8_LDA(At, 1, 0); PG8_STAGE(PG8_SA(0, 1), a2 + hstepA, voffA);
            PG8_WAIT_V(8); PG8_WAIT_L(0); PG8_BAR; PG8_MMA(0, 0, At, B0); PG8_MMA(0, 1, At, B1); PG8_BAR; PG8_SCHED;
            PG8_LDA(At, 1, 1); PG8_STAGE(PG8_SB(1, 0), b3, voffB); PG8_STAGE(PG8_SB(1, 1), b3 + hstepB, voffB); PG8_STAGE(PG8_SA(1, 0), a3, voffA);
            PG8_WAIT_V(8); PG8_WAIT_L(0); PG8_BAR; PG8_MMA(1, 0, At, B0); PG8_MMA(1, 1, At, B1); PG8_BAR; PG8_SCHED;
            } else {
            PG8_LDB(B0, 0, 0); PG8_SCHED; PG8_LDA(At, 0, 0); PG8_STAGE(PG8_SA(1, 1), a1 + hstepA, voffA);
            PG8_WAIT_L(8); PG8_BAR; PG8_WAIT_L(0); PG8_MMA(0, 0, At, B0); PG8_BAR; PG8_SCHED;
            PG8_LDB(B1, 0, 1); PG8_STAGE(PG8_SB(0, 0), b2, voffB);
            PG8_BAR; PG8_WAIT_L(0); PG8_MMA(0, 1, At, B1); PG8_BAR;
            PG8_LDA(At, 0, 1); PG8_STAGE(PG8_SA(0, 0), a2, voffA);
            PG8_BAR; PG8_WAIT_L(0); PG8_MMA(1, 0, At, B0); PG8_BAR; PG8_SCHED;
            PG8_STAGE(PG8_SB(0, 1), b2 + hstepB, voffB);
            PG8_WAIT_V(6); PG8_BAR; PG8_MMA(1, 1, At, B1); PG8_BAR;
            PG8_LDB(B0, 1, 0); PG8_SCHED; PG8_LDA(At, 1, 0); PG8_STAGE(PG8_SA(0, 1), a2 + hstepA, voffA);
            PG8_WAIT_L(8); PG8_BAR; PG8_WAIT_L(0); PG8_MMA(0, 0, At, B0); PG8_BAR; PG8_SCHED;
            PG8_LDB(B1, 1, 1); PG8_STAGE(PG8_SB(1, 0), b3, voffB);
            PG8_BAR; PG8_WAIT_L(0); PG8_MMA(0, 1, At, B1); PG8_BAR;
            PG8_LDA(At, 1, 1); PG8_STAGE(PG8_SA(1, 0), a3, voffA);
            PG8_BAR; PG8_WAIT_L(0); PG8_MMA(1, 0, At, B0); PG8_BAR; PG8_SCHED;
            PG8_STAGE(PG8_SB(1, 1), b3 + hstepB, voffB);
            PG8_WAIT_V(6); PG8_BAR; PG8_MMA(1, 1, At, B1); PG8_BAR;
            }
        }
        if constexpr (ALIGN_EPI) { if (wr == 0) PG8_BAR; }
        if constexpr (!Epi::AFTER_DRAIN) { int l2 = lane_id(); asm volatile("" : "+v"(l2));
            const int w2 = wid; E(acc, cur, w2 >> 2, w2 & 3, l2 & 15, l2 >> 4); S.done(cur); }
        if (!has_next) break;
#pragma unroll
        for (int a = 0; a < 2; ++a)
#pragma unroll
            for (int b = 0; b < 2; ++b)
#pragma unroll
                for (int m = 0; m < 4; ++m)
#pragma unroll
                    for (int n = 0; n < 2; ++n) acc[a][b][m][n] = (f32x4){0.f, 0.f, 0.f, 0.f};
        cur = nxt; cA = nA; cB = nB; ++ui;
        if constexpr (ALIGN_EPI) { if (wr == 1) PG8_BAR; }
    }
    PG8_WAIT_V(0);
    if constexpr (!ALIGN_EPI) { if (wr == 0) PG8_BAR; }
    PG8_BAR;
    if constexpr (Epi::AFTER_DRAIN) { E.fused(acc, cur, wr, wc, fr, fq, lds, wid, lane); S.done(cur); }
#undef PG8_SA
#undef PG8_SB
#undef PG8_STAGE
#undef PG8_LDA
#undef PG8_LDB
#undef PG8_MMA
#undef PG8_CAT8
#undef PG8_WAIT_V
#undef PG8_WAIT_L
#undef PG8_BAR
#undef PG8_SCHED
}
}

namespace att {
typedef unsigned short bf16_t;
typedef short bf16x8 __attribute__((ext_vector_type(8)));
typedef short s16x4 __attribute__((ext_vector_type(4)));
typedef float f32x16 __attribute__((ext_vector_type(16)));
typedef float f32x4 __attribute__((ext_vector_type(4)));
typedef unsigned u32x4 __attribute__((ext_vector_type(4)));
constexpr int NW = 8, QBLK = 32, KVBLK = 64, SHM_V = 16384;
constexpr int LDS_V = 0, LDS_K = 2 * SHM_V, LDS_WS = LDS_K + 2 * 32768, LDS_OTAB = LDS_WS + NW * 256, LDS_PFX = LDS_OTAB + NW * 128, LDS_END = LDS_PFX + 8192;
#define SBAR() __builtin_amdgcn_sched_barrier(0)
__device__ __forceinline__ int v_st(int k, int c) { const int kk = (k & ~0xC) | ((k & 4) << 1) | ((k & 8) >> 1); return ((kk >> 3) * 4 + (c >> 5)) * 512 + ((kk & 7) * 32 + (c & 31)) * 2; }
__device__ __forceinline__ int v_rd_base(int lane) { return ((lane & 3) << 3) | (((lane >> 2) & 3) << 6) | (((lane >> 4) & 1) << 5) | (((lane >> 5) & 1) << 8); }
constexpr int v_rd_off(int d0, int ks, int half) { return d0 * 512 + ks * 4096 + half * 2048; }
__device__ __forceinline__ int crow(int r, int hi) { return (r & 3) + 8 * (r >> 2) + 4 * hi; }
__device__ __forceinline__ unsigned cvtpk(float lo, float hi) { unsigned r; asm volatile("v_cvt_pk_bf16_f32 %0, %1, %2" : "=v"(r) : "v"(lo), "v"(hi)); return r; }
__device__ __forceinline__ float bf2f(unsigned short x) { return __uint_as_float((unsigned)x << 16); }
template <int DQK> __device__ __forceinline__ int kswz(int row, int colB) { return row * (DQK * 2) + (colB ^ ((row & 7) << 4)); }
__device__ __forceinline__ void mask_tile(f32x16& p0, f32x16& p1, int dq, unsigned W) {
    const float NEG = -__builtin_inff();
#pragma unroll
    for (int r = 0; r < 16; ++r) { const int c = (r & 3) + 8 * (r >> 2);
        if ((unsigned)(dq - c) >= W) p0[r] = NEG;
        if ((unsigned)(dq - c - 32) >= W) p1[r] = NEG; }
}
__device__ __forceinline__ void partialSM(f32x16& p0, f32x16& p1, float& m_reg, float& alpha, float sc, float c2) {
    float pmax = p0[0];
#pragma unroll
    for (int r = 1; r < 16; ++r) pmax = fmaxf(pmax, p0[r]);
#pragma unroll
    for (int r = 0; r < 16; ++r) pmax = fmaxf(pmax, p1[r]);
    { auto rr = __builtin_amdgcn_permlane32_swap(__float_as_uint(pmax), __float_as_uint(pmax), false, false);
      pmax = fmaxf(__uint_as_float(rr[0]), __uint_as_float(rr[1])); }
    float mn;
    if (__builtin_expect(__all((pmax - m_reg) * sc <= 8.f), 1)) { mn = m_reg; alpha = 1.f; }
    else { mn = fmaxf(m_reg, pmax); alpha = __builtin_amdgcn_exp2f((m_reg - mn) * c2); m_reg = mn; }
    const float mnL = -mn * c2;
#pragma unroll
    for (int r = 0; r < 16; ++r) p0[r] = __builtin_amdgcn_exp2f(fmaf(p0[r], c2, mnL));
#pragma unroll
    for (int r = 0; r < 16; ++r) p1[r] = __builtin_amdgcn_exp2f(fmaf(p1[r], c2, mnL));
}
__device__ __forceinline__ void finishSM(f32x16& p0, f32x16& p1, float alpha, float& l_reg, bf16x8& pa0, bf16x8& pa1, bf16x8& pa2, bf16x8& pa3) {
    float ps = 0;
#pragma unroll
    for (int r = 0; r < 16; ++r) ps += p0[r];
#pragma unroll
    for (int r = 0; r < 16; ++r) ps += p1[r];
    { auto rr = __builtin_amdgcn_permlane32_swap(__float_as_uint(ps), __float_as_uint(ps), false, false);
      ps = __uint_as_float(rr[0]) + __uint_as_float(rr[1]); }
    l_reg = l_reg * alpha + ps;
#define PK4(P, B_, OUT) do { unsigned a0 = cvtpk(P[B_+0], P[B_+1]), a1 = cvtpk(P[B_+2], P[B_+3]);                          \
        unsigned b0 = cvtpk(P[B_+4], P[B_+5]), b1 = cvtpk(P[B_+6], P[B_+7]);                                             \
        auto r0 = __builtin_amdgcn_permlane32_swap(a0, b0, false, false); auto r1 = __builtin_amdgcn_permlane32_swap(a1, b1, false, false); \
        u32x4 w = {r0[0], r1[0], r0[1], r1[1]}; OUT = *reinterpret_cast<bf16x8*>(&w); } while (0)
    PK4(p0, 0, pa0); PK4(p0, 8, pa1); PK4(p1, 0, pa2); PK4(p1, 8, pa3);
#undef PK4
}
template <int DQK>
__device__ __forceinline__ void qkt(f32x16& p0, f32x16& p1, const char* Kbuf, int r32, int hi, const bf16x8* qr) {
    p0 = f32x16{}; p1 = f32x16{};
    const int sw = (r32 & 7) << 4; const char* rb = Kbuf + r32 * (DQK * 2);
#pragma unroll
    for (int d0 = 0; d0 < DQK / 16; ++d0) { const char* a = rb + ((d0 * 32 + hi * 16) ^ sw);
        const bf16x8 b0 = *reinterpret_cast<const bf16x8*>(a);
        const bf16x8 b1 = *reinterpret_cast<const bf16x8*>(a + 32 * DQK * 2);
        p0 = __builtin_amdgcn_mfma_f32_32x32x16_bf16(b0, qr[d0], p0, 0, 0, 0);
        p1 = __builtin_amdgcn_mfma_f32_32x32x16_bf16(b1, qr[d0], p1, 0, 0, 0); }
}
template <int DV>
__device__ __forceinline__ void pv_tile(f32x16* o, int vb, bf16x8 pa0, bf16x8 pa1, bf16x8 pa2, bf16x8 pa3) {
#define TRRD(dst, off) asm volatile("ds_read_b64_tr_b16 %0, %1 offset:%2" : "=&v"(dst) : "v"(vb), "i"(off) : "memory")
#define PV_KS(ks, PA) do { s16x4 l0, h0, l1, h1, l2, h2, l3, h3; constexpr int b_ = v_rd_off(0, ks, 0);   \
        TRRD(l0, b_); TRRD(h0, b_ + 2048); TRRD(l1, b_ + 512); TRRD(h1, b_ + 512 + 2048); \
        if constexpr (DV == 128) { TRRD(l2, b_ + 1024); TRRD(h2, b_ + 1024 + 2048); TRRD(l3, b_ + 1536); TRRD(h3, b_ + 1536 + 2048); } \
        asm volatile("s_waitcnt lgkmcnt(0)" ::: "memory"); SBAR();   \
        o[0] = __builtin_amdgcn_mfma_f32_32x32x16_bf16(PA, (bf16x8){l0[0], l0[1], l0[2], l0[3], h0[0], h0[1], h0[2], h0[3]}, o[0], 0, 0, 0);   \
        o[1] = __builtin_amdgcn_mfma_f32_32x32x16_bf16(PA, (bf16x8){l1[0], l1[1], l1[2], l1[3], h1[0], h1[1], h1[2], h1[3]}, o[1], 0, 0, 0);   \
        if constexpr (DV == 128) { \
        o[2] = __builtin_amdgcn_mfma_f32_32x32x16_bf16(PA, (bf16x8){l2[0], l2[1], l2[2], l2[3], h2[0], h2[1], h2[2], h2[3]}, o[2], 0, 0, 0);   \
        o[3] = __builtin_amdgcn_mfma_f32_32x32x16_bf16(PA, (bf16x8){l3[0], l3[1], l3[2], l3[3], h3[0], h3[1], h3[2], h3[3]}, o[3], 0, 0, 0); } } while (0)
    PV_KS(0, pa0); PV_KS(1, pa1); PV_KS(2, pa2); PV_KS(3, pa3);
#undef PV_KS
#undef TRRD
}
struct Job {
    const bf16_t* K; long ldk;
    const bf16_t* K2; long ldk2;
    const bf16_t* V; long ldv;
    int j_lo, j_hi;
    int wave;
    int wq_lo;
    int qpos;
    unsigned W;
    int nomask;
    float m0, l0;
    float sc, c2;
};
template <int DQK, int DV>
__device__ __forceinline__ void attn_core(__attribute__((address_space(3))) unsigned char* lds3, const Job& J, const bf16x8* qr, f32x16* o, float& m_reg, float& l_reg) {
    constexpr int KB = KVBLK * DQK * 2, NKC = DQK / 8, NKT = DQK / 64, NVT = DV / 64;
    char* lds = (char*)lds3;
    int wid = J.wave; asm volatile("" : "+s"(wid)); int tid = wid * 64 + lane_id(); asm volatile("" : "+v"(tid));
    const int lane = tid & 63, r32 = lane & 31, hi = lane >> 5;
    char* V_lds = lds + LDS_V; char* K_lds = lds + LDS_K;
    float* al_l = (float*)(lds + LDS_WS) + wid * 64 + 32;
    const bf16_t* ksrc[NKT]; long kld[NKT]; const bf16_t* vsrc[NVT];
#pragma unroll
    for (int i = 0; i < NKT; ++i) { const int q = (wid * NKT + i) * 64 + lane, row = q / NKC, pos = q % NKC, ch = pos ^ (row & 7);
        if (DQK == 192 && ch >= 16) { ksrc[i] = J.K2 + (long)row * J.ldk2 + (ch - 16) * 8; kld[i] = J.ldk2; } else { ksrc[i] = J.K + (long)row * J.ldk + ch * 8; kld[i] = J.ldk; } }
#pragma unroll
    for (int i = 0; i < NVT; ++i) { const int m = (DV == 128) ? (wid * 2 + i) : (wid * 2), q = m * 64 + lane, st = q >> 5, w = q & 31, kk = ((st >> 2) << 3) | (w >> 2), c = (st & 3) * 32 + (w & 3) * 8;
        const int k = (kk & ~0xC) | ((kk & 4) << 1) | ((kk & 8) >> 1); vsrc[i] = J.V + (long)k * J.ldv + c; }
#define LOADT(j, bf) do { const long kb_ = (long)(j) * KVBLK; \
        _Pragma("unroll") for (int i = 0; i < NKT; ++i) __builtin_amdgcn_global_load_lds((const unsigned*)(ksrc[i] + kb_ * kld[i]), (__attribute__((address_space(3))) unsigned*)(lds3 + LDS_K + (bf) * KB + (wid * NKT + i) * 1024), 16, 0, 0); \
        _Pragma("unroll") for (int i = 0; i < NVT; ++i) __builtin_amdgcn_global_load_lds((const unsigned*)(vsrc[i] + kb_ * J.ldv), (__attribute__((address_space(3))) unsigned*)(lds3 + LDS_V + (bf) * SHM_V + ((DV == 128) ? (wid * 2 + i) : (wid * 2)) * 1024), 16, 0, 0); } while (0)
    const int vb0 = (int)(uintptr_t)V_lds + v_rd_base(lane);
    m_reg = J.m0; l_reg = J.l0;
#pragma unroll
    for (int d = 0; d < DV / 32; ++d) o[d] = f32x16{};
    const int NT = J.j_hi - J.j_lo;
    LOADT(J.j_lo, 0); asm volatile("s_waitcnt vmcnt(0)" ::: "memory"); __syncthreads();
    for (int t = 0; t < NT; ++t) {
        const int bf = t & 1, kbase = (J.j_lo + t) * KVBLK;
        if (t + 1 < NT) LOADT(J.j_lo + t + 1, bf ^ 1);
        const bool act = J.nomask || ((kbase <= J.wq_lo + QBLK - 1) && (kbase + KVBLK - 1 >= J.wq_lo - (int)J.W + 1));
        if (act) {
            f32x16 p0, p1; bf16x8 pa0, pa1, pa2, pa3; float alpha;
            qkt<DQK>(p0, p1, K_lds + bf * KB, r32, hi, qr);
            if (!J.nomask && (kbase + KVBLK - 1 > J.wq_lo || kbase <= J.wq_lo + QBLK - 1 - (int)J.W)) mask_tile(p0, p1, J.qpos - 4 * hi - kbase, J.W);
            partialSM(p0, p1, m_reg, alpha, J.sc, J.c2);
            if (__any(alpha < 1.f)) { if (hi == 0) al_l[r32] = alpha; asm volatile("s_waitcnt lgkmcnt(0)" ::: "memory");
#pragma unroll
                for (int d_ = 0; d_ < DV / 32; ++d_)
#pragma unroll
                    for (int r = 0; r < 16; ++r) o[d_][r] *= al_l[crow(r, hi)]; }
            finishSM(p0, p1, alpha, l_reg, pa0, pa1, pa2, pa3); SBAR();
            pv_tile<DV>(o, vb0 + bf * SHM_V, pa0, pa1, pa2, pa3);
        }
        asm volatile("s_waitcnt vmcnt(0)" ::: "memory");
        __syncthreads();
    }
#undef LOADT
}

typedef int i32x8 __attribute__((ext_vector_type(8)));
typedef int i32x4v __attribute__((ext_vector_type(4)));
struct Job8 { const unsigned char* Kn; const unsigned char* Kr; };
template <int DV>
__device__ __forceinline__ void attn_core_k8(__attribute__((address_space(3))) unsigned char* lds3, const Job& J, const Job8& J8, const i32x8* qf, f32x16* o, float& m_reg, float& l_reg) {
    constexpr int KB8 = KVBLK * 256, NVT = DV / 64;
    char* lds = (char*)lds3;
    int wid = J.wave; asm volatile("" : "+s"(wid)); int tid = wid * 64 + lane_id(); asm volatile("" : "+v"(tid));
    const int lane = tid & 63, r32 = lane & 31, hi = lane >> 5;
    char* V_lds = lds + LDS_V; char* K_lds = lds + LDS_K;
    float* al_l = (float*)(lds + LDS_WS) + wid * 64 + 32;
    const unsigned char* ksrc[2]; long kld[2]; const bf16_t* vsrc[NVT];
#pragma unroll
    for (int i = 0; i < 2; ++i) { const int q = (wid * 2 + i) * 64 + lane, row = q >> 4, pos = q & 15; int c = pos ^ (row & 15); if (c > 11) c = 11;
        if (c >= 8) { ksrc[i] = J8.Kr + (long)row * 64 + (c - 8) * 16; kld[i] = 64; } else { ksrc[i] = J8.Kn + (long)row * 1024 + c * 16; kld[i] = 1024; } }
#pragma unroll
    for (int i = 0; i < NVT; ++i) { const int m = (DV == 128) ? (wid * 2 + i) : (wid * 2), q = m * 64 + lane, st = q >> 5, w = q & 31, kk = ((st >> 2) << 3) | (w >> 2), c = (st & 3) * 32 + (w & 3) * 8;
        const int k = (kk & ~0xC) | ((kk & 4) << 1) | ((kk & 8) >> 1); vsrc[i] = J.V + (long)k * J.ldv + c; }
#define LOADT8(j, bf) do { const long kb_ = (long)(j) * KVBLK; \
        _Pragma("unroll") for (int i = 0; i < 2; ++i) __builtin_amdgcn_global_load_lds((const unsigned*)(ksrc[i] + kb_ * kld[i]), (__attribute__((address_space(3))) unsigned*)(lds3 + LDS_K + (bf) * KB8 + (wid * 2 + i) * 1024), 16, 0, 0); \
        _Pragma("unroll") for (int i = 0; i < NVT; ++i) __builtin_amdgcn_global_load_lds((const unsigned*)(vsrc[i] + kb_ * J.ldv), (__attribute__((address_space(3))) unsigned*)(lds3 + LDS_V + (bf) * SHM_V + ((DV == 128) ? (wid * 2 + i) : (wid * 2)) * 1024), 16, 0, 0); } while (0)
    const int vb0 = (int)(uintptr_t)V_lds + v_rd_base(lane);
    m_reg = J.m0; l_reg = J.l0;
#pragma unroll
    for (int d = 0; d < DV / 32; ++d) o[d] = f32x16{};
    const int NT = J.j_hi - J.j_lo;
    LOADT8(J.j_lo, 0); asm volatile("s_waitcnt vmcnt(0)" ::: "memory"); __syncthreads();
    for (int t = 0; t < NT; ++t) {
        const int bf = t & 1, kbase = (J.j_lo + t) * KVBLK;
        if (t + 1 < NT) LOADT8(J.j_lo + t + 1, bf ^ 1);
        const bool act = J.nomask || ((kbase <= J.wq_lo + QBLK - 1) && (kbase + KVBLK - 1 >= J.wq_lo - (int)J.W + 1));
        if (act) {
            f32x16 p0 = f32x16{}, p1 = f32x16{}; bf16x8 pa0, pa1, pa2, pa3; float alpha;
            { const char* rb = K_lds + bf * KB8 + r32 * 256; const int sw = r32 & 15;
#pragma unroll
              for (int g = 0; g < 3; ++g) { const int c0 = (4 * g + 2 * hi) ^ sw;
                  const i32x4v a0 = *reinterpret_cast<const i32x4v*>(rb + (c0 << 4)), a1 = *reinterpret_cast<const i32x4v*>(rb + ((c0 ^ 1) << 4));
                  const i32x4v b0 = *reinterpret_cast<const i32x4v*>(rb + 32 * 256 + (c0 << 4)), b1 = *reinterpret_cast<const i32x4v*>(rb + 32 * 256 + ((c0 ^ 1) << 4));
                  const i32x8 A0 = __builtin_shufflevector(a0, a1, 0, 1, 2, 3, 4, 5, 6, 7), A1 = __builtin_shufflevector(b0, b1, 0, 1, 2, 3, 4, 5, 6, 7);
                  p0 = __builtin_amdgcn_mfma_scale_f32_32x32x64_f8f6f4(A0, qf[g], p0, 0, 0, 0, 0x7f7f7f7f, 0, 0x7f7f7f7f);
                  p1 = __builtin_amdgcn_mfma_scale_f32_32x32x64_f8f6f4(A1, qf[g], p1, 0, 0, 0, 0x7f7f7f7f, 0, 0x7f7f7f7f); } }
            if (!J.nomask && (kbase + KVBLK - 1 > J.wq_lo || kbase <= J.wq_lo + QBLK - 1 - (int)J.W)) mask_tile(p0, p1, J.qpos - 4 * hi - kbase, J.W);
            partialSM(p0, p1, m_reg, alpha, J.sc, J.c2);
            if (__any(alpha < 1.f)) { if (hi == 0) al_l[r32] = alpha; asm volatile("s_waitcnt lgkmcnt(0)" ::: "memory");
#pragma unroll
                for (int d_ = 0; d_ < DV / 32; ++d_)
#pragma unroll
                    for (int r = 0; r < 16; ++r) o[d_][r] *= al_l[crow(r, hi)]; }
            finishSM(p0, p1, alpha, l_reg, pa0, pa1, pa2, pa3); SBAR();
            pv_tile<DV>(o, vb0 + bf * SHM_V, pa0, pa1, pa2, pa3);
        }
        asm volatile("s_waitcnt vmcnt(0)" ::: "memory");
        __syncthreads();
    }
#undef LOADT8
}

struct Job8v { const unsigned char* Kn; const unsigned char* Kr; const unsigned char* Vt; long ldvt; };
template <int DV>
__device__ __forceinline__ void attn_core_kv8(__attribute__((address_space(3))) unsigned char* lds3, const Job& J, const Job8v& J8, const i32x8* qf, f32x16* o, float& m_reg, float& l_reg) {
    constexpr int KB8 = KVBLK * 256, VB8 = DV * 64;
    static_assert(DV == 128, "one LDS-DMA instruction per wave fills the 128 x 64 B V^T tile");
    char* lds = (char*)lds3;
    int wid = J.wave; asm volatile("" : "+s"(wid)); int tid = wid * 64 + lane_id(); asm volatile("" : "+v"(tid));
    const int lane = tid & 63, r32 = lane & 31, hi = lane >> 5;
    char* V_lds = lds + LDS_V; char* K_lds = lds + LDS_K;
    float* al_l = (float*)(lds + LDS_WS) + wid * 64 + 32;
    const unsigned char* ksrc[2]; long kld[2]; const unsigned char* vsrc;
#pragma unroll
    for (int i = 0; i < 2; ++i) { const int q = (wid * 2 + i) * 64 + lane, row = q >> 4, pos = q & 15; int c = pos ^ (row & 15); if (c > 11) c = 11;
        if (c >= 8) { ksrc[i] = J8.Kr + (long)row * 64 + (c - 8) * 16; kld[i] = 64; } else { ksrc[i] = J8.Kn + (long)row * 1024 + c * 16; kld[i] = 1024; } }
    { const int q = wid * 64 + lane, row = q >> 2, pos = q & 3, c = pos ^ ((row >> 2) & 3); vsrc = J8.Vt + (long)row * J8.ldvt + c * 16; }
#define LOADT9(j, bf) do { const long kb_ = (long)(j) * KVBLK; \
        _Pragma("unroll") for (int i = 0; i < 2; ++i) __builtin_amdgcn_global_load_lds((const unsigned*)(ksrc[i] + kb_ * kld[i]), (__attribute__((address_space(3))) unsigned*)(lds3 + LDS_K + (bf) * KB8 + (wid * 2 + i) * 1024), 16, 0, 0); \
        __builtin_amdgcn_global_load_lds((const unsigned*)(vsrc + kb_), (__attribute__((address_space(3))) unsigned*)(lds3 + LDS_V + (bf) * VB8 + wid * 1024), 16, 0, 0); } while (0)
    m_reg = J.m0; l_reg = J.l0;
#pragma unroll
    for (int d = 0; d < DV / 32; ++d) o[d] = f32x16{};
    const int NT = J.j_hi - J.j_lo;
    LOADT9(J.j_lo, 0); asm volatile("s_waitcnt vmcnt(0)" ::: "memory"); __syncthreads();
    const int swv = (r32 >> 2) & 3;
    for (int t = 0; t < NT; ++t) {
        const int bf = t & 1, kbase = (J.j_lo + t) * KVBLK;
        if (t + 1 < NT) LOADT9(J.j_lo + t + 1, bf ^ 1);
        const bool act = J.nomask || ((kbase <= J.wq_lo + QBLK - 1) && (kbase + KVBLK - 1 >= J.wq_lo - (int)J.W + 1));
        if (act) {
            f32x16 p0 = f32x16{}, p1 = f32x16{}; float alpha;
            { const char* rb = K_lds + bf * KB8 + r32 * 256; const int sw = r32 & 15;
#pragma unroll
              for (int g = 0; g < 3; ++g) { const int c0 = (4 * g + 2 * hi) ^ sw;
                  const i32x4v a0 = *reinterpret_cast<const i32x4v*>(rb + (c0 << 4)), a1 = *reinterpret_cast<const i32x4v*>(rb + ((c0 ^ 1) << 4));
                  const i32x4v b0 = *reinterpret_cast<const i32x4v*>(rb + 32 * 256 + (c0 << 4)), b1 = *reinterpret_cast<const i32x4v*>(rb + 32 * 256 + ((c0 ^ 1) << 4));
                  const i32x8 A0 = __builtin_shufflevector(a0, a1, 0, 1, 2, 3, 4, 5, 6, 7), A1 = __builtin_shufflevector(b0, b1, 0, 1, 2, 3, 4, 5, 6, 7);
                  p0 = __builtin_amdgcn_mfma_scale_f32_32x32x64_f8f6f4(A0, qf[g], p0, 0, 0, 0, 0x7f7f7f7f, 0, 0x7f7f7f7f);
                  p1 = __builtin_amdgcn_mfma_scale_f32_32x32x64_f8f6f4(A1, qf[g], p1, 0, 0, 0, 0x7f7f7f7f, 0, 0x7f7f7f7f); } }
            if (!J.nomask && (kbase + KVBLK - 1 > J.wq_lo || kbase <= J.wq_lo + QBLK - 1 - (int)J.W)) mask_tile(p0, p1, J.qpos - 4 * hi - kbase, J.W);
            {
                float pmax = p0[0];
#pragma unroll
                for (int r = 1; r < 16; ++r) pmax = fmaxf(pmax, p0[r]);
#pragma unroll
                for (int r = 0; r < 16; ++r) pmax = fmaxf(pmax, p1[r]);
                pmax = max32(pmax);
                float mn;
                if (__builtin_expect(__all((pmax - m_reg) * J.sc <= 5.f), 1)) { mn = m_reg; alpha = 1.f; }
                else { mn = fmaxf(m_reg, pmax); alpha = __builtin_amdgcn_exp2f((m_reg - mn) * J.c2); m_reg = mn; }
                const float mnL = -mn * J.c2; float ps = 0.f;
#pragma unroll
                for (int r = 0; r < 16; ++r) { p0[r] = __builtin_amdgcn_exp2f(fmaf(p0[r], J.c2, mnL)); ps += p0[r]; }
#pragma unroll
                for (int r = 0; r < 16; ++r) { p1[r] = __builtin_amdgcn_exp2f(fmaf(p1[r], J.c2, mnL)); ps += p1[r]; }
                ps = sum32(ps); l_reg = l_reg * alpha + ps; }
            if (__any(alpha < 1.f)) { if (hi == 0) al_l[r32] = alpha; asm volatile("s_waitcnt lgkmcnt(0)" ::: "memory");
#pragma unroll
                for (int d_ = 0; d_ < DV / 32; ++d_)
#pragma unroll
                    for (int r = 0; r < 16; ++r) o[d_][r] *= al_l[crow(r, hi)]; }
            i32x8 P8;
#pragma unroll
            for (int q4 = 0; q4 < 4; ++q4) { P8[q4] = (int)pg8::pk4_fp8(p0[4 * q4], p0[4 * q4 + 1], p0[4 * q4 + 2], p0[4 * q4 + 3]); P8[4 + q4] = (int)pg8::pk4_fp8(p1[4 * q4], p1[4 * q4 + 1], p1[4 * q4 + 2], p1[4 * q4 + 3]); }
            SBAR();
            { const char* vb = V_lds + bf * VB8 + r32 * 64; const int c0 = (2 * hi) ^ swv;
#pragma unroll
              for (int d0 = 0; d0 < DV / 32; ++d0) { const i32x4v x0 = *reinterpret_cast<const i32x4v*>(vb + d0 * 32 * 64 + (c0 << 4)), x1 = *reinterpret_cast<const i32x4v*>(vb + d0 * 32 * 64 + ((c0 ^ 1) << 4));
                  o[d0] = __builtin_amdgcn_mfma_scale_f32_32x32x64_f8f6f4(P8, __builtin_shufflevector(x0, x1, 0, 1, 2, 3, 4, 5, 6, 7), o[d0], 0, 0, 0, 0x7f7f7f7f, 0, 0x7f7f7f7f); } }
        }
        asm volatile("s_waitcnt vmcnt(0)" ::: "memory");
        __syncthreads();
    }
#undef LOADT9
}
template <int DV>
__device__ __forceinline__ void attn_core_kv8x2(__attribute__((address_space(3))) unsigned char* lds3, const Job& J, const Job8v& J8, const i32x8* qf, f32x16* o, float& m_reg, float& l_reg) {
    constexpr int KB8 = KVBLK * 256, VB8 = DV * 64, KB2 = 2 * KB8, VB2 = 2 * VB8;
    static_assert(DV == 128, "one LDS-DMA instruction per wave fills the 128 x 64 B V^T tile");
    char* lds = (char*)lds3;
    int wid = J.wave; asm volatile("" : "+s"(wid)); int tid = wid * 64 + lane_id(); asm volatile("" : "+v"(tid));
    const int lane = tid & 63, r32 = lane & 31, hi = lane >> 5;
    char* V_lds = lds + LDS_V; char* K_lds = lds + LDS_K;
    float* al_l = (float*)(lds + LDS_WS) + wid * 64 + 32;
    const unsigned char* ksrc[2]; long kld[2]; const unsigned char* vsrc;
#pragma unroll
    for (int i = 0; i < 2; ++i) { const int q = (wid * 2 + i) * 64 + lane, row = q >> 4, pos = q & 15; int c = pos ^ (row & 15); if (c > 11) c = 11;
        if (c >= 8) { ksrc[i] = J8.Kr + (long)row * 64 + (c - 8) * 16; kld[i] = 64; } else { ksrc[i] = J8.Kn + (long)row * 1024 + c * 16; kld[i] = 1024; } }
    { const int q = wid * 64 + lane, row = q >> 2, pos = q & 3, c = pos ^ ((row >> 2) & 3); vsrc = J8.Vt + (long)row * J8.ldvt + c * 16; }
#define LOADT9(j, bf) do { _Pragma("unroll") for (int sb = 0; sb < 2; ++sb) { const long kb_ = (long)(2 * (j) + sb) * KVBLK; \
        _Pragma("unroll") for (int i = 0; i < 2; ++i) __builtin_amdgcn_global_load_lds((const unsigned*)(ksrc[i] + kb_ * kld[i]), (__attribute__((address_space(3))) unsigned*)(lds3 + LDS_K + (bf) * KB2 + sb * KB8 + (wid * 2 + i) * 1024), 16, 0, 0); \
        __builtin_amdgcn_global_load_lds((const unsigned*)(vsrc + kb_), (__attribute__((address_space(3))) unsigned*)(lds3 + LDS_V + (bf) * VB2 + sb * VB8 + wid * 1024), 16, 0, 0); } } while (0)
    m_reg = J.m0; l_reg = J.l0;
#pragma unroll
    for (int d = 0; d < DV / 32; ++d) o[d] = f32x16{};
    const int NT = (J.j_hi - J.j_lo) >> 1;
    LOADT9(0, 0); asm volatile("s_waitcnt vmcnt(0)" ::: "memory"); __syncthreads();
    const int swv = (r32 >> 2) & 3;
    for (int t = 0; t < NT; ++t) {
        const int bf = t & 1;
        if (t + 1 < NT) LOADT9(t + 1, bf ^ 1);
#pragma unroll
        for (int sb = 0; sb < 2; ++sb) { const int kbase = (2 * t + sb) * KVBLK;
        const bool act = J.nomask || ((kbase <= J.wq_lo + QBLK - 1) && (kbase + KVBLK - 1 >= J.wq_lo - (int)J.W + 1));
        if (act) {
            f32x16 p0 = f32x16{}, p1 = f32x16{}; float alpha;
            { const char* rb = K_lds + bf * KB2 + sb * KB8 + r32 * 256; const int sw = r32 & 15;
#pragma unroll
              for (int g = 0; g < 3; ++g) { const int c0 = (4 * g + 2 * hi) ^ sw;
                  const i32x4v a0 = *reinterpret_cast<const i32x4v*>(rb + (c0 << 4)), a1 = *reinterpret_cast<const i32x4v*>(rb + ((c0 ^ 1) << 4));
                  const i32x4v b0 = *reinterpret_cast<const i32x4v*>(rb + 32 * 256 + (c0 << 4)), b1 = *reinterpret_cast<const i32x4v*>(rb + 32 * 256 + ((c0 ^ 1) << 4));
                  const i32x8 A0 = __builtin_shufflevector(a0, a1, 0, 1, 2, 3, 4, 5, 6, 7), A1 = __builtin_shufflevector(b0, b1, 0, 1, 2, 3, 4, 5, 6, 7);
                  p0 = __builtin_amdgcn_mfma_scale_f32_32x32x64_f8f6f4(A0, qf[g], p0, 0, 0, 0, 0x7f7f7f7f, 0, 0x7f7f7f7f);
                  p1 = __builtin_amdgcn_mfma_scale_f32_32x32x64_f8f6f4(A1, qf[g], p1, 0, 0, 0, 0x7f7f7f7f, 0, 0x7f7f7f7f); } }
            if (!J.nomask && (kbase + KVBLK - 1 > J.wq_lo || kbase <= J.wq_lo + QBLK - 1 - (int)J.W)) mask_tile(p0, p1, J.qpos - 4 * hi - kbase, J.W);
            {
                float pmax = p0[0];
#pragma unroll
                for (int r = 1; r < 16; ++r) pmax = fmaxf(pmax, p0[r]);
#pragma unroll
                for (int r = 0; r < 16; ++r) pmax = fmaxf(pmax, p1[r]);
                pmax = max32(pmax);
                float mn;
                if (__builtin_expect(__all((pmax - m_reg) * J.sc <= 5.f), 1)) { mn = m_reg; alpha = 1.f; }
                else { mn = fmaxf(m_reg, pmax); alpha = __builtin_amdgcn_exp2f((m_reg - mn) * J.c2); m_reg = mn; }
                const float mnL = -mn * J.c2; float ps = 0.f;
#pragma unroll
                for (int r = 0; r < 16; ++r) { p0[r] = __builtin_amdgcn_exp2f(fmaf(p0[r], J.c2, mnL)); ps += p0[r]; }
#pragma unroll
                for (int r = 0; r < 16; ++r) { p1[r] = __builtin_amdgcn_exp2f(fmaf(p1[r], J.c2, mnL)); ps += p1[r]; }
                ps = sum32(ps); l_reg = l_reg * alpha + ps; }
            if (__any(alpha < 1.f)) { if (hi == 0) al_l[r32] = alpha; asm volatile("s_waitcnt lgkmcnt(0)" ::: "memory");
#pragma unroll
                for (int d_ = 0; d_ < DV / 32; ++d_)
#pragma unroll
                    for (int r = 0; r < 16; ++r) o[d_][r] *= al_l[crow(r, hi)]; }
            i32x8 P8;
#pragma unroll
            for (int q4 = 0; q4 < 4; ++q4) { P8[q4] = (int)pg8::pk4_fp8(p0[4 * q4], p0[4 * q4 + 1], p0[4 * q4 + 2], p0[4 * q4 + 3]); P8[4 + q4] = (int)pg8::pk4_fp8(p1[4 * q4], p1[4 * q4 + 1], p1[4 * q4 + 2], p1[4 * q4 + 3]); }
            SBAR();
            { const char* vb = V_lds + bf * VB2 + sb * VB8 + r32 * 64; const int c0 = (2 * hi) ^ swv;
#pragma unroll
              for (int d0 = 0; d0 < DV / 32; ++d0) { const i32x4v x0 = *reinterpret_cast<const i32x4v*>(vb + d0 * 32 * 64 + (c0 << 4)), x1 = *reinterpret_cast<const i32x4v*>(vb + d0 * 32 * 64 + ((c0 ^ 1) << 4));
                  o[d0] = __builtin_amdgcn_mfma_scale_f32_32x32x64_f8f6f4(P8, __builtin_shufflevector(x0, x1, 0, 1, 2, 3, 4, 5, 6, 7), o[d0], 0, 0, 0, 0x7f7f7f7f, 0, 0x7f7f7f7f); } }
        } }
        asm volatile("s_waitcnt vmcnt(0)" ::: "memory");
        __syncthreads();
    }
#undef LOADT9
}
template <int DV, bool CONTIG>
__device__ __forceinline__ void store_o(__attribute__((address_space(3))) unsigned char* lds3, const f32x16* o, float l_reg, bf16_t* Ob, long ldo, int wave, int ws_off = LDS_WS, int rt_off = LDS_OTAB) {
    char* lds = (char*)lds3; int wid = wave; asm volatile("" : "+s"(wid)); int tid = wid * 64 + lane_id(); asm volatile("" : "+v"(tid));
    const int lane = tid & 63, r32 = lane & 31, hi = lane >> 5;
    float* li_l = (float*)(lds + ws_off) + wid * 64; const int* rtab = (const int*)(lds + rt_off) + wid * 32;
    if (hi == 0) li_l[r32] = l_reg; asm volatile("s_waitcnt lgkmcnt(0)" ::: "memory");
#pragma unroll
    for (int r = 0; r < 16; ++r) { const int orow = crow(r, hi); const float rl = __builtin_amdgcn_rcpf(li_l[orow]);
        long drow = orow; if (!CONTIG) drow = rtab[orow];
#pragma unroll
        for (int d0 = 0; d0 < DV / 32; ++d0) { const float v = o[d0][r] * rl; const float vn = shx<1>(v);
            if ((r32 & 1) == 0 && drow >= 0) *(unsigned*)(Ob + drow * ldo + d0 * 32 + r32) = cvtpk(v, vn); } }
}

__device__ __forceinline__ void store_o_staged(__attribute__((address_space(3))) unsigned char* lds3, const f32x16* o, float l_reg, bf16_t* Ob, int ws_off, int rt_off, int st_off, int wave) {
    char* lds = (char*)lds3; int wid = wave; asm volatile("" : "+s"(wid)); int tid = wid * 64 + lane_id(); asm volatile("" : "+v"(tid));
    const int lane = tid & 63, r32 = lane & 31, hi = lane >> 5;
    float* li_l = (float*)(lds + ws_off) + wid * 64; const int* rtab = (const int*)(lds + rt_off) + wid * 32; bf16_t* stg = (bf16_t*)(lds + st_off) + wid * 1024;
    if (hi == 0) li_l[r32] = l_reg; asm volatile("s_waitcnt lgkmcnt(0)" ::: "memory");
    float rl[16];
#pragma unroll
    for (int r = 0; r < 16; ++r) rl[r] = __builtin_amdgcn_rcpf(li_l[crow(r, hi)]);
    const int rowA = lane >> 2, ch = lane & 3; const long dA = rtab[rowA], dB = rtab[rowA + 16];
#pragma unroll
    for (int d0 = 0; d0 < 4; ++d0) {
#pragma unroll
        for (int r = 0; r < 16; ++r) { const float v = o[d0][r] * rl[r]; const float vn = shx<1>(v); if ((r32 & 1) == 0) *(unsigned*)(stg + crow(r, hi) * 32 + r32) = cvtpk(v, vn); }
        asm volatile("s_waitcnt lgkmcnt(0)" ::: "memory");
        const u32x4 va = *(const u32x4*)(stg + rowA * 32 + ch * 8), vb = *(const u32x4*)(stg + (rowA + 16) * 32 + ch * 8);
        if (dA >= 0) *(u32x4*)(Ob + dA * 128 + d0 * 32 + ch * 8) = va;
        if (dB >= 0) *(u32x4*)(Ob + dB * 128 + d0 * 32 + ch * 8) = vb;
        asm volatile("s_waitcnt lgkmcnt(0)" ::: "memory");
    }
}

__device__ __forceinline__ void store_o_staged8(__attribute__((address_space(3))) unsigned char* lds3, const f32x16* o, float l_reg, unsigned char* Ob, int ws_off, int rt_off, int st_off, int wave) {
    char* lds = (char*)lds3; int wid = wave; asm volatile("" : "+s"(wid)); int tid = wid * 64 + lane_id(); asm volatile("" : "+v"(tid));
    const int lane = tid & 63, r32 = lane & 31, hi = lane >> 5;
    float* li_l = (float*)(lds + ws_off) + wid * 64; const int* rtab = (const int*)(lds + rt_off) + wid * 32; unsigned char* stg = (unsigned char*)(lds + st_off) + wid * 2048;
    if (hi == 0) li_l[r32] = l_reg; asm volatile("s_waitcnt lgkmcnt(0)" ::: "memory");
    float rl[16];
#pragma unroll
    for (int r = 0; r < 16; ++r) rl[r] = 16.f * __builtin_amdgcn_rcpf(li_l[crow(r, hi)]);
    const int rowA = lane >> 2, ch = lane & 3; const long dA = rtab[rowA], dB = rtab[rowA + 16];
#pragma unroll
    for (int hf = 0; hf < 2; ++hf) {
#pragma unroll
        for (int dl = 0; dl < 2; ++dl)
#pragma unroll
            for (int r = 0; r < 16; ++r) { const float v = o[2 * hf + dl][r] * rl[r]; const float vn = shx<1>(v);
                if ((r32 & 1) == 0) *(unsigned short*)(stg + crow(r, hi) * 64 + dl * 32 + r32) = (unsigned short)__builtin_amdgcn_cvt_pk_fp8_f32(v, vn, 0, false); }
        asm volatile("s_waitcnt lgkmcnt(0)" ::: "memory");
        const u32x4 va = *(const u32x4*)(stg + rowA * 64 + ch * 16), vb = *(const u32x4*)(stg + (rowA + 16) * 64 + ch * 16);
        if (dA >= 0) *(u32x4*)(Ob + dA * 128 + hf * 64 + ch * 16) = va;
        if (dB >= 0) *(u32x4*)(Ob + dB * 128 + hf * 64 + ch * 16) = vb;
        asm volatile("s_waitcnt lgkmcnt(0)" ::: "memory");
    }
}

__device__ __forceinline__ void chunk_resident(__attribute__((address_space(3))) unsigned char* lds3, int k_off, int v_off, int ws_off, int ntile, bool causal, int wq_lo, int qrel,
                                               float sc, float c2, const bf16x8* qr, f32x16* o, float& m_reg, float& l_reg, int wave) {
    char* lds = (char*)lds3; int wid = wave; asm volatile("" : "+s"(wid)); int tid = wid * 64 + lane_id(); asm volatile("" : "+v"(tid));
    const int lane = tid & 63, r32 = lane & 31, hi = lane >> 5;
    float* al_l = (float*)(lds + ws_off) + wid * 64 + 32;
    const int vb0 = (int)(uintptr_t)(lds + v_off) + v_rd_base(lane);
    m_reg = -1e30f; l_reg = 0.f;
#pragma unroll
    for (int d = 0; d < 4; ++d) o[d] = f32x16{};
    for (int t = 0; t < ntile; ++t) {
        f32x16 p0, p1; bf16x8 pa0, pa1, pa2, pa3; float alpha;
        qkt<128>(p0, p1, lds + k_off + t * 16384, r32, hi, qr);
        if (causal && (t * KVBLK + KVBLK - 1 > wq_lo)) mask_tile(p0, p1, qrel - 4 * hi - t * KVBLK, 1u << 30);
        partialSM(p0, p1, m_reg, alpha, sc, c2);
        if (__any(alpha < 1.f)) { if (hi == 0) al_l[r32] = alpha; asm volatile("s_waitcnt lgkmcnt(0)" ::: "memory");
#pragma unroll
            for (int d_ = 0; d_ < 4; ++d_)
#pragma unroll
                for (int r = 0; r < 16; ++r) o[d_][r] *= al_l[crow(r, hi)]; }
        finishSM(p0, p1, alpha, l_reg, pa0, pa1, pa2, pa3); SBAR();
        pv_tile<128>(o, vb0 + t * 16384, pa0, pa1, pa2, pa3);
    }
}

__device__ __forceinline__ void chunk_resident8(__attribute__((address_space(3))) unsigned char* lds3, int k_off, int v_off, int ws_off, int ntile, bool causal, int wq_lo, int qrel,
                                                float sc, float c2, const i32x8* qf, f32x16* o, float& m_reg, float& l_reg, int wave) {
    char* lds = (char*)lds3; int wid = wave; asm volatile("" : "+s"(wid)); int tid = wid * 64 + lane_id(); asm volatile("" : "+v"(tid));
    const int lane = tid & 63, r32 = lane & 31, hi = lane >> 5;
    float* al_l = (float*)(lds + ws_off) + wid * 64 + 32;
    const int vb0 = (int)(uintptr_t)(lds + v_off) + v_rd_base(lane);
    m_reg = -1e30f; l_reg = 0.f;
#pragma unroll
    for (int d = 0; d < 4; ++d) o[d] = f32x16{};
    const int sw = (r32 >> 1) & 7;
    for (int t = 0; t < ntile; ++t) {
        f32x16 p0 = f32x16{}, p1 = f32x16{}; bf16x8 pa0, pa1, pa2, pa3; float alpha;
        { const char* rb = lds + k_off + t * 8192 + r32 * 128;
#pragma unroll
          for (int g = 0; g < 2; ++g) { const int c0 = (4 * g + 2 * hi) ^ sw;
              const i32x4v a0 = *reinterpret_cast<const i32x4v*>(rb + (c0 << 4)), a1 = *reinterpret_cast<const i32x4v*>(rb + ((c0 ^ 1) << 4));
              const i32x4v b0 = *reinterpret_cast<const i32x4v*>(rb + 32 * 128 + (c0 << 4)), b1 = *reinterpret_cast<const i32x4v*>(rb + 32 * 128 + ((c0 ^ 1) << 4));
              const i32x8 A0 = __builtin_shufflevector(a0, a1, 0, 1, 2, 3, 4, 5, 6, 7), A1 = __builtin_shufflevector(b0, b1, 0, 1, 2, 3, 4, 5, 6, 7);
              p0 = __builtin_amdgcn_mfma_scale_f32_32x32x64_f8f6f4(A0, qf[g], p0, 0, 0, 0, 0x7f7f7f7f, 0, 0x7f7f7f7f);
              p1 = __builtin_amdgcn_mfma_scale_f32_32x32x64_f8f6f4(A1, qf[g], p1, 0, 0, 0, 0x7f7f7f7f, 0, 0x7f7f7f7f); } }
        if (causal && (t * KVBLK + KVBLK - 1 > wq_lo)) mask_tile(p0, p1, qrel - 4 * hi - t * KVBLK, 1u << 30);
        partialSM(p0, p1, m_reg, alpha, sc, c2);
        if (__any(alpha < 1.f)) { if (hi == 0) al_l[r32] = alpha; asm volatile("s_waitcnt lgkmcnt(0)" ::: "memory");
#pragma unroll
            for (int d_ = 0; d_ < 4; ++d_)
#pragma unroll
                for (int r = 0; r < 16; ++r) o[d_][r] *= al_l[crow(r, hi)]; }
        finishSM(p0, p1, alpha, l_reg, pa0, pa1, pa2, pa3); SBAR();
        pv_tile<128>(o, vb0 + t * 16384, pa0, pa1, pa2, pa3);
    }
}

__device__ __forceinline__ void chunk_resident_kv8(__attribute__((address_space(3))) unsigned char* lds3, int k_off, int v_off, int ws_off, int ntile, bool causal, int wq_lo, int qrel,
                                                   float sc, float c2, const i32x8* qf, f32x16* o, float& m_reg, float& l_reg, int wave) {
    char* lds = (char*)lds3; int wid = wave; asm volatile("" : "+s"(wid)); int tid = wid * 64 + lane_id(); asm volatile("" : "+v"(tid));
    const int lane = tid & 63, r32 = lane & 31, hi = lane >> 5;
    float* al_l = (float*)(lds + ws_off) + wid * 64 + 32;
    m_reg = -1e30f; l_reg = 0.f;
#pragma unroll
    for (int d = 0; d < 4; ++d) o[d] = f32x16{};
    const int sw = (r32 >> 1) & 7, swv = (r32 >> 2) & 3;
    for (int t = 0; t < ntile; ++t) {
        f32x16 p0 = f32x16{}, p1 = f32x16{}; float alpha;
        { const char* rb = lds + k_off + t * 8192 + r32 * 128;
#pragma unroll
          for (int g = 0; g < 2; ++g) { const int c0 = (4 * g + 2 * hi) ^ sw;
              const i32x4v a0 = *reinterpret_cast<const i32x4v*>(rb + (c0 << 4)), a1 = *reinterpret_cast<const i32x4v*>(rb + ((c0 ^ 1) << 4));
              const i32x4v b0 = *reinterpret_cast<const i32x4v*>(rb + 32 * 128 + (c0 << 4)), b1 = *reinterpret_cast<const i32x4v*>(rb + 32 * 128 + ((c0 ^ 1) << 4));
              const i32x8 A0 = __builtin_shufflevector(a0, a1, 0, 1, 2, 3, 4, 5, 6, 7), A1 = __builtin_shufflevector(b0, b1, 0, 1, 2, 3, 4, 5, 6, 7);
              p0 = __builtin_amdgcn_mfma_scale_f32_32x32x64_f8f6f4(A0, qf[g], p0, 0, 0, 0, 0x7f7f7f7f, 0, 0x7f7f7f7f);
              p1 = __builtin_amdgcn_mfma_scale_f32_32x32x64_f8f6f4(A1, qf[g], p1, 0, 0, 0, 0x7f7f7f7f, 0, 0x7f7f7f7f); } }
        if (causal && (t * KVBLK + KVBLK - 1 > wq_lo)) mask_tile(p0, p1, qrel - 4 * hi - t * KVBLK, 1u << 30);
        { float pmax = p0[0];
#pragma unroll
          for (int r = 1; r < 16; ++r) pmax = fmaxf(pmax, p0[r]);
#pragma unroll
          for (int r = 0; r < 16; ++r) pmax = fmaxf(pmax, p1[r]);
          pmax = max32(pmax);
          float mn;
          if (__builtin_expect(__all((pmax - m_reg) * sc <= 5.f), 1)) { mn = m_reg; alpha = 1.f; }
          else { mn = fmaxf(m_reg, pmax); alpha = __builtin_amdgcn_exp2f((m_reg - mn) * c2); m_reg = mn; }
          const float mnL = -mn * c2; float ps = 0.f;
#pragma unroll
          for (int r = 0; r < 16; ++r) { p0[r] = __builtin_amdgcn_exp2f(fmaf(p0[r], c2, mnL)); ps += p0[r]; }
#pragma unroll
          for (int r = 0; r < 16; ++r) { p1[r] = __builtin_amdgcn_exp2f(fmaf(p1[r], c2, mnL)); ps += p1[r]; }
          ps = sum32(ps); l_reg = l_reg * alpha + ps; }
        if (__any(alpha < 1.f)) { if (hi == 0) al_l[r32] = alpha; asm volatile("s_waitcnt lgkmcnt(0)" ::: "memory");
#pragma unroll
            for (int d_ = 0; d_ < 4; ++d_)
#pragma unroll
                for (int r = 0; r < 16; ++r) o[d_][r] *= al_l[crow(r, hi)]; }
        i32x8 P8;
#pragma unroll
        for (int q4 = 0; q4 < 4; ++q4) { P8[q4] = (int)pg8::pk4_fp8(p0[4 * q4], p0[4 * q4 + 1], p0[4 * q4 + 2], p0[4 * q4 + 3]); P8[4 + q4] = (int)pg8::pk4_fp8(p1[4 * q4], p1[4 * q4 + 1], p1[4 * q4 + 2], p1[4 * q4 + 3]); }
        SBAR();
        { const char* vb = lds + v_off + t * 8192 + r32 * 64; const int c0 = (2 * hi) ^ swv;
#pragma unroll
          for (int d0 = 0; d0 < 4; ++d0) { const i32x4v x0 = *reinterpret_cast<const i32x4v*>(vb + d0 * 32 * 64 + (c0 << 4)), x1 = *reinterpret_cast<const i32x4v*>(vb + d0 * 32 * 64 + ((c0 ^ 1) << 4));
              o[d0] = __builtin_amdgcn_mfma_scale_f32_32x32x64_f8f6f4(P8, __builtin_shufflevector(x0, x1, 0, 1, 2, 3, 4, 5, 6, 7), o[d0], 0, 0, 0, 0x7f7f7f7f, 0, 0x7f7f7f7f); } }
    }
}
#undef SBAR
}

#define GAS __attribute__((address_space(1)))
#define LAS __attribute__((address_space(3)))
typedef unsigned short bf16;
typedef unsigned v4u __attribute__((ext_vector_type(4)));
typedef float f32x4 __attribute__((ext_vector_type(4)));
typedef short bf16x8 __attribute__((ext_vector_type(8)));
typedef GAS unsigned gu32;
typedef GAS unsigned long long gu64;
#define RLX_AGENT __ATOMIC_RELAXED, __HIP_MEMORY_SCOPE_AGENT
#define LDS_WAIT() asm volatile("s_waitcnt lgkmcnt(0)" ::: "memory")
#define VM_WAIT() asm volatile("s_waitcnt vmcnt(0)" ::: "memory")
__device__ __forceinline__ unsigned long long rt() { return __builtin_amdgcn_s_memrealtime(); }
__device__ __forceinline__ unsigned f2bf(float f) { unsigned u = __builtin_bit_cast(unsigned, f); return (u + 0x7fffu + ((u >> 16) & 1u)) >> 16; }
__device__ __forceinline__ unsigned pk2(float lo, float hi) { return f2bf(lo) | (f2bf(hi) << 16); }

#define XB_TMO      128
#define XB_XCNT(j)  (256  + 64 * (j))
#define XB_XSUB(j)  (1280 + 64 * (j))
#define XB_XGEN(j)  (2304 + 64 * (j))
#define XB_TOP      3328
#define XB_TOPGEN   3392
#define XCD_BAR_WORDS 3456
#define XB_SPIN_CAP (1u << 18)

__device__ __forceinline__ unsigned xb_ld(unsigned* p)              { return __hip_atomic_load(p, __ATOMIC_RELAXED, __HIP_MEMORY_SCOPE_AGENT); }
__device__ __forceinline__ unsigned xb_add(unsigned* p, unsigned v) { return __hip_atomic_fetch_add(p, v, __ATOMIC_RELAXED, __HIP_MEMORY_SCOPE_AGENT); }
__device__ __forceinline__ unsigned xb_xcc_id() { return (unsigned)__builtin_amdgcn_s_getreg((3 << 11) | 20) & 0xFu; }
#define XB_SPIN(cond, bar) do { unsigned _sp = 0; while (cond) { __builtin_amdgcn_s_sleep(1); \
    if ((++_sp & 255u) == 0u) { if (xb_ld(&(bar)[XB_TMO])) break; if (_sp > XB_SPIN_CAP) { atomicAdd(&(bar)[XB_TMO], 1u); break; } } } } while (0)

struct XcdBarrier {
    unsigned* bar; unsigned x;
    volatile LAS unsigned* st;
};

__device__ __forceinline__ XcdBarrier xcd_barrier_post(unsigned* bar, volatile LAS unsigned* st) {
    XcdBarrier b; b.bar = bar; b.x = xb_xcc_id(); b.st = st;
    if (threadIdx.x == 0) (void)xb_add(&bar[XB_XCNT(b.x)], 1u);
    return b;
}
__device__ __forceinline__ void xcd_barrier_complete(unsigned* bar, unsigned x, unsigned& nloc, unsigned& nx) {
    const unsigned G = gridDim.x * gridDim.y * gridDim.z;
    unsigned sum, cnt, mine, sp = 0u;
    for (;;) {
        sum = 0u; cnt = 0u; mine = 0u;
#pragma unroll
        for (unsigned j = 0; j < 16; ++j) { const unsigned c = xb_ld(&bar[XB_XCNT(j)]); sum += c; cnt += (c > 0u) ? 1u : 0u; mine = (j == x) ? c : mine; }
        if (sum == G) break;
        __builtin_amdgcn_s_sleep(1);
        if ((++sp & 255u) == 0u) { if (xb_ld(&bar[XB_TMO])) break; if (sp > XB_SPIN_CAP) { atomicAdd(&bar[XB_TMO], 1u); break; } }
    }
    nloc = mine > 0u ? mine : 1u; nx = cnt > 0u ? cnt : 1u;
}

__device__ __forceinline__ void xcd_barrier(const XcdBarrier& b) {
    asm volatile("s_waitcnt vmcnt(0)" ::: "memory");
    __syncthreads();
    if (threadIdx.x == 0) {
        unsigned oz_; asm volatile("s_mov_b32 %0, 0" : "=s"(oz_));
        unsigned* bar = b.bar + oz_; const unsigned bx = (unsigned)__builtin_amdgcn_readfirstlane((int)b.x) + oz_;
        __builtin_amdgcn_s_waitcnt(0);
        unsigned nloc = b.st[0], nx = b.st[1];
        if (nloc == 0u) { xcd_barrier_complete(bar, bx, nloc, nx); b.st[0] = nloc; b.st[1] = nx; }
        const unsigned old = xb_add(&bar[XB_XSUB(bx)], 1u);
        const unsigned gen = old / nloc;
        if (old + 1u == (gen + 1u) * nloc) {
            __builtin_amdgcn_fence(__ATOMIC_RELEASE, "agent");
            asm volatile("s_waitcnt vmcnt(0)" ::: "memory");
            const unsigned og = xb_add(&bar[XB_TOP], 1u);
            const unsigned tg = og / nx;
            if (og + 1u == (tg + 1u) * nx) xb_add(&bar[XB_TOPGEN], 1u);
            else XB_SPIN(xb_ld(&bar[XB_TOPGEN]) == tg, bar);
            __builtin_amdgcn_fence(__ATOMIC_ACQUIRE, "agent");
            xb_add(&bar[XB_XGEN(bx)], 1u);
            asm volatile("s_waitcnt vmcnt(0)" ::: "memory");
        } else {
            XB_SPIN(xb_ld(&bar[XB_XGEN(bx)]) == gen, bar);
            __builtin_amdgcn_fence(__ATOMIC_ACQUIRE, "agent");
            asm volatile("s_waitcnt vmcnt(0)" ::: "memory");
        }
    }
    __syncthreads();
}

constexpr int NWAVES = 8;
constexpr int S = 16384, DM = 2048, FF = 8192, PLED = 256;
constexpr int NIN_PAD = 2560;
constexpr int SWAW = 1344;
constexpr float NORM_EPS = 1e-6f;
constexpr float W8_DOWN_SC = 128.f, W8_GATE_SC = 64.f;
#ifndef DUP_MASK
#define DUP_MASK 0
#endif
#ifndef MK_N_LAUNCHES
#define MK_N_LAUNCHES 1
#endif
constexpr size_t MiB = 1u << 20;
constexpr size_t WS_CTL = 0, CTL_ZERO_BYTES = 1 * MiB;
constexpr size_t WS_CS64 = 1 * MiB, WS_CS128 = 5 * MiB, WS_SS = 13 * MiB, WS_KM = 15 * MiB, WS_LIST = 16 * MiB, WS_PLSE = 32 * MiB, WS_PB = 36 * MiB;
constexpr size_t WS_WB = 52 * MiB, WS_XN = 160 * MiB, WS_M = 224 * MiB, WS_AR = 288 * MiB, WS_END = 555 * MiB;
constexpr size_t WB_MIX = 81 * MiB, WB_IN = WB_MIX, WB_QUP = WB_MIX + 10 * MiB, WB_KVUP = WB_QUP + 3 * MiB / 2, WB_QKV = WB_MIX;
__host__ __device__ constexpr size_t wo_up(int l) { return 52 * MiB + (size_t)l * 16 * MiB; }
__host__ __device__ constexpr size_t wo_upsc(int l) { return 52 * MiB + 107 * MiB + (size_t)l * 32768; }
__host__ __device__ constexpr size_t wo_down(int l) { return 52 * MiB + 32 * MiB + (size_t)l * 16 * MiB; }
__host__ __device__ constexpr size_t wo_gate(int l) { return 52 * MiB + 64 * MiB + (size_t)l * 4 * MiB; }
__host__ __device__ constexpr size_t wo_proj(int l) { return l ? 552 * MiB : 52 * MiB + 72 * MiB; }
__host__ __device__ constexpr size_t wo_out(int l) { return l ? 544 * MiB : 52 * MiB + 73 * MiB; }
constexpr size_t WS_CQKV = WS_AR, WS_SWAB = WS_AR + 32 * MiB, WS_Q = WS_AR + 74 * MiB, WS_KV = WS_AR + 122 * MiB;
constexpr size_t WS_VT8 = 522 * MiB;
constexpr size_t WS_K8N = WS_AR + 186 * MiB, WS_KR8 = WS_AR + 202 * MiB;
constexpr size_t WS_HID = WS_AR, WS_PP = WS_AR, WS_HG = WS_AR + 128 * MiB, WS_H16L = WS_AR + 128 * MiB;
constexpr size_t WS_SSQ = WS_PLSE;
constexpr size_t WS_ASC2 = WS_PLSE;
constexpr size_t WS_ASC = WS_KM;
constexpr size_t WS_VT8B = 124 * MiB;
constexpr size_t WS_QK8 = WS_XN;
constexpr size_t WS_QKV = WS_M, WS_PART = WS_M + 192 * MiB;
constexpr size_t WS_WQKV1 = 498 * MiB;
static_assert(WS_KV + 64 * MiB <= WS_WQKV1 && WS_HG + 64 * MiB <= WS_WQKV1 && WS_WQKV1 + 24 * MiB <= 544 * MiB && WS_HID + 128 * MiB <= WS_HG && WS_PART + 128 * MiB <= WS_END, "d_ws map");
constexpr int CW_TMO = 0, CW_BAR = 4096, CW_CNT = 131072, CW_QH = 135168;
constexpr int LIST_PER_HEAD = 516096;
__host__ __device__ __forceinline__ int list_off(int j) { return 256 * (63 * j - (j * (j - 1)) / 2); }
constexpr int RING_BYTES = 131072, LDSCTL_OFF = RING_BYTES, MISC_OFF = LDSCTL_OFF + 320, LDS_BYTES = 163840;
static_assert(att::LDS_END <= RING_BYTES, "attention scratch inside the ring region");

typedef unsigned v2u __attribute__((ext_vector_type(2)));
typedef float f32x2 __attribute__((ext_vector_type(2)));
__device__ __forceinline__ float bflo(unsigned w) { return __uint_as_float(w << 16); }
__device__ __forceinline__ float bfhi(unsigned w) { return __uint_as_float(w & 0xffff0000u); }

#define PH_TID() int wave_ = F.wave; asm volatile("" : "+s"(wave_)); int tid_ = wave_ * 64 + lane_id(); asm volatile("" : "+v"(tid_)); const int lane_ = tid_ & 63; (void)lane_; (void)wave_; \
    unsigned oz_; asm volatile("s_mov_b32 %0, 0" : "=s"(oz_)); unsigned char* wsb = F.ws + oz_; const void* const* inb = F.in + oz_; (void)wsb; (void)inb
struct Frame {
    LAS unsigned char* lds; unsigned char* ldsg; volatile LAS unsigned* MISC; gu32* ctl;
    int vcu, G, wave;
    const void* const* in; float* out; unsigned char* ws;
};
__device__ __forceinline__ float wave_sum(float v) { v += shx<1>(v); v += shx<2>(v); v += shx<4>(v); v += shx<8>(v); v += shx<16>(v); return sum32(v); }
constexpr int X_WS = MISC_OFF + 128;
__device__ __forceinline__ void place_cols(int mode, int n0, int& r0, int& rs) {
    r0 = n0; rs = 1;
    if (mode == 1) { int sec, base, rope = 1;
        if (n0 < 1024) { sec = 0; base = 0; rope = 0; } else if (n0 < 1088) { sec = 1024; base = 2304; } else if (n0 < 2112) { sec = 1088; base = 1024; } else if (n0 < 2240) { sec = 2112; base = 2048; } else { sec = 2240; base = 2176; rope = 0; }
        const int d = n0 - sec;
        if (!rope) { r0 = base + d; } else { const int blk = d >> 6, half = (d >> 5) & 1; r0 = base + blk * 64 + half; rs = 2; } }
    else if (mode == 2) { if (n0 < 4096) { const int hb = n0 & ~127, d = n0 & 127, half = d >> 6; r0 = hb + 2 * (d - 64 * half) + half; rs = 2; } }
    else if (mode == 3) { const int hb = (n0 / 192) * 192, d = n0 - hb; if (d >= 128) { const int half = (d - 128) >> 5; r0 = hb + 128 + half; rs = 2; } }
}
__device__ __forceinline__ void transpose_item(const float* W, int K, int N, bf16* WT, int mode, LAS float* scr, int item, int lane) {
    const int nblk = N / 32, kb = item / nblk, nb = item % nblk, k0 = 64 * kb, n0 = 32 * nb; int r0, rs; place_cols(mode, n0, r0, rs);
#pragma unroll CONV_UNROLL
    for (int i = 0; i < 32; ++i) { const int kk = 2 * i + (lane >> 5); scr[kk * 33 + (lane & 31)] = W[(size_t)(k0 + kk) * N + n0 + (lane & 31)]; }
    LDS_WAIT(); asm volatile("" ::: "memory");
    const int c = lane & 7;
#pragma unroll
    for (int j = 0; j < 4; ++j) { const int n = (lane >> 3) + 8 * j; const LAS float* s = scr + (8 * c) * 33 + n;
        v4u o; o.x = pk2(s[0 * 33], s[1 * 33]); o.y = pk2(s[2 * 33], s[3 * 33]); o.z = pk2(s[4 * 33], s[5 * 33]); o.w = pk2(s[6 * 33], s[7 * 33]);
        *(GAS v4u*)(WT + (size_t)(r0 + n * rs) * K + k0 + 8 * c) = o; }
    LDS_WAIT(); asm volatile("" ::: "memory");
}
__device__ __forceinline__ void transpose_item8(const float* W, int K, int N, unsigned char* WT, float sc, LAS float* scr, int item, int lane) {
    const int nblk = N / 32, kb = item / nblk, nb = item % nblk, k0 = 64 * kb, n0 = 32 * nb;
#pragma unroll CONV_UNROLL
    for (int i = 0; i < 32; ++i) { const int kk = 2 * i + (lane >> 5); scr[kk * 33 + (lane & 31)] = W[(size_t)(k0 + kk) * N + n0 + (lane & 31)] * sc; }
    LDS_WAIT(); asm volatile("" ::: "memory");
    const int c = lane & 7;
#pragma unroll
    for (int j = 0; j < 4; ++j) { const int n = (lane >> 3) + 8 * j; const LAS float* s = scr + (8 * c) * 33 + n;
        v2u o; o.x = pg8::pk4_fp8(s[0 * 33], s[1 * 33], s[2 * 33], s[3 * 33]); o.y = pg8::pk4_fp8(s[4 * 33], s[5 * 33], s[6 * 33], s[7 * 33]);
        *(GAS v2u*)(WT + (size_t)(n0 + n) * K + k0 + 8 * c) = o; }
    LDS_WAIT(); asm volatile("" ::: "memory");
}
__device__ __forceinline__ void convert_i8_all(Frame& F) {
    PH_TID();
    LAS float* scr = (LAS float*)(F.lds + wave_ * 16384); LAS float* red = (LAS float*)(F.lds + X_WS);
    constexpr int T_UP = FF / 32, T_QKV = (QKV_I8) ? 6144 / 32 : 0, T_IN = (PROJ_I8) ? 2368 / 32 : 0, T_O1 = (OUT1_I8) ? DM / 32 : 0, T_ALL = 2 * T_UP + T_QKV + T_IN + T_O1;
    const int col = lane_ & 31, hi = lane_ >> 5;
    for (int g = F.vcu; g < T_ALL; g += F.G) {
        int t = g, N, mode; const float* W; signed char* W8; float* WSC;
        if (t < 2 * T_UP) { const int layer = t >= T_UP ? 1 : 0; t -= layer * T_UP; W = (const float*)inb[17] + (size_t)layer * DM * FF; N = FF; mode = 0; W8 = (signed char*)(wsb + wo_up(layer)); WSC = (float*)(wsb + wo_upsc(layer)); }
        else if (t < 2 * T_UP + T_QKV) { t -= 2 * T_UP; W = (const float*)inb[13]; N = 6144; mode = 2; W8 = (signed char*)(wsb + WS_WQKV1); WSC = (float*)(wsb + wo_upsc(2)); }
        else if (t < 2 * T_UP + T_QKV + T_IN) { t -= 2 * T_UP + T_QKV; W = (const float*)inb[4]; N = 2368; mode = 1; W8 = (signed char*)(wsb + WS_WB + WB_IN); WSC = (float*)(wsb + wo_upsc(3)); }
        else { t -= 2 * T_UP + T_QKV + T_IN; W = (const float*)inb[14]; N = DM; mode = 0; W8 = (signed char*)(wsb + wo_out(1)); WSC = (float*)(wsb + wo_upsc(4)); }
        const int n0 = t * 32; int r0, rs; place_cols(mode, n0, r0, rs);
        float v[128]; float m = 0.f;
        { const float* wp = W + (size_t)(wave_ * 256 + hi) * N + n0 + col; const size_t st = (size_t)2 * N;
#pragma unroll
          for (int i = 0; i < 128; ++i) v[i] = wp[i * st]; }
#pragma unroll
        for (int i = 0; i < 128; ++i) m = fmaxf(m, fabsf(v[i]));
        m = max32(m); if (lane_ < 32) red[wave_ * 32 + lane_] = m;
        __syncthreads();
        if (tid_ < 32) { float c = red[tid_];
#pragma unroll
            for (int w = 1; w < 8; ++w) c = fmaxf(c, red[w * 32 + tid_]);
            c = c > 0.f ? c : 1.f; red[256 + tid_] = 127.f / c; WSC[r0 + tid_ * rs] = c * (1.f / 127.f); }
        __syncthreads();
#pragma unroll
        for (int bq = 0; bq < 4; ++bq) { const int k0 = wave_ * 256 + 64 * bq;
#pragma unroll
            for (int i = 0; i < 32; ++i) scr[(2 * i + hi) * 33 + col] = v[32 * bq + i];
            LDS_WAIT(); asm volatile("" ::: "memory");
            const int c = lane_ & 7;
#pragma unroll
            for (int j = 0; j < 4; ++j) { const int n = (lane_ >> 3) + 8 * j; const LAS float* s = scr + (8 * c) * 33 + n; const float inv = red[256 + n]; unsigned w0 = 0u, w1 = 0u;
#pragma unroll
                for (int e = 0; e < 4; ++e) { const int q0 = (int)__builtin_rintf(s[e * 33] * inv), q1 = (int)__builtin_rintf(s[(4 + e) * 33] * inv); w0 |= ((unsigned)q0 & 0xffu) << (8 * e); w1 |= ((unsigned)q1 & 0xffu) << (8 * e); }
                *(GAS v2u*)(W8 + (size_t)(r0 + n * rs) * DM + k0 + 8 * c) = (v2u){w0, w1}; }
            LDS_WAIT(); asm volatile("" ::: "memory");
        }
        __syncthreads();
    }
}
__device__ __forceinline__ void convert_weights(Frame& F, int layer) {
    PH_TID();
    LAS float* scr = (LAS float*)(F.lds + wave_ * 16384);
    const int gw = F.vcu * NWAVES + wave_, NGW = F.G * NWAVES;
    bf16* WB = (bf16*)(wsb + WS_WB);
    const float* wdn = (const float*)inb[18] + (size_t)layer * FF * DM;
    const float* wgt = (const float*)inb[20] + (size_t)layer * DM * DM; const float* wpj = (const float*)inb[22] + (size_t)layer * PLED * DM;
    constexpr int I_DN = (FF / 64) * (DM / 32), I_G = (DM / 64) * (DM / 32), I_PJ = (PLED / 64) * (DM / 32), I_O = I_G;
    constexpr int I_IN = (PROJ_I8) ? 0 : (DM / 64) * (2368 / 32), I_QU = (512 / 64) * (1536 / 32), I_KVU = (512 / 64) * (2048 / 32), I_QKV = (DM / 64) * (6144 / 32);
    const int nmix = layer == 0 ? (I_IN + I_QU + I_KVU) : (QKV_I8 ? 0 : I_QKV);
    const int NITEMS = I_DN + I_G + I_PJ + I_O + nmix;
    for (int it = gw; it < NITEMS; it += NGW) {
        int r = it;
        if (r < I_DN) { transpose_item8(wdn, FF, DM, wsb + wo_down(layer), W8_DOWN_SC, scr, r, lane_); continue; } r -= I_DN;
        if (r < I_G) { transpose_item8(wgt, DM, DM, wsb + wo_gate(layer), W8_GATE_SC, scr, r, lane_); continue; } r -= I_G;
        if (r < I_PJ) { transpose_item(wpj, PLED, DM, (bf16*)(wsb + wo_proj(layer)), 0, scr, r, lane_); continue; } r -= I_PJ;
        if (r < I_O) { if (!(OUT1_I8) || layer == 0) transpose_item((const float*)inb[layer == 0 ? 10 : 14], DM, DM, (bf16*)(wsb + wo_out(layer)), 0, scr, r, lane_); continue; } r -= I_O;
        if (layer == 0) {
            if (r < I_IN) { transpose_item((const float*)inb[4], DM, 2368, (bf16*)((char*)WB + WB_IN), 1, scr, r, lane_); continue; } r -= I_IN;
            if (r < I_QU) { transpose_item((const float*)inb[6], 512, 1536, (bf16*)((char*)WB + WB_QUP), 3, scr, r, lane_); continue; } r -= I_QU;
            transpose_item((const float*)inb[8], 512, 2048, (bf16*)((char*)WB + WB_KVUP), 0, scr, r, lane_);
        } else {
            transpose_item((const float*)inb[13], DM, 6144, (bf16*)(wsb + WS_WQKV1), 2, scr, r, lane_);
        }
    }
    if (layer == 0) {
        GAS v4u* z = (GAS v4u*)((char*)WB + WB_IN + (size_t)2368 * DM * ((PROJ_I8) ? 1 : 2)); const int nz = 192 * DM * ((PROJ_I8) ? 1 : 2) / 16;
        for (int i = (F.vcu * NWAVES + wave_) * 64 + lane_; i < nz; i += F.G * NWAVES * 64) { z[i] = (v4u){0u, 0u, 0u, 0u}; if ((PROJ_I8) && i < 192) ((float*)(wsb + wo_upsc(3)))[2368 + i] = 0.f; }
    }
}
__device__ __forceinline__ void sincos_acc(float ang, float& sn, float& cs) {
    const double x = (double)ang, k = __builtin_rint(x * 0.6366197723675814);
    double r = __builtin_fma(-k, 1.5707963267948966, x); r = __builtin_fma(-k, 6.123233995736766e-17, r);
    const double r2 = r * r;
    double sp = -1.0 / 1307674368000.0; sp = sp * r2 + 1.0 / 6227020800.0; sp = sp * r2 - 1.0 / 39916800.0; sp = sp * r2 + 1.0 / 362880.0; sp = sp * r2 - 1.0 / 5040.0; sp = sp * r2 + 1.0 / 120.0; sp = sp * r2 - 1.0 / 6.0; sp = sp * r2 * r + r;
    double cp = 1.0 / 20922789888000.0; cp = cp * r2 - 1.0 / 87178291200.0; cp = cp * r2 + 1.0 / 479001600.0; cp = cp * r2 - 1.0 / 3628800.0; cp = cp * r2 + 1.0 / 40320.0; cp = cp * r2 - 1.0 / 720.0; cp = cp * r2 + 1.0 / 24.0; cp = cp * r2 - 0.5; cp = cp * r2 + 1.0;
    const int q = (int)(long long)k & 3;
    const double s_ = (q & 1) ? cp : sp, c_ = (q & 1) ? sp : cp;
    sn = (float)((q & 2) ? -s_ : s_); cs = (float)(((q + 1) & 2) ? -c_ : c_);
}
__device__ __forceinline__ void rms_row_to_bf16(int lane_, const float* xrow, const float* g, bf16* orow) {
    const GAS f32x4* xr = (const GAS f32x4*)xrow + lane_; const GAS f32x4* gr = (const GAS f32x4*)g + lane_;
    f32x4 v[8]; float s = 0.f;
#pragma unroll
    for (int j = 0; j < 8; ++j) { v[j] = xr[64 * j]; s += (v[j].x * v[j].x + v[j].y * v[j].y) + (v[j].z * v[j].z + v[j].w * v[j].w); }
    const float rstd = 1.f / sqrtf(wave_sum(s) * (1.f / DM) + NORM_EPS);
    GAS v2u* o8 = (GAS v2u*)orow + lane_;
#pragma unroll
    for (int j = 0; j < 8; ++j) { const f32x4 gg = gr[64 * j]; v2u w; w.x = pk2(v[j].x * rstd * gg.x, v[j].y * rstd * gg.y); w.y = pk2(v[j].z * rstd * gg.z, v[j].w * rstd * gg.w); o8[64 * j] = w; }
}
template <int MODE> __device__ __forceinline__ void p_rows(Frame& F, const float* hprev32, const bf16* hprev16, bf16* hout16, const float* gpost, const float* gnext);
__device__ __forceinline__ void p_prologue(Frame& F) {
    PH_TID();
    convert_weights(F, 0);
    convert_weights(F, 1);
    convert_i8_all(F);
    const int gt = (F.vcu * NWAVES + wave_) * 64 + lane_, NGT = F.G * NWAVES * 64;
    {
        const GAS f32x4* p4 = (const GAS f32x4*)inb[1]; GAS v4u* o = (GAS v4u*)(wsb + WS_PB); const int n = 2 * S * PLED / 8;
#pragma unroll 4
        for (int i = gt; i < n; i += NGT) { const f32x4 a = p4[2 * i], b = p4[2 * i + 1]; v4u w; w.x = pk2(a.x, a.y); w.y = pk2(a.z, a.w); w.z = pk2(b.x, b.y); w.w = pk2(b.z, b.w); o[i] = w; }
    }
    {
        const int* pos = (const int*)inb[2]; GAS f32x2* c64 = (GAS f32x2*)(wsb + WS_CS64); GAS f32x2* c128 = (GAS f32x2*)(wsb + WS_CS128);
        for (int i = gt; i < S * 96; i += NGT) { const int s = i / 96, r = i % 96; const float pf = (float)pos[s]; float sn, cs;
            if (r < 32) { const float inv = exp2f(-(float)r * (2.0f / 64.f) * 13.287712379549449f); sincos_acc(pf * inv, sn, cs); c64[s * 32 + r] = (f32x2){cs, sn}; }
            else { const int q = r - 32; const float inv = exp2f(-(float)q * (2.0f / 128.f) * 13.287712379549449f); sincos_acc(pf * inv, sn, cs); c128[s * 64 + q] = (f32x2){cs, sn}; } }
    }
#if PROJ_I8
    p_rows<3>(F, (const float*)inb[0], nullptr, nullptr, nullptr, (const float*)inb[3]);
#else
    {
        const int gw = F.vcu * NWAVES + wave_, NGW = F.G * NWAVES;
        for (int m = gw; m < S; m += NGW) rms_row_to_bf16(lane_, (const float*)inb[0] + (size_t)m * DM, (const float*)inb[3], (bf16*)(wsb + WS_XN) + (size_t)m * DM);
    }
#endif
}
#if ROWS_X16
template <int MODE>
__device__ __forceinline__ void p_rows(Frame& F, const float* hprev32, const bf16* hprev16, bf16* hout16, const float* gpost, const float* gnext) {
    PH_TID();
    const int gw = F.vcu * NWAVES + wave_, NGW = F.G * NWAVES;
    const bf16* Mb = (const bf16*)(wsb + WS_M); const float* SS = (const float*)(wsb + WS_SS); bf16* XN = (bf16*)(wsb + WS_XN);
    f32x4 gpv[8], gnv[8];
#pragma unroll
    for (int j = 0; j < 8; ++j) { gpv[j] = (f32x4){0.f, 0.f, 0.f, 0.f}; gnv[j] = gpv[j]; }
    if (MODE < 2) { const GAS f32x4* gp = (const GAS f32x4*)gpost + 2 * lane_;
#pragma unroll
        for (int j = 0; j < 8; ++j) gpv[j] = gp[128 * (j >> 1) + (j & 1)]; }
    if (MODE != 1) { const GAS f32x4* gn = (const GAS f32x4*)gnext + 2 * lane_;
#pragma unroll
        for (int j = 0; j < 8; ++j) gnv[j] = gn[128 * (j >> 1) + (j & 1)]; }
    for (int s = gw; s < S; s += NGW) {
        GAS v4u* orow = (GAS v4u*)(hout16 + (size_t)s * DM) + lane_;
        f32x4 v[8];
        if (hprev32) { const GAS f32x4* hr = (const GAS f32x4*)(hprev32 + (size_t)s * DM) + 2 * lane_;
#pragma unroll
            for (int q = 0; q < 4; ++q) { v[2 * q] = hr[128 * q]; v[2 * q + 1] = hr[128 * q + 1]; } }
        else { const GAS v4u* hr = (const GAS v4u*)(hprev16 + (size_t)s * DM) + lane_;
#pragma unroll
            for (int q = 0; q < 4; ++q) { const v4u w = hr[64 * q]; v[2 * q] = (f32x4){bflo(w.x), bfhi(w.x), bflo(w.y), bfhi(w.y)}; v[2 * q + 1] = (f32x4){bflo(w.z), bfhi(w.z), bflo(w.w), bfhi(w.w)}; } }
        if (MODE < 2) {
            float t = SS[(size_t)s * 32 + (lane_ & 31)];
            t += shx<1>(t); t += shx<2>(t); t += shx<4>(t); t += shx<8>(t); t += shx<16>(t);
            const float rstd = 1.f / sqrtf(t * (1.f / DM) + NORM_EPS);
            const GAS v4u* mr = (const GAS v4u*)(Mb + (size_t)s * DM) + lane_;
#pragma unroll
            for (int q = 0; q < 4; ++q) { const v4u w = mr[64 * q]; const f32x4 g0 = gpv[2 * q], g1 = gpv[2 * q + 1];
                v[2 * q].x += bflo(w.x) * rstd * g0.x; v[2 * q].y += bfhi(w.x) * rstd * g0.y; v[2 * q].z += bflo(w.y) * rstd * g0.z; v[2 * q].w += bfhi(w.y) * rstd * g0.w;
                v[2 * q + 1].x += bflo(w.z) * rstd * g1.x; v[2 * q + 1].y += bfhi(w.z) * rstd * g1.y; v[2 * q + 1].z += bflo(w.w) * rstd * g1.z; v[2 * q + 1].w += bfhi(w.w) * rstd * g1.w;
                v4u hw; hw.x = pk2(v[2 * q].x, v[2 * q].y); hw.y = pk2(v[2 * q].z, v[2 * q].w); hw.z = pk2(v[2 * q + 1].x, v[2 * q + 1].y); hw.w = pk2(v[2 * q + 1].z, v[2 * q + 1].w); orow[64 * q] = hw; }
        }
        if (MODE == 1) {
            GAS v2u* o8 = (GAS v2u*)((unsigned char*)XN + (size_t)s * DM) + lane_;
#pragma unroll
            for (int q = 0; q < 4; ++q) o8[64 * q] = (v2u){pg8::pk4_fp8(v[2 * q].x, v[2 * q].y, v[2 * q].z, v[2 * q].w), pg8::pk4_fp8(v[2 * q + 1].x, v[2 * q + 1].y, v[2 * q + 1].z, v[2 * q + 1].w)};
        } else {
            float ss = 0.f;
#pragma unroll
            for (int j = 0; j < 8; ++j) ss += (v[j].x * v[j].x + v[j].y * v[j].y) + (v[j].z * v[j].z + v[j].w * v[j].w);
            const float r2 = 1.f / sqrtf(wave_sum(ss) * (1.f / DM) + NORM_EPS);
            float am = 0.f;
#pragma unroll
            for (int j = 0; j < 8; ++j) { const f32x4 g = gnv[j]; v[j].x *= r2 * g.x; v[j].y *= r2 * g.y; v[j].z *= r2 * g.z; v[j].w *= r2 * g.w; am = fmaxf(fmaxf(am, fmaxf(fabsf(v[j].x), fabsf(v[j].y))), fmaxf(fabsf(v[j].z), fabsf(v[j].w))); }
            am = fmaxf(am, shx<1>(am)); am = fmaxf(am, shx<2>(am)); am = fmaxf(am, shx<4>(am)); am = fmaxf(am, shx<8>(am)); am = fmaxf(am, shx<16>(am)); am = max32(am); am = am > 0.f ? am : 1.f;
            const float inv = 127.f / am; GAS v2u* o8 = (GAS v2u*)((MODE == 2 ? wsb + WS_HG : (unsigned char*)XN) + (size_t)s * DM) + lane_;
#pragma unroll
            for (int q = 0; q < 4; ++q) { unsigned w2[2];
#pragma unroll
                for (int e = 0; e < 2; ++e) { const f32x4 x = v[2 * q + e]; const int q0 = (int)__builtin_rintf(x.x * inv), q1 = (int)__builtin_rintf(x.y * inv), q2 = (int)__builtin_rintf(x.z * inv), q3 = (int)__builtin_rintf(x.w * inv);
                    w2[e] = ((unsigned)q0 & 0xffu) | (((unsigned)q1 & 0xffu) << 8) | (((unsigned)q2 & 0xffu) << 16) | ((unsigned)q3 << 24); }
                o8[64 * q] = (v2u){w2[0], w2[1]}; }
            if (lane_ == 0) ((float*)(wsb + (MODE == 2 ? WS_ASC2 : WS_ASC)))[s] = am * (1.f / 127.f);
        }
    }
}
#else
template <int MODE>
__device__ __forceinline__ void p_rows(Frame& F, const float* hprev32, const bf16* hprev16, bf16* hout16, const float* gpost, const float* gnext) {
    PH_TID();
    const int gw = F.vcu * NWAVES + wave_, NGW = F.G * NWAVES;
    const bf16* Mb = (const bf16*)(wsb + WS_M); const float* SS = (const float*)(wsb + WS_SS); bf16* XN = (bf16*)(wsb + WS_XN);
    for (int s = gw; s < S; s += NGW) {
        GAS v2u* orow = (GAS v2u*)(hout16 + (size_t)s * DM) + lane_;
        f32x4 v[8];
        if (hprev32) { const GAS f32x4* hr = (const GAS f32x4*)(hprev32 + (size_t)s * DM) + lane_;
#pragma unroll
            for (int j = 0; j < 8; ++j) v[j] = hr[64 * j]; }
        else { const GAS v2u* hr = (const GAS v2u*)(hprev16 + (size_t)s * DM) + lane_;
#pragma unroll
            for (int j = 0; j < 8; ++j) { const v2u w = hr[64 * j]; v[j] = (f32x4){bflo(w.x), bfhi(w.x), bflo(w.y), bfhi(w.y)}; } }
        if (MODE < 2) {
            float t = SS[(size_t)s * 32 + (lane_ & 31)];
            t += shx<1>(t); t += shx<2>(t); t += shx<4>(t); t += shx<8>(t); t += shx<16>(t);
            const float rstd = 1.f / sqrtf(t * (1.f / DM) + NORM_EPS);
            const GAS v2u* mr = (const GAS v2u*)(Mb + (size_t)s * DM) + lane_; const GAS f32x4* gp = (const GAS f32x4*)gpost + lane_;
#pragma unroll
            for (int j = 0; j < 8; ++j) { const v2u w = mr[64 * j]; const f32x4 g = gp[64 * j];
                v[j].x += bflo(w.x) * rstd * g.x; v[j].y += bfhi(w.x) * rstd * g.y; v[j].z += bflo(w.y) * rstd * g.z; v[j].w += bfhi(w.y) * rstd * g.w; v2u hw; hw.x = pk2(v[j].x, v[j].y); hw.y = pk2(v[j].z, v[j].w); orow[64 * j] = hw; }
        }
        if (MODE == 1) {
            GAS unsigned* o4 = (GAS unsigned*)((unsigned char*)XN + (size_t)s * DM) + lane_;
#pragma unroll
            for (int j = 0; j < 8; ++j) o4[64 * j] = pg8::pk4_fp8(v[j].x, v[j].y, v[j].z, v[j].w);
        } else {
            float ss = 0.f;
#pragma unroll
            for (int j = 0; j < 8; ++j) ss += (v[j].x * v[j].x + v[j].y * v[j].y) + (v[j].z * v[j].z + v[j].w * v[j].w);
            const float r2 = 1.f / sqrtf(wave_sum(ss) * (1.f / DM) + NORM_EPS); const GAS f32x4* gn = (const GAS f32x4*)gnext + lane_;
            float am = 0.f;
#pragma unroll
            for (int j = 0; j < 8; ++j) { const f32x4 g = gn[64 * j]; v[j].x *= r2 * g.x; v[j].y *= r2 * g.y; v[j].z *= r2 * g.z; v[j].w *= r2 * g.w; am = fmaxf(fmaxf(am, fmaxf(fabsf(v[j].x), fabsf(v[j].y))), fmaxf(fabsf(v[j].z), fabsf(v[j].w))); }
            am = fmaxf(am, shx<1>(am)); am = fmaxf(am, shx<2>(am)); am = fmaxf(am, shx<4>(am)); am = fmaxf(am, shx<8>(am)); am = fmaxf(am, shx<16>(am)); am = max32(am); am = am > 0.f ? am : 1.f;
            const float inv = 127.f / am; GAS unsigned* o4 = (GAS unsigned*)((MODE == 2 ? wsb + WS_HG : (unsigned char*)XN) + (size_t)s * DM) + lane_;
#pragma unroll
            for (int j = 0; j < 8; ++j) { const int q0 = (int)__builtin_rintf(v[j].x * inv), q1 = (int)__builtin_rintf(v[j].y * inv), q2 = (int)__builtin_rintf(v[j].z * inv), q3 = (int)__builtin_rintf(v[j].w * inv);
                o4[64 * j] = ((unsigned)q0 & 0xffu) | (((unsigned)q1 & 0xffu) << 8) | (((unsigned)q2 & 0xffu) << 16) | ((unsigned)q3 << 24); }
            if (lane_ == 0) ((float*)(wsb + (MODE == 2 ? WS_ASC2 : WS_ASC)))[s] = am * (1.f / 127.f);
        }
    }
}
#endif
__device__ __forceinline__ void p_l0_attn(Frame& F) {
    PH_TID();
    char* lds = (char*)F.ldsg; const int r32 = lane_ & 31, hi = lane_ >> 5;
    const bf16* Q = (const bf16*)(wsb + WS_Q); const bf16* KV = (const bf16*)(wsb + WS_KV); const bf16* SW = (const bf16*)(wsb + WS_SWAB); bf16* ATT = (bf16*)(wsb + WS_XN);
    for (int it = F.vcu; it < 256; it += F.G) {
        const int hm = it >> 5, x = it & 31;
        for (int pass = 0; pass < 2; ++pass) {
            const int qb = pass ? 63 - x : x, P0 = qb * 256, s = P0 + wave_ * 32 + r32;
            att::i32x8 qf[3]; { const unsigned char* q8 = (const unsigned char*)Q + (size_t)s * 1536 + hm * 192 + hi * 32;
#pragma unroll
                for (int g = 0; g < 3; ++g) { const att::i32x4v lo = *(const att::i32x4v*)(q8 + g * 64), hi4 = *(const att::i32x4v*)(q8 + g * 64 + 16); qf[g] = __builtin_shufflevector(lo, hi4, 0, 1, 2, 3, 4, 5, 6, 7); } }
            att::Job J; J.K = KV; J.ldk = 0; J.K2 = KV; J.ldk2 = 0; J.V = KV + hm * 256 + 128; J.ldv = 2048;
            J.wave = wave_; J.j_lo = 0; J.j_hi = 4 * qb + 4; J.wq_lo = P0 + wave_ * 32; J.qpos = s; J.W = 1u << 30; J.nomask = 0; J.m0 = -1e30f; J.l0 = 0.f;
            J.sc = 0.07216878364870322f; J.c2 = 0.07216878364870322f * 1.4426950408889634f;
            att::Job8v J8; J8.Kn = wsb + WS_K8N + hm * 128; J8.Kr = wsb + WS_KR8; J8.Vt = wsb + WS_VT8 + (size_t)hm * 128 * S; J8.ldvt = S;
            att::f32x16 o[4]; float m_reg, l_reg;
            att::attn_core_kv8x2<128>(F.lds, J, J8, qf, o, m_reg, l_reg);
            att::store_o<128, true>(F.lds, o, l_reg, ATT + (size_t)(P0 + wave_ * 32) * DM + hm * 128, DM, wave_);
            __syncthreads();
        }
    }
    const float* sinks = (const float*)inb[9];
    for (int rep2_ = 0; rep2_ < ((((DUP_MASK) >> 17) & 1) ? 2 : 1); ++rep2_)
    for (int u = F.vcu; u < 1024; u += F.G) {
        const int h = u >> 6, qb = u & 63, P0 = qb * 256, s = P0 + wave_ * 32 + r32, kvh = h >> 3;
        att::bf16x8 qr[4]; const bf16* qrow = SW + (size_t)s * SWAW + h * 64 + hi * 8;
#pragma unroll
        for (int d0 = 0; d0 < 4; ++d0) qr[d0] = *(const att::bf16x8*)(qrow + d0 * 16);
        att::Job J; J.K = SW + 1024 + kvh * 64; J.ldk = SWAW; J.K2 = J.K; J.ldk2 = SWAW; J.V = SW + 1152 + kvh * 64; J.ldv = SWAW;
        J.wave = wave_; J.j_lo = qb == 0 ? 0 : 4 * qb - 2; J.j_hi = 4 * qb + 4; J.wq_lo = P0 + wave_ * 32; J.qpos = s; J.W = 128u; J.nomask = 0; J.m0 = sinks[h] * 8.f; J.l0 = 1.f;
        J.sc = 0.125f; J.c2 = 0.125f * 1.4426950408889634f;
        att::f32x16 o[2]; float m_reg, l_reg;
        att::attn_core<64, 64>(F.lds, J, qr, o, m_reg, l_reg);
        att::store_o<64, true>(F.lds, o, l_reg, ATT + (size_t)(P0 + wave_ * 32) * DM + 1024 + h * 64, DM, wave_);
        __syncthreads();
    }
}
#if GATE_MFMA
#define GATE_INS(a_, n_) { const float a__ = (a_); const int n__ = (n_); \
    if (a__ > t0 || (a__ == t0 && n__ < i0)) { t2 = t1; i2 = i1; t1 = t0; i1 = i0; t0 = a__; i0 = n__; } \
    else if (a__ > t1 || (a__ == t1 && n__ < i1)) { t2 = t1; i2 = i1; t1 = a__; i1 = n__; } \
    else if (a__ > t2 || (a__ == t2 && n__ < i2)) { t2 = a__; i2 = n__; } }
__device__ __forceinline__ void p_l1_gate(Frame& F) {
    PH_TID();
    const bf16* QKV = (const bf16*)(wsb + WS_QKV); const float* KM = (const float*)(wsb + WS_KM); unsigned short* LIST = (unsigned short*)(wsb + WS_LIST);
    unsigned* CNT = (unsigned*)(F.ctl + CW_CNT); LAS unsigned char* L = F.lds;
    LAS unsigned* lc = (LAS unsigned*)(F.lds + X_WS);
    const int r32 = lane_ & 31, hi = lane_ >> 5;
    constexpr int KROW = 272, KLO = 64 * KROW;
    for (int u = F.vcu; u < 512; u += F.G) {
        const int h = u >> 5, c = (u < 256) ? (u & 31) : 31 - (u & 31), nrows = 2 * c + 1, nr32 = (nrows + 31) & ~31;
        if (tid_ < 64) lc[tid_] = 0u;
        for (int i = tid_; i < nr32 * 32; i += NWAVES * 64) { const int n = i >> 5, c4 = i & 31; f32x4 m = (f32x4){0.f, 0.f, 0.f, 0.f};
            if (n < nrows) { const GAS f32x4* p0 = (const GAS f32x4*)(KM + (size_t)(n * 2) * 2048 + h * 128) + c4; const f32x4 a = p0[0], bb = p0[512]; m = (a + bb) * (1.f / 256.f); }
            const unsigned h0 = f2bf(m.x), h1 = f2bf(m.y), h2 = f2bf(m.z), h3 = f2bf(m.w);
            const float l0 = m.x - __uint_as_float(h0 << 16), l1 = m.y - __uint_as_float(h1 << 16), l2 = m.z - __uint_as_float(h2 << 16), l3 = m.w - __uint_as_float(h3 << 16);
            *(LAS v2u*)(L + n * KROW + c4 * 8) = (v2u){h0 | (h1 << 16), h2 | (h3 << 16)}; *(LAS v2u*)(L + KLO + n * KROW + c4 * 8) = (v2u){pk2(l0, l1), pk2(l2, l3)}; }
        __syncthreads();
        const int qb = 2 * c + (wave_ >> 2), nvalid = qb < 3 ? qb : 3;
        int sel[2][3]; unsigned lp[2][3];
#pragma unroll
        for (int qt = 0; qt < 2; ++qt) { const int s = c * 512 + wave_ * 64 + qt * 32 + r32;
            att::bf16x8 qf[8]; { const bf16* qrow = QKV + (size_t)s * 6144 + h * 128 + hi * 8;
#pragma unroll
                for (int kk = 0; kk < 8; ++kk) qf[kk] = *(const att::bf16x8*)(qrow + kk * 16); }
            att::f32x16 acc0 = att::f32x16{}, acc1 = att::f32x16{};
            { const LAS unsigned char* rb = L + r32 * KROW + hi * 16;
#pragma unroll
              for (int kk = 0; kk < 8; ++kk) { const att::bf16x8 ah = *(const LAS att::bf16x8*)(rb + kk * 32), al = *(const LAS att::bf16x8*)(rb + KLO + kk * 32);
                  acc0 = __builtin_amdgcn_mfma_f32_32x32x16_bf16(ah, qf[kk], acc0, 0, 0, 0); acc0 = __builtin_amdgcn_mfma_f32_32x32x16_bf16(al, qf[kk], acc0, 0, 0, 0); }
              if (nrows > 32) {
#pragma unroll
                  for (int kk = 0; kk < 8; ++kk) { const att::bf16x8 ah = *(const LAS att::bf16x8*)(rb + 32 * KROW + kk * 32), al = *(const LAS att::bf16x8*)(rb + 32 * KROW + KLO + kk * 32);
                      acc1 = __builtin_amdgcn_mfma_f32_32x32x16_bf16(ah, qf[kk], acc1, 0, 0, 0); acc1 = __builtin_amdgcn_mfma_f32_32x32x16_bf16(al, qf[kk], acc1, 0, 0, 0); } } }
            float t0 = -__builtin_inff(), t1 = t0, t2 = t0; int i0 = 0, i1 = 0, i2 = 0;
#pragma unroll
            for (int i = 0; i < 16; ++i) { const int n = (i & 3) + 8 * (i >> 2) + 4 * hi; GATE_INS(n < qb ? acc0[i] : -__builtin_inff(), n); }
            if (nrows > 32) {
#pragma unroll
                for (int i = 0; i < 16; ++i) { const int n = 32 + (i & 3) + 8 * (i >> 2) + 4 * hi; GATE_INS(n < qb ? acc1[i] : -__builtin_inff(), n); } }
            {
                const auto rt0 = __builtin_amdgcn_permlane32_swap(__float_as_uint(t0), __float_as_uint(t0), false, false), rt1 = __builtin_amdgcn_permlane32_swap(__float_as_uint(t1), __float_as_uint(t1), false, false), rt2 = __builtin_amdgcn_permlane32_swap(__float_as_uint(t2), __float_as_uint(t2), false, false);
                const auto ri0 = __builtin_amdgcn_permlane32_swap((unsigned)i0, (unsigned)i0, false, false), ri1 = __builtin_amdgcn_permlane32_swap((unsigned)i1, (unsigned)i1, false, false), ri2 = __builtin_amdgcn_permlane32_swap((unsigned)i2, (unsigned)i2, false, false);
                t0 = __uint_as_float(rt0[0]); t1 = __uint_as_float(rt1[0]); t2 = __uint_as_float(rt2[0]); i0 = (int)ri0[0]; i1 = (int)ri1[0]; i2 = (int)ri2[0];
                GATE_INS(__uint_as_float(rt0[1]), (int)ri0[1]); GATE_INS(__uint_as_float(rt1[1]), (int)ri1[1]); GATE_INS(__uint_as_float(rt2[1]), (int)ri2[1]); }
            sel[qt][0] = i0; sel[qt][1] = i1; sel[qt][2] = i2;
#pragma unroll
            for (int r = 0; r < 3; ++r) { lp[qt][r] = 0u; if (hi == 0 && r < nvalid) lp[qt][r] = __hip_atomic_fetch_add(lc + sel[qt][r], 1u, __ATOMIC_RELAXED, __HIP_MEMORY_SCOPE_WORKGROUP); }
        }
        __syncthreads();
        if (tid_ < 64) { const unsigned n_ = lc[tid_]; lc[64 + tid_] = n_ ? atomicAdd(CNT + h * 64 + tid_, n_) : 0u; }
        __syncthreads();
        if (hi == 0) { unsigned short* lh = LIST + (size_t)h * LIST_PER_HEAD;
#pragma unroll
            for (int qt = 0; qt < 2; ++qt) { const int s = c * 512 + wave_ * 64 + qt * 32 + r32;
#pragma unroll
                for (int r = 0; r < 3; ++r) if (r < nvalid) { const int j = sel[qt][r]; lh[list_off(j) + lc[64 + j] + lp[qt][r]] = (unsigned short)(s | (r << 14)); } } }
        __syncthreads();
    }
}
#undef GATE_INS
#else
__device__ __forceinline__ void p_l1_gate(Frame& F) {
    PH_TID();
    const bf16* QKV = (const bf16*)(wsb + WS_QKV); const float* KM = (const float*)(wsb + WS_KM); unsigned short* LIST = (unsigned short*)(wsb + WS_LIST);
    unsigned* CNT = (unsigned*)(F.ctl + CW_CNT); LAS f32x4* km4 = (LAS f32x4*)F.lds;
    LAS unsigned* lc = (LAS unsigned*)(F.lds + X_WS);
    for (int u = F.vcu; u < 512; u += F.G) {
        const int h = u >> 5, c = (u < 256) ? (u & 31) : 31 - (u & 31), nrows = 2 * c + 1;
        if (tid_ < 64) lc[tid_] = 0u;
        for (int i = tid_; i < nrows * 32; i += NWAVES * 64) { const int n = i >> 5, c4 = i & 31; const GAS f32x4* p0 = (const GAS f32x4*)(KM + (size_t)(n * 2) * 2048 + h * 128) + c4; const f32x4 a = p0[0], bb = p0[512]; km4[i] = (a + bb) * (1.f / 256.f); }
        __syncthreads();
        const int s = c * 512 + tid_, qb = __builtin_amdgcn_readfirstlane(s >> 8);
        float q[128]; const GAS v4u* qp = (const GAS v4u*)(QKV + (size_t)s * 6144 + h * 128);
#pragma unroll
        for (int i = 0; i < 16; ++i) { const v4u w = qp[i]; q[8 * i] = bflo(w.x); q[8 * i + 1] = bfhi(w.x); q[8 * i + 2] = bflo(w.y); q[8 * i + 3] = bfhi(w.y); q[8 * i + 4] = bflo(w.z); q[8 * i + 5] = bfhi(w.z); q[8 * i + 6] = bflo(w.w); q[8 * i + 7] = bfhi(w.w); }
        float t0 = -__builtin_inff(), t1 = t0, t2 = t0; int i0 = 0, i1 = 0, i2 = 0;
        for (int n = 0; n < qb; ++n) { float a0 = 0.f, a1 = 0.f, a2 = 0.f, a3 = 0.f;
#pragma unroll
            for (int i = 0; i < 32; ++i) { const f32x4 k = km4[n * 32 + i]; a0 = fmaf(q[4 * i], k.x, a0); a1 = fmaf(q[4 * i + 1], k.y, a1); a2 = fmaf(q[4 * i + 2], k.z, a2); a3 = fmaf(q[4 * i + 3], k.w, a3); }
            const float a = (a0 + a1) + (a2 + a3);
            if (a > t0) { t2 = t1; i2 = i1; t1 = t0; i1 = i0; t0 = a; i0 = n; } else if (a > t1) { t2 = t1; i2 = i1; t1 = a; i1 = n; } else if (a > t2) { t2 = a; i2 = n; } }
        const int nvalid = qb < 3 ? qb : 3;
        unsigned lp0 = 0u, lp1 = 0u, lp2 = 0u;
        if (0 < nvalid) lp0 = __hip_atomic_fetch_add(lc + i0, 1u, __ATOMIC_RELAXED, __HIP_MEMORY_SCOPE_WORKGROUP);
        if (1 < nvalid) lp1 = __hip_atomic_fetch_add(lc + i1, 1u, __ATOMIC_RELAXED, __HIP_MEMORY_SCOPE_WORKGROUP);
        if (2 < nvalid) lp2 = __hip_atomic_fetch_add(lc + i2, 1u, __ATOMIC_RELAXED, __HIP_MEMORY_SCOPE_WORKGROUP);
        __syncthreads();
        if (tid_ < 64) { const unsigned n_ = lc[tid_]; lc[64 + tid_] = n_ ? atomicAdd(CNT + h * 64 + tid_, n_) : 0u; }
        __syncthreads();
        { unsigned short* lh = LIST + (size_t)h * LIST_PER_HEAD;
          if (0 < nvalid) lh[list_off(i0) + lc[64 + i0] + lp0] = (unsigned short)(s | (0 << 14));
          if (1 < nvalid) lh[list_off(i1) + lc[64 + i1] + lp1] = (unsigned short)(s | (1 << 14));
          if (2 < nvalid) lh[list_off(i2) + lc[64 + i2] + lp2] = (unsigned short)(s | (2 << 14)); }
        __syncthreads();
    }
}
#endif
constexpr int MOBA_CH = 32;
constexpr int X_RT = X_WS + 2048, X_PFX = X_RT + 1024, X_Q = X_PFX + 8320, X_ST = X_Q + 16, X_END = X_ST + 16384;
static_assert(X_END <= LDS_BYTES, "MoBA scratch beyond the ring");
__device__ __forceinline__ void p_l1_items(Frame& F, int qslot) {
    PH_TID();
    const int r32 = lane_ & 31, hi = lane_ >> 5;
    const bf16* QKV = (const bf16*)(wsb + WS_QKV); const unsigned char* QK8 = wsb + WS_QK8; const unsigned short* LIST = (const unsigned short*)(wsb + WS_LIST); const unsigned* CNT = (const unsigned*)(F.ctl + CW_CNT);
    unsigned char* PART = wsb + WS_PART; float* PLSE = (float*)(wsb + WS_PLSE); unsigned* QH = (unsigned*)(F.ctl + CW_QH) + 128 * qslot;
    LAS int* pfx = (LAS int*)(F.lds + X_PFX); LAS int* cn = pfx + 1032; LAS int* wt = pfx + 2064; LAS int* qw = (LAS int*)(F.lds + X_Q);
    {
        int v2[2];
#pragma unroll
        for (int k = 0; k < 2; ++k) { const int e = 2 * tid_ + k, j = e >> 4, h = e & 15;
            const int cnt = (int)__hip_atomic_load(CNT + h * 64 + j, __ATOMIC_RELAXED, __HIP_MEMORY_SCOPE_AGENT); const int nch = 8 + (cnt + 31) / 32; v2[k] = (nch + MOBA_CH - 1) / MOBA_CH; cn[e] = cnt; }
        int v = v2[0] + v2[1];
#pragma unroll
        for (int o = 1; o < 64; o <<= 1) { const int t = __builtin_amdgcn_ds_bpermute(((lane_ - o) & 63) << 2, v); if (lane_ >= o) v += t; }
        if (lane_ == 63) wt[wave_] = v;
        __syncthreads();
        int base = 0; for (int w = 0; w < wave_; ++w) base += wt[w];
        pfx[2 * tid_ + 2] = base + v; pfx[2 * tid_ + 1] = base + v - v2[1]; if (tid_ == 0) pfx[0] = 0;
        __syncthreads();
    }
    const int total = pfx[1024]; int* rtab = (int*)((char*)F.ldsg + X_RT) + wave_ * 32;
    const float sc = 0.08838834764831845f, c2 = 0.08838834764831845f * 1.4426950408889634f;
    int voff8; { const int q = wave_ * 64 + lane_, row = q >> 2, pos = q & 3, ch = pos ^ ((row >> 2) & 3); voff8 = row * S + ch * 16; }
    int voff[2]; int koff8; { const int q = wave_ * 64 + lane_, row = q >> 3, pos = q & 7, ch = pos ^ ((row >> 1) & 7); koff8 = row * 4096 + ch * 16; }
#pragma unroll
    for (int i = 0; i < 2; ++i) { const int q = (wave_ * 2 + i) * 64 + lane_;
        const int st = q >> 5, w = q & 31, kk = ((st >> 2) << 3) | (w >> 2), c = (st & 3) * 32 + (w & 3) * 8, k = (kk & ~0xC) | ((kk & 4) << 1) | ((kk & 8) >> 1); voff[i] = k * 6144 + c; }
    int qid_ = (int)(blockIdx.x & 7), dry_ = 0;
#define MOBA_RESOLVE(k_, out_) { int it_ = qid_ + 8 * (int)(k_); while (it_ >= total) { if (++dry_ >= 8) { it_ = total; break; } qid_ = (qid_ + 1) & 7; it_ = qid_ + 8 * (int)atomicAdd(QH + qid_ * 16, 1u); } out_ = it_; }
    if (tid_ == 0) { const unsigned k0_ = atomicAdd(QH + qid_ * 16, 1u); int r_; MOBA_RESOLVE(k0_, r_) qw[0] = r_; }
    __syncthreads();
    for (int par = 0;; par ^= 1) {
        const int it = qw[par];
        if (it >= total) break;
        unsigned nxt_ = 0u; if (tid_ == 0) nxt_ = atomicAdd(QH + qid_ * 16, 1u);
        int lo = 0, hi_ = 1024;
        while (hi_ - lo > 1) { const int mid = (lo + hi_) >> 1; if (pfx[mid] <= it) lo = mid; else hi_ = mid; }
        const int e = lo, j = e >> 4, h = e & 15, sub = it - pfx[e], cnt = cn[e], nch = 8 + (cnt + 31) / 32;
        const int c_lo = sub * MOBA_CH, c_hi = (c_lo + MOBA_CH < nch) ? c_lo + MOBA_CH : nch;
        {
            const unsigned char* K8b = QK8 + (size_t)(256 * j) * 4096 + 2048 + h * 128; const unsigned char* Vtb = wsb + WS_VT8B + (size_t)h * 128 * S + 256 * j;
#pragma unroll
            for (int t = 0; t < 4; ++t) {
                __builtin_amdgcn_global_load_lds((const unsigned*)(K8b + (size_t)t * 64 * 4096 + koff8), (LAS unsigned*)(F.lds + t * 8192 + wave_ * 1024), 16, 0, 0);
                __builtin_amdgcn_global_load_lds((const unsigned*)(Vtb + t * 64 + voff8), (LAS unsigned*)(F.lds + 32768 + t * 8192 + wave_ * 1024), 16, 0, 0); }
            asm volatile("s_waitcnt vmcnt(0)" ::: "memory");
        }
        __syncthreads();
        for (int c = c_lo + wave_; c < c_hi; c += 8) {
            int s, slot, ntile; bool valid = true;
            if (c < 8) { s = 256 * j + 32 * c + r32; slot = 3; ntile = (c >> 1) + 1; }
            else { const int gi = (c - 8) * 32 + r32; valid = gi < cnt; const unsigned ent = LIST[(size_t)h * LIST_PER_HEAD + list_off(j) + (valid ? gi : cnt - 1)]; s = ent & 16383; slot = ent >> 14; ntile = 4; }
            const int didx = (s * 16 + h) * 4 + slot;
            if (hi == 0) rtab[r32] = valid ? didx : -1;
            att::i32x8 qf[2]; { const unsigned char* q8 = QK8 + (size_t)s * 4096 + h * 128 + hi * 32;
#pragma unroll
                for (int g = 0; g < 2; ++g) { const att::i32x4v lo4 = *(const att::i32x4v*)(q8 + g * 64), hi4 = *(const att::i32x4v*)(q8 + g * 64 + 16); qf[g] = __builtin_shufflevector(lo4, hi4, 0, 1, 2, 3, 4, 5, 6, 7); } }
            att::f32x16 o[4]; float m_reg, l_reg;
            att::chunk_resident_kv8(F.lds, 0, 32768, X_WS, ntile, c < 8, 32 * c, 32 * c + r32, sc, c2, qf, o, m_reg, l_reg, wave_);
            att::store_o_staged8(F.lds, o, l_reg, PART, X_WS, X_RT, X_ST, wave_);
            if (hi == 0 && valid) PLSE[didx] = m_reg * c2 + __builtin_amdgcn_logf(l_reg);
        }
        if (tid_ == 0) { int r_; if (dry_ >= 8) r_ = total; else MOBA_RESOLVE(nxt_, r_) qw[par ^ 1] = r_; }
        __syncthreads();
    }
}
__device__ __forceinline__ f32x4 sel4(bool c, f32x4 x, f32x4 y) { return (f32x4){c ? x[0] : y[0], c ? x[1] : y[1], c ? x[2] : y[2], c ? x[3] : y[3]}; }
template <int K> __device__ __forceinline__ f32x4 shx4(f32x4 v) { return (f32x4){shx<K>(v[0]), shx<K>(v[1]), shx<K>(v[2]), shx<K>(v[3])}; }
__device__ __forceinline__ void p_l1_combine(Frame& F) {
    PH_TID();
    const int gw = F.vcu * NWAVES + wave_, NGW = F.G * NWAVES;
    const unsigned char* PART = wsb + WS_PART; const float* PLSE = (const float*)(wsb + WS_PLSE); bf16* ATT = (bf16*)(wsb + WS_XN);
    const int slot = (lane_ >> 3) & 3, dch = lane_ & 7;
#if OUT1_I8
    const bool b0 = (slot & 1) != 0, b1 = (slot & 2) != 0;
#define CMB_LOAD(s_, L_, P_) { const int qb_ = (s_) >> 8, nv_ = qb_ < 3 ? qb_ : 3; const bool vl_ = (slot == 3) || (slot < nv_); \
        _Pragma("unroll") for (int i = 0; i < 8; ++i) { const int idx_ = ((s_) * 16 + 2 * i + (lane_ >> 5)) * 4 + slot; { f32x4 l4_ = *(const GAS f32x4*)(PLSE + (idx_ - slot)); const float ni_ = -__builtin_inff(); l4_.x = nv_ > 0 ? l4_.x : ni_; l4_.y = nv_ > 1 ? l4_.y : ni_; l4_.z = nv_ > 2 ? l4_.z : ni_; L_[i] = l4_; } P_[i] = (v4u){0u, 0u, 0u, 0u}; if (vl_) P_[i] = *(const GAS v4u*)(PART + (size_t)idx_ * 128 + dch * 16); } }
    f32x4 lse_[8]; v4u pw_[8];
#pragma unroll
    for (int i = 0; i < 8; ++i) { lse_[i] = (f32x4){0.f, 0.f, 0.f, 0.f}; pw_[i] = (v4u){0u, 0u, 0u, 0u}; }
    if (gw < S) CMB_LOAD(gw, lse_, pw_);
    for (int s = gw; s < S; s += NGW) {
        f32x4 lseN[8]; v4u pwN[8];
#pragma unroll
        for (int i = 0; i < 8; ++i) { lseN[i] = (f32x4){0.f, 0.f, 0.f, 0.f}; pwN[i] = (v4u){0u, 0u, 0u, 0u}; }
        if (s + NGW < S) CMB_LOAD(s + NGW, lseN, pwN);
        f32x4 keep[8]; float am = 0.f;
#pragma unroll
        for (int i = 0; i < 8; ++i) {
            const f32x4 l4 = lse_[i]; const float mx = fmaxf(fmaxf(l4.x, l4.y), fmaxf(l4.z, l4.w));
            const float w0 = __builtin_amdgcn_exp2f(l4.x - mx), w1 = __builtin_amdgcn_exp2f(l4.y - mx), w2 = __builtin_amdgcn_exp2f(l4.z - mx), w3 = __builtin_amdgcn_exp2f(l4.w - mx);
            const float wsum = (w0 + w1) + (w2 + w3), w = b1 ? (b0 ? w3 : w2) : (b0 ? w1 : w0);
            const v4u pw = pw_[i];
            f32x4 a0, a1, a2, a3;
            { const f32x2 l0 = __builtin_amdgcn_cvt_pk_f32_fp8((int)pw.x, false), h0 = __builtin_amdgcn_cvt_pk_f32_fp8((int)pw.x, true); a0 = (f32x4){l0.x * w, l0.y * w, h0.x * w, h0.y * w}; }
            { const f32x2 l0 = __builtin_amdgcn_cvt_pk_f32_fp8((int)pw.y, false), h0 = __builtin_amdgcn_cvt_pk_f32_fp8((int)pw.y, true); a1 = (f32x4){l0.x * w, l0.y * w, h0.x * w, h0.y * w}; }
            { const f32x2 l0 = __builtin_amdgcn_cvt_pk_f32_fp8((int)pw.z, false), h0 = __builtin_amdgcn_cvt_pk_f32_fp8((int)pw.z, true); a2 = (f32x4){l0.x * w, l0.y * w, h0.x * w, h0.y * w}; }
            { const f32x2 l0 = __builtin_amdgcn_cvt_pk_f32_fp8((int)pw.w, false), h0 = __builtin_amdgcn_cvt_pk_f32_fp8((int)pw.w, true); a3 = (f32x4){l0.x * w, l0.y * w, h0.x * w, h0.y * w}; }
            const f32x4 r0 = sel4(b0, a1, a0) + shx4<8>(sel4(b0, a0, a1)), r1 = sel4(b0, a3, a2) + shx4<8>(sel4(b0, a2, a3));
            const f32x4 f = (sel4(b1, r1, r0) + shx4<16>(sel4(b1, r0, r1))) * ((1.f / 16.f) / wsum);
            keep[i] = f; am = fmaxf(am, fmaxf(fmaxf(fabsf(f[0]), fabsf(f[1])), fmaxf(fabsf(f[2]), fabsf(f[3]))));
        }
        am = fmaxf(am, shx<1>(am)); am = fmaxf(am, shx<2>(am)); am = fmaxf(am, shx<4>(am)); am = fmaxf(am, shx<8>(am)); am = fmaxf(am, shx<16>(am)); am = max32(am); am = am > 0.f ? am : 1.f;
        const float inv = 127.f / am; GAS unsigned* o4 = (GAS unsigned*)((unsigned char*)ATT + (size_t)s * DM + (lane_ >> 5) * 128 + dch * 16 + slot * 4);
#pragma unroll
        for (int i = 0; i < 8; ++i) { const int q0 = (int)__builtin_rintf(keep[i][0] * inv), q1 = (int)__builtin_rintf(keep[i][1] * inv), q2 = (int)__builtin_rintf(keep[i][2] * inv), q3 = (int)__builtin_rintf(keep[i][3] * inv);
            o4[64 * i] = ((unsigned)q0 & 0xffu) | (((unsigned)q1 & 0xffu) << 8) | (((unsigned)q2 & 0xffu) << 16) | ((unsigned)q3 << 24); }
        if (lane_ == 0) ((float*)(wsb + WS_ASC))[s] = am * (1.f / 127.f);
#pragma unroll
        for (int i = 0; i < 8; ++i) { lse_[i] = lseN[i]; pw_[i] = pwN[i]; }
    }
#undef CMB_LOAD
#else
    for (int s = gw; s < S; s += NGW) {
        const int qb = s >> 8, nvalid = qb < 3 ? qb : 3; const bool valid = (slot == 3) || (slot < nvalid);
#pragma unroll
        for (int i = 0; i < 8; ++i) { const int h = 2 * i + (lane_ >> 5), idx = (s * 16 + h) * 4 + slot;
            const float lse = valid ? PLSE[idx] : -__builtin_inff(); float mx = fmaxf(lse, shx<8>(lse)); mx = fmaxf(mx, shx<16>(mx));
            const float w = valid ? __builtin_amdgcn_exp2f(lse - mx) : 0.f; float wsum = w + shx<8>(w); wsum += shx<16>(wsum);
            v4u pw = (v4u){0u, 0u, 0u, 0u}; if (valid) pw = *(const GAS v4u*)(PART + (size_t)idx * 128 + dch * 16);
            const unsigned pwv[4] = {pw.x, pw.y, pw.z, pw.w}; float a[16];
#pragma unroll
            for (int q = 0; q < 4; ++q) { const f32x2 lo = __builtin_amdgcn_cvt_pk_f32_fp8((int)pwv[q], false), hi2 = __builtin_amdgcn_cvt_pk_f32_fp8((int)pwv[q], true);
                a[4 * q] = lo.x * w; a[4 * q + 1] = lo.y * w; a[4 * q + 2] = hi2.x * w; a[4 * q + 3] = hi2.y * w; }
#pragma unroll
            for (int e = 0; e < 16; ++e) { a[e] += shx<8>(a[e]); a[e] += shx<16>(a[e]); }
            if (slot == 0) { const float rw = (1.f / 16.f) / wsum; v4u o0, o1;
                o0.x = pk2(a[0] * rw, a[1] * rw); o0.y = pk2(a[2] * rw, a[3] * rw); o0.z = pk2(a[4] * rw, a[5] * rw); o0.w = pk2(a[6] * rw, a[7] * rw);
                o1.x = pk2(a[8] * rw, a[9] * rw); o1.y = pk2(a[10] * rw, a[11] * rw); o1.z = pk2(a[12] * rw, a[13] * rw); o1.w = pk2(a[14] * rw, a[15] * rw);
                GAS v4u* op = (GAS v4u*)(ATT + (size_t)s * DM + h * 128 + dch * 16); op[0] = o0; op[1] = o1; } }
    }
#endif
}

struct CfgBase { static constexpr int BF16_NT = 1 << 20; static constexpr bool I8IN = false; static constexpr size_t ASC_OFF = 0, WSC_OFF = 0; static constexpr int F8MODE = 0; static constexpr size_t K8_OFF = 0, KR8_OFF = 0, VT8_OFF = 0, SROWS = S; static constexpr bool ROWSCALE = false, GAINSS = false, COLSUM = false; static constexpr int NSS = 4, ROPE = 0, ROPE_KIND = 0;
    static constexpr size_t O0_OFF = 0, O1_OFF = 0, SSIN_OFF = 0, SSOUT_OFF = 0, CS_OFF = 0, KMP_OFF = 0; static constexpr int LD0 = 0, NT0 = 1 << 20, LD1 = 0, NC1 = 0, SSIN_STRIDE = 0, SSIN_IDX = 0, SSOUT_STRIDE = 0, GSPLIT = 1 << 30, CS_LO = 0, CS_HI = 0, CS_LD = 0;
    static constexpr float INV_N = 0.f; };
struct CfgProj : CfgBase {
    static constexpr int F8MODE = 3; static constexpr size_t KR8_OFF = WS_KR8;
#if PROJ_I8
    static constexpr bool I8IN = true; static constexpr size_t ASC_OFF = WS_ASC, WSC_OFF = wo_upsc(3);
#endif
    static constexpr bool GAINSS = true; static constexpr int ROPE = 64, ROPE_KIND = 1, LD0 = 1024, NT0 = 4, LD1 = SWAW, NC1 = SWAW, SSOUT_STRIDE = 16, GSPLIT = 512;
    static constexpr size_t O0_OFF = WS_CQKV, O1_OFF = WS_SWAB, SSOUT_OFF = WS_SSQ, CS_OFF = WS_CS64; };
struct CfgQup : CfgBase {
    static constexpr int F8MODE = 1;
    static constexpr bool ROWSCALE = true; static constexpr int NSS = 8, ROPE = 64, ROPE_KIND = 2, LD0 = 1536, SSIN_STRIDE = 16, SSIN_IDX = 0;
    static constexpr size_t O0_OFF = WS_Q, SSIN_OFF = WS_SSQ, CS_OFF = WS_CS64; static constexpr float INV_N = 1.f / 512.f; };
struct CfgKVup : CfgBase {
    static constexpr int F8MODE = 2, BF16_NT = 0; static constexpr size_t K8_OFF = WS_K8N, VT8_OFF = WS_VT8;
    static constexpr bool ROWSCALE = true; static constexpr int NSS = 8, LD0 = 2048, SSIN_STRIDE = 16, SSIN_IDX = 8;
    static constexpr size_t O0_OFF = WS_KV, SSIN_OFF = WS_SSQ; static constexpr float INV_N = 1.f / 512.f; };
struct CfgQKV : CfgBase {
    static constexpr int F8MODE = 4, BF16_NT = 8; static constexpr size_t K8_OFF = WS_QK8, VT8_OFF = WS_VT8B;
#if QKV_I8
    static constexpr bool I8IN = true, ROWSCALE = false; static constexpr size_t ASC_OFF = WS_ASC2, WSC_OFF = wo_upsc(2);
#else
    static constexpr bool ROWSCALE = true;
#endif
    static constexpr bool COLSUM = true; static constexpr int NSS = 32, ROPE = 128, ROPE_KIND = 3, LD0 = 6144, SSIN_STRIDE = 32, SSIN_IDX = 0, CS_LO = 8, CS_HI = 16, CS_LD = 2048;
    static constexpr size_t O0_OFF = WS_QKV, SSIN_OFF = WS_SS, CS_OFF = WS_CS128, KMP_OFF = WS_KM; static constexpr float INV_N = 1.f / 2048.f; };

struct CfgOut1 { static constexpr size_t O_OFF = WS_M, SS_OFF = WS_SS, ASC_OFF = WS_ASC, WSC_OFF = wo_upsc(4); static constexpr int LD = DM; };

struct Args { const void* in[23]; float* out; unsigned char* ws; int ph_lo, ph_hi, li, pad; };
constexpr int NPH = 21;
__global__ void __launch_bounds__(NWAVES * 64, 2) fwd(Args args) {
    extern __shared__ __attribute__((aligned(16))) unsigned char lds[];
    Frame F;
    F.lds = (LAS unsigned char*)lds; F.ldsg = lds; F.MISC = (volatile LAS unsigned*)(F.lds + MISC_OFF);
    F.wave = __builtin_amdgcn_readfirstlane((int)threadIdx.x >> 6);
    F.G = gridDim.x; { const int bx = blockIdx.x; F.vcu = (F.G % 8 == 0) ? (bx % 8) * (F.G / 8) + bx / 8 : bx; }
    F.in = args.in; F.out = args.out; F.ws = args.ws; F.ctl = (gu32*)(args.ws + WS_CTL);
    for (int u = threadIdx.x; u < (LDS_BYTES - LDSCTL_OFF) / 4; u += NWAVES * 64) ((LAS unsigned*)(F.lds + LDSCTL_OFF))[u] = 0u;
    __syncthreads();
    XcdBarrier bar = xcd_barrier_post((unsigned*)(F.ctl + CW_BAR) + args.li * XCD_BAR_WORDS, F.MISC + 8);
    const int lo = args.ph_lo, hi = args.ph_hi; (void)lo; (void)hi;
#ifndef KMASK
#define KMASK 0xfffff
#endif
#define KIND(k) (((KMASK) >> (k)) & 1)
#ifndef DUP_MASK
#define DUP_MASK 0
#endif
#define REP(k) for (int rep_ = 0; rep_ < ((((DUP_MASK) >> (k)) & 1) ? 2 : 1); ++rep_)
#if MK_N_LAUNCHES == 1
#define IN(k) true
#else
#define IN(k) (lo <= (k) && (k) < hi)
#endif
#define SEAM(k) do { if (IN(k) && IN((k) + 1)) xcd_barrier(bar); } while (0)
#define PHB() unsigned oz_; asm volatile("s_mov_b32 %0, 0" : "=s"(oz_)); unsigned char* ws = args.ws + oz_; const void* const* inp = args.in + oz_; \
    bf16* WB = (bf16*)(ws + WS_WB); bf16* XN = (bf16*)(ws + WS_XN); bf16* Mb = (bf16*)(ws + WS_M); float* SS = (float*)(ws + WS_SS); float* SSQ = (float*)(ws + WS_SSQ); \
    const float* CS64 = (const float*)(ws + WS_CS64); const float* CS128 = (const float*)(ws + WS_CS128); (void)WB; (void)XN; (void)Mb; (void)SS; (void)SSQ; (void)CS64; (void)CS128; (void)inp
#define WBP(off) ((const pg8::bf16_t*)((const char*)WB + (off)))
#ifndef DUPG
#define DUPG 0
#endif
#define RUN_GEMM(KD, EPI_T, Ap, lda_, Bp, M_, N_, K_, Eobj) do { RUN_GEMM1(EPI_T, Ap, lda_, Bp, M_, N_, K_, Eobj); if (((DUPG) >> (KD)) & 1) RUN_GEMM1(EPI_T, Ap, lda_, Bp, M_, N_, K_, Eobj); } while (0)
#ifndef F8_SP2
#define F8_SP2 true
#endif
#ifndef F8_ALIGN
#define F8_ALIGN true
#endif
#define RUN_GEMMI8(EPI_T, Ap, lda_, Bp, M_, N_, K_, Eobj) do { pg8::Gemm g_{(const pg8::bf16_t*)(Ap), (Bp), (M_), (N_), (K_) / 2, (lda_) / 2, F.wave}; pg8::StaticOrder S_; S_.init((M_), (N_), F.G, (int)blockIdx.x); \
        pg8::gemm_phase<EPI_T, pg8::StaticOrder, true, true, 2>(F.lds, g_, S_, Eobj); } while (0)
#define RUN_GEMM8(EPI_T, Ap, lda_, Bp, M_, N_, K_, Eobj) do { pg8::Gemm g_{(const pg8::bf16_t*)(Ap), (Bp), (M_), (N_), (K_) / 2, (lda_) / 2, F.wave}; pg8::StaticOrder S_; S_.init((M_), (N_), F.G, (int)blockIdx.x); \
        pg8::gemm_phase<EPI_T, pg8::StaticOrder, F8_ALIGN, F8_SP2, 1>(F.lds, g_, S_, Eobj); } while (0)
#define RUN_GEMM1(EPI_T, Ap, lda_, Bp, M_, N_, K_, Eobj) do { pg8::Gemm g_{(const pg8::bf16_t*)(Ap), (Bp), (M_), (N_), (K_), (lda_), F.wave}; pg8::StaticOrder S_; S_.init((M_), (N_), F.G, (int)blockIdx.x); \
        pg8::gemm_phase<EPI_T, pg8::StaticOrder, true, true>(F.lds, g_, S_, Eobj); } while (0)

    if (KIND(0) && IN(0)) { REP(0) p_prologue(F); } SEAM(0);
#pragma unroll 1
    for (int l = 0; l < 2; ++l) {
        if (l == 0) {
            if (KIND(1) && IN(1)) { PHB();
                pg8::EpiX<CfgProj> E{ws, (const float*)inp[5], (const float*)inp[7]};
#if PROJ_I8
                RUN_GEMMI8(decltype(E), XN, DM, WBP(WB_IN), S, NIN_PAD, DM, E); } SEAM(1);
#else
                RUN_GEMM(1, decltype(E), XN, DM, WBP(WB_IN), S, NIN_PAD, DM, E); } SEAM(1);
#endif
            if (KIND(3) && IN(2)) { PHB();
                { pg8::EpiX<CfgQup> E{ws, nullptr, nullptr}; RUN_GEMM(3, decltype(E), ws + WS_CQKV, 1024, WBP(WB_QUP), S, 1536, 512, E); }
                { pg8::EpiX<CfgKVup> E{ws, nullptr, nullptr}; RUN_GEMM(3, decltype(E), ws + WS_CQKV + 1024, 1024, WBP(WB_KVUP), S, 2048, 512, E); } } SEAM(2);
            if (KIND(4) && IN(3)) { REP(4) p_l0_attn(F); } SEAM(3);
        } else {
#if QKV_I8
            if (KIND(11) && IN(10)) { PHB(); p_rows<2>(F, nullptr, (const bf16*)args.out, nullptr, nullptr, (const float*)inp[12]); } SEAM(10);
            if (KIND(12) && IN(11)) { PHB();
                pg8::EpiX<CfgQKV> E{ws, nullptr, nullptr};
                RUN_GEMMI8(decltype(E), ws + WS_HG, DM, (const pg8::bf16_t*)(ws + WS_WQKV1), S, 6144, DM, E); } SEAM(11);
#else
            if (KIND(12) && IN(11)) { PHB();
                pg8::EpiX<CfgQKV> E{ws, nullptr, nullptr};
                RUN_GEMM(12, decltype(E), ws + WS_HG, DM, (const pg8::bf16_t*)(ws + WS_WQKV1), S, 6144, DM, E); } SEAM(11);
#endif
            if (KIND(14) && IN(12)) { p_l1_gate(F); } SEAM(12);
            if (KIND(15) && IN(13)) { REP(15) p_l1_items(F, rep_); } SEAM(13);
            if (KIND(16) && IN(14)) { REP(16) p_l1_combine(F); } SEAM(14);
        }
        const int tb = l ? 15 : 4;
        if (KIND(5) && IN(tb + 0)) { PHB();
#if OUT1_I8
            if (l == 1) { pg8::EpiOutI8<CfgOut1> E{ws}; RUN_GEMMI8(decltype(E), XN, DM, (const pg8::bf16_t*)(ws + wo_out(1)), S, DM, DM, E); } else
#endif
            { pg8::EpiStore<0, true> E{(pg8::bf16_t*)Mb, DM, 1 << 20, nullptr, 0, 0, SS}; RUN_GEMM(5, decltype(E), XN, DM, (const pg8::bf16_t*)(ws + wo_out(l)), S, DM, DM, E); } } SEAM(tb + 0);
        if (KIND(6) && IN(tb + 1)) { PHB(); p_rows<0>(F, l == 0 ? (const float*)inp[0] : nullptr, (const bf16*)args.out, (bf16*)args.out, (const float*)inp[l == 0 ? 11 : 15], (const float*)inp[16] + l * DM); } SEAM(tb + 1);
        if (KIND(7) && IN(tb + 2)) { PHB();
            pg8::EpiUpI8 E{ws + WS_HID, FF, (const float*)(ws + WS_ASC), (const float*)(ws + wo_upsc(l))}; RUN_GEMMI8(decltype(E), XN, DM, (const pg8::bf16_t*)(ws + wo_up(l)), S, FF, DM, E); } SEAM(tb + 2);
        if (KIND(8) && IN(tb + 3)) { PHB();
            pg8::EpiDown8 E{(pg8::bf16_t*)Mb, DM, SS, 1.f / W8_DOWN_SC}; RUN_GEMM8(decltype(E), ws + WS_HID, FF, (const pg8::bf16_t*)(ws + wo_down(l)), S, DM, FF, E); } SEAM(tb + 3);
        if (KIND(9) && IN(tb + 4)) { PHB();
            p_rows<1>(F, nullptr, (const bf16*)args.out, l == 0 ? (bf16*)args.out : (bf16*)(ws + WS_H16L), (const float*)inp[19] + l * DM, nullptr);
            pg8::EpiStore8 E{ws + WS_PP, DM}; RUN_GEMM(9, decltype(E), ws + WS_PB + (size_t)l * S * PLED * 2, PLED, (const pg8::bf16_t*)(ws + wo_proj(l)), S, DM, PLED, E); } SEAM(tb + 4);
        if (l == 0) {
            if (KIND(10) && IN(tb + 5)) { PHB();
                pg8::EpiPle<true> E{(pg8::bf16_t*)args.out, nullptr, ws + WS_PP, (const float*)inp[21], DM, (pg8::bf16_t*)(ws + WS_HG), (const float*)inp[12], SS, 1.f / W8_GATE_SC}; RUN_GEMM8(pg8::EpiPle<true>, XN, DM, (const pg8::bf16_t*)(ws + wo_gate(0)), S, DM, DM, E); } SEAM(tb + 5);
        } else {
            if (KIND(10) && IN(tb + 5)) { PHB(); pg8::EpiPle<false> E{(pg8::bf16_t*)(ws + WS_H16L), args.out, ws + WS_PP, (const float*)inp[21] + DM, DM, nullptr, nullptr, nullptr, 1.f / W8_GATE_SC}; RUN_GEMM8(pg8::EpiPle<false>, XN, DM, (const pg8::bf16_t*)(ws + wo_gate(1)), S, DM, DM, E); }
        }
    }
#undef IN
#undef SEAM
}

extern "C" void kernel_launch(void* const* d_in, const int* in_sizes, int n_in, void* d_out, int out_size, void* d_ws, size_t ws_size, hipStream_t stream) {
    static int grid = 0;
    if (grid == 0) {
        if (n_in != 23 || in_sizes[0] != S * DM || out_size != S * DM || ws_size < WS_END) { fprintf(stderr, "kernel_launch: unexpected shapes / workspace (%d inputs, ws %zu)\n", n_in, ws_size); grid = -1; return; }
        int dev = 0, cus = 0, per_cu = 0;
        if (hipGetDevice(&dev) != hipSuccess || hipDeviceGetAttribute(&cus, hipDeviceAttributeMultiprocessorCount, dev) != hipSuccess) { grid = -1; return; }
        if (hipFuncSetAttribute((const void*)fwd, hipFuncAttributeMaxDynamicSharedMemorySize, LDS_BYTES) != hipSuccess) { grid = -1; return; }
        if (hipOccupancyMaxActiveBlocksPerMultiprocessor(&per_cu, (const void*)fwd, NWAVES * 64, LDS_BYTES) != hipSuccess || per_cu < 1) { fprintf(stderr, "kernel_launch: occupancy query says %d\n", per_cu); }
        (void)hipGetLastError();
        grid = cus;
    }
    if (grid < 0) return;
    if (hipMemsetAsync((char*)d_ws + WS_CTL, 0, CTL_ZERO_BYTES, stream) != hipSuccess) return;
    Args a{};
    for (int i = 0; i < 23; ++i) a.in[i] = d_in[i];
    a.out = (float*)d_out; a.ws = (unsigned char*)d_ws; a.pad = 0;
#if MK_N_LAUNCHES == 1
    a.ph_lo = 0; a.ph_hi = NPH; a.li = 0;
    hipLaunchKernelGGL(fwd, dim3(grid), dim3(NWAVES * 64), LDS_BYTES, stream, a);
#else
    for (int ph = 0; ph < NPH; ++ph) { a.ph_lo = ph; a.ph_hi = ph + 1; a.li = ph; hipLaunchKernelGGL(fwd, dim3(grid), dim3(NWAVES * 64), LDS_BYTES, stream, a); }
#endif
}
```

```cpp
#include <hip/hip_runtime.h>
#include <cstdio>
#include <cstdint>
#ifndef PROJ_I8
#define PROJ_I8 1
#endif
#ifndef OUT1_I8
#define OUT1_I8 1
#endif
#ifndef CONV_UNROLL
#define CONV_UNROLL 8
#endif
#ifndef ROWS_X16
#define ROWS_X16 1
#endif
#ifndef GATE_MFMA
#define GATE_MFMA 1
#endif
#ifndef OUT0_I8
#define OUT0_I8 1
#endif
#ifndef QKV_I8
#define QKV_I8 1
#endif

__device__ __forceinline__ int lane_id() { int l; asm volatile("v_mbcnt_lo_u32_b32 %0, -1, 0\n\tv_mbcnt_hi_u32_b32 %0, -1, %0" : "=v"(l)); return l; }
template <int K> __device__ __forceinline__ float shx(float v) {
    static_assert(K == 1 || K == 2 || K == 4 || K == 8 || K == 16, "shx: xor mask inside a 32-lane half");
    if constexpr (K == 1) return __uint_as_float((unsigned)__builtin_amdgcn_mov_dpp((int)__float_as_uint(v), 0xB1, 0xf, 0xf, true));
    else if constexpr (K == 2) return __uint_as_float((unsigned)__builtin_amdgcn_mov_dpp((int)__float_as_uint(v), 0x4E, 0xf, 0xf, true));
    else return __uint_as_float((unsigned)__builtin_amdgcn_ds_swizzle((int)__float_as_uint(v), 0x1F | (K << 10)));
}
__device__ __forceinline__ float sum32(float v) { auto r = __builtin_amdgcn_permlane32_swap(__float_as_uint(v), __float_as_uint(v), false, false); return __uint_as_float(r[0]) + __uint_as_float(r[1]); }
__device__ __forceinline__ float max32(float v) { auto r = __builtin_amdgcn_permlane32_swap(__float_as_uint(v), __float_as_uint(v), false, false); return fmaxf(__uint_as_float(r[0]), __uint_as_float(r[1])); }
namespace pg8 {
#define PG8_LAS __attribute__((address_space(3)))
typedef unsigned short bf16_t;
typedef short bf16x8 __attribute__((ext_vector_type(8)));
typedef float f32x4 __attribute__((ext_vector_type(4)));
typedef unsigned u32x4 __attribute__((ext_vector_type(4)));
typedef int i32x4 __attribute__((ext_vector_type(4)));
typedef unsigned u32x2 __attribute__((ext_vector_type(2)));
constexpr int BM = 256, BK = 64, HALF = 128, HTB = HALF * BK * 2  , STAGE_BYTES = 8 * HTB, NXCD = 8, WGM = 8;

__host__ __device__ __forceinline__ int lds_byte(int r, int c) { const int st = (r >> 4) * 2 + (c >> 5), rr = r & 15, cc = c & 31, ob = rr * 64 + cc * 2; return st * 1024 + (ob ^ (((ob >> 9) & 1) << 5)); }
__host__ __device__ __forceinline__ void stage_rc(int b, int& R, int& C) { const int st = b / 1024, sb = b % 1024, swz = sb ^ (((sb >> 9) & 1) << 5); R = (st >> 1) * 16 + swz / 64; C = (st & 1) * 32 + (swz % 64) / 2; }
__host__ __device__ __forceinline__ int perm32(int rho) { const int n = rho >> 4, i = rho & 15; return 8 * (i >> 2) + 4 * n + (i & 3); }

struct Unit { int pm, pn; };
struct Gemm { const bf16_t* A; const bf16_t* Bt; int M, N, K, lda, wave; };

struct StaticOrder {
    int nM, nN, nwg, G, c;
    __host__ __device__ void init(int M, int N, int G_, int c_) { nM = M / BM; nN = N / BM; nwg = nM * nN; G = G_; c = c_; }
    __host__ __device__ bool next(int i, Unit& u) const {
        const long L = (long)i * G + c; if (L >= nwg) return false;
        int wgid = (int)L; { const int q = nwg / NXCD, r = nwg % NXCD, xcd = wgid % NXCD, off = wgid / NXCD; wgid = (xcd < r ? xcd * (q + 1) : r * (q + 1) + (xcd - r) * q) + off; }
        const int nig = WGM * nN, gid = wgid / nig, fm = gid * WGM, gsz = (nM - fm) < WGM ? (nM - fm) : WGM;
        u.pm = fm + ((wgid % nig) % gsz); u.pn = (wgid % nig) / gsz; return true;
    }
    __device__ __forceinline__ void a_ready(const Unit&) const {}
    __device__ __forceinline__ void done(const Unit&) const {}
};

__device__ __forceinline__ unsigned cvt_pk_bf16(float lo, float hi) { unsigned r; asm volatile("v_cvt_pk_bf16_f32 %0, %1, %2" : "=v"(r) : "v"(lo), "v"(hi)); return r; }
typedef float f32x2 __attribute__((ext_vector_type(2)));

template <int ACT, bool SUMSQ> struct EpiStore {
    static constexpr bool PERM = true, AFTER_DRAIN = false;
    bf16_t* O0; int ld0; int nt0; bf16_t* O1; int ld1; int nc1; float* SS;
    __device__ __forceinline__ void operator()(const f32x4 (&acc)[2][2][4][2], const Unit& u, int wr, int wc, int fr, int fq) const {
        const int row0 = u.pm * BM + wr * 64 + fr;
        bf16_t* base; int ld, colt, lim;
        if (u.pn < nt0) { base = O0; ld = ld0; colt = u.pn * BM; lim = 0x7fffffff; } else { base = O1; ld = ld1; colt = (u.pn - nt0) * BM; lim = nc1; }
        const int col0 = colt + wc * 32 + 8 * fq;
#pragma unroll
        for (int ai = 0; ai < 2; ++ai)
#pragma unroll
            for (int m = 0; m < 4; ++m) { const int row = row0 + ai * HALF + m * 16; bf16_t* rowp = base + (size_t)row * ld + col0; float ss = 0.f;
#pragma unroll
                for (int bj = 0; bj < 2; ++bj) { f32x4 v0 = acc[ai][bj][m][0], v1 = acc[ai][bj][m][1];
                    if (ACT == 1) {
#pragma unroll
                        for (int e = 0; e < 4; ++e) { const float a = fmaxf(v0[e], 0.f), b = fmaxf(v1[e], 0.f); v0[e] = a * a; v1[e] = b * b; } }
                    if (SUMSQ) ss += (v0[0] * v0[0] + v0[1] * v0[1]) + (v0[2] * v0[2] + v0[3] * v0[3]) + (v1[0] * v1[0] + v1[1] * v1[1]) + (v1[2] * v1[2] + v1[3] * v1[3]);
                    u32x4 w; w.x = cvt_pk_bf16(v0[0], v0[1]); w.y = cvt_pk_bf16(v0[2], v0[3]); w.z = cvt_pk_bf16(v1[0], v1[1]); w.w = cvt_pk_bf16(v1[2], v1[3]);
                    if (col0 + bj * HALF < lim) *(u32x4*)(rowp + bj * HALF) = w; }
                if (SUMSQ) { ss += shx<16>(ss); ss = sum32(ss); if (fq == 0) SS[(size_t)row * 32 + u.pn * 4 + wc] = ss; } }
    }
};
__device__ __forceinline__ unsigned pk4_fp8(float a, float b, float c, float d) { int w = __builtin_amdgcn_cvt_pk_fp8_f32(a, b, 0, false); w = __builtin_amdgcn_cvt_pk_fp8_f32(c, d, w, true); return (unsigned)w; }
template <class C> struct EpiX {
    static constexpr bool PERM = true, AFTER_DRAIN = false;
    static constexpr bool ROWSCALE = C::ROWSCALE, GAINSS = C::GAINSS, COLSUM = C::COLSUM; static constexpr int NSS = C::NSS, ROPE = C::ROPE;
    unsigned char* ws; const float* gcol; const float* gcol2;
    __device__ __forceinline__ void operator()(const f32x4 (&acc)[2][2][4][2], const Unit& u, int wr, int wc, int fr, int fq) const {
        bf16_t* const O0 = (bf16_t*)(ws + C::O0_OFF); bf16_t* const O1 = (bf16_t*)(ws + C::O1_OFF); constexpr int ld0 = C::LD0, nt0 = C::NT0, ld1 = C::LD1, nc1 = C::NC1;
        const float* const SSin = (const float*)(ws + C::SSIN_OFF); constexpr int ssin_stride = C::SSIN_STRIDE, ssin_off = C::SSIN_IDX; constexpr float inv_n = C::INV_N;
        float* const SSout = (float*)(ws + C::SSOUT_OFF); constexpr int ssout_stride = C::SSOUT_STRIDE, gsplit = C::GSPLIT;
        const float* const cs = (const float*)(ws + C::CS_OFF); constexpr int rope_kind = C::ROPE_KIND;
        float* const KMP = (float*)(ws + C::KMP_OFF); constexpr int cs_lo = C::CS_LO, cs_hi = C::CS_HI, cs_ld = C::CS_LD;
        const int row0 = u.pm * BM + wr * 64 + fr;
        bf16_t* base; int ld, colt, lim; const bool first = u.pn < nt0;
        if (first) { base = O0; ld = ld0; colt = u.pn * BM; lim = 0x7fffffff; } else { base = O1; ld = ld1; colt = (u.pn - nt0) * BM; lim = nc1; }
        const int col0 = colt + wc * 32 + 8 * fq;
        const int gc0 = u.pn * BM + wc * 32 + 8 * fq;
        const bool docs = COLSUM && u.pn >= cs_lo && u.pn < cs_hi;
        float csum[2][8];
#pragma unroll
        for (int bj = 0; bj < 2; ++bj)
#pragma unroll
            for (int e = 0; e < 8; ++e) csum[bj][e] = 0.f;
        f32x4 wsv[2][2];
        if constexpr (C::I8IN) {
#pragma unroll
            for (int bj = 0; bj < 2; ++bj) { const float* wp = (const float*)(ws + C::WSC_OFF) + gc0 + bj * HALF; wsv[bj][0] = *(const f32x4*)wp; wsv[bj][1] = *(const f32x4*)(wp + 4); } }
        f32x4 gv[2][2];
        if (GAINSS) {
#pragma unroll
            for (int bj = 0; bj < 2; ++bj) { const int gc = gc0 + bj * HALF; const float* gp = gc < gsplit ? gcol + gc : gcol2 + (gc - gsplit);
                gv[bj][0] = first ? *(const f32x4*)gp : (f32x4){1.f, 1.f, 1.f, 1.f}; gv[bj][1] = first ? *(const f32x4*)(gp + 4) : (f32x4){1.f, 1.f, 1.f, 1.f}; } }
#pragma unroll
        for (int ai = 0; ai < 2; ++ai)
#pragma unroll
            for (int m = 0; m < 4; ++m) { const int row = row0 + ai * HALF + m * 16; bf16_t* rowp = base + (size_t)row * ld + col0;
                float rs = 1.f;
                if (ROWSCALE) { const f32x4* sp = (const f32x4*)(SSin + (size_t)row * ssin_stride + ssin_off); f32x4 t = sp[0];
#pragma unroll
                    for (int i = 1; i < NSS / 4; ++i) t += sp[i];
                    rs = 1.f / sqrtf(((t[0] + t[1]) + (t[2] + t[3])) * inv_n + 1e-6f); }
                if constexpr (C::I8IN) rs = ((const float*)(ws + C::ASC_OFF))[row];
                float ss = 0.f;
#pragma unroll
                for (int bj = 0; bj < 2; ++bj) { f32x4 v0 = acc[ai][bj][m][0], v1 = acc[ai][bj][m][1];
                    if constexpr (C::I8IN) { const i32x4 i0 = __builtin_bit_cast(i32x4, v0), i1 = __builtin_bit_cast(i32x4, v1);
#pragma unroll
                        for (int e = 0; e < 4; ++e) { v0[e] = (float)i0[e] * rs * wsv[bj][0][e]; v1[e] = (float)i1[e] * rs * wsv[bj][1][e]; } }
                    if (ROWSCALE) { v0 = v0 * rs; v1 = v1 * rs; }
                    if (GAINSS) { ss += (v0[0] * v0[0] + v0[1] * v0[1]) + (v0[2] * v0[2] + v0[3] * v0[3]) + (v1[0] * v1[0] + v1[1] * v1[1]) + (v1[2] * v1[2] + v1[3] * v1[3]); v0 = v0 * gv[bj][0]; v1 = v1 * gv[bj][1]; }
                    if (ROPE != 0) { const int dc = col0 + bj * HALF, gc = gc0 + bj * HALF;
                        const bool rot = rope_kind == 1 ? (!first && (dc < 1152 || dc >= 1280)) : (rope_kind == 2 ? ((gc % 192) >= 128) : (u.pn < 16));
                        if (rot) { const int i0 = (rope_kind == 2 ? ((gc % 192) - 128) : (gc % ROPE)) >> 1; const f32x4* cp = (const f32x4*)(cs + ((size_t)row * (ROPE / 2) + i0) * 2); const f32x4 c01 = cp[0], c23 = cp[1];
                            const float a0 = v0[0] * c01[0] - v0[1] * c01[1], b0 = v0[1] * c01[0] + v0[0] * c01[1], a1 = v0[2] * c01[2] - v0[3] * c01[3], b1 = v0[3] * c01[2] + v0[2] * c01[3];
                            const float a2 = v1[0] * c23[0] - v1[1] * c23[1], b2 = v1[1] * c23[0] + v1[0] * c23[1], a3 = v1[2] * c23[2] - v1[3] * c23[3], b3 = v1[3] * c23[2] + v1[2] * c23[3];
                            v0 = (f32x4){a0, b0, a1, b1}; v1 = (f32x4){a2, b2, a3, b3}; } }
                    if (COLSUM) {
#pragma unroll
                        for (int e = 0; e < 4; ++e) { csum[bj][e] += v0[e]; csum[bj][4 + e] += v1[e]; } }
                    if constexpr (C::F8MODE == 1) {
                        u32x2 w8; w8.x = pk4_fp8(v0[0], v0[1], v0[2], v0[3]); w8.y = pk4_fp8(v1[0], v1[1], v1[2], v1[3]);
                        *(u32x2*)((unsigned char*)O0 + (size_t)row * ld0 + col0 + bj * HALF) = w8;
                    } else {
                        u32x4 w; w.x = cvt_pk_bf16(v0[0], v0[1]); w.y = cvt_pk_bf16(v0[2], v0[3]); w.z = cvt_pk_bf16(v1[0], v1[1]); w.w = cvt_pk_bf16(v1[2], v1[3]);
                        if ((C::BF16_NT >= (1 << 20) || u.pn < C::BF16_NT) && col0 + bj * HALF < lim) *(u32x4*)(rowp + bj * HALF) = w;
                        if constexpr (C::F8MODE == 2) { u32x2 w8; w8.x = pk4_fp8(v0[0], v0[1], v0[2], v0[3]); w8.y = pk4_fp8(v1[0], v1[1], v1[2], v1[3]);
                            if (bj == 0) {
                                *(u32x2*)(ws + C::K8_OFF + (size_t)row * 1024 + u.pn * 128 + wc * 32 + 8 * fq) = w8; }
                            else {
                                const int k = row & 63, pi = 32 * ((k >> 2) & 1) + ((k & 3) | (((k >> 3) & 3) << 2) | ((k >> 5) << 4));
                                unsigned char* vt = ws + C::VT8_OFF + (size_t)(u.pn * 128 + wc * 32 + 8 * fq) * C::SROWS + (row & ~63) + pi;
#pragma unroll
                                for (int e = 0; e < 4; ++e) { vt[(size_t)e * C::SROWS] = (unsigned char)(w8.x >> (8 * e)); vt[(size_t)(4 + e) * C::SROWS] = (unsigned char)(w8.y >> (8 * e)); } } }
                        if constexpr (C::F8MODE == 4) { if (u.pn >= 16) {
                            u32x2 w8; w8.x = pk4_fp8(v0[0], v0[1], v0[2], v0[3]); w8.y = pk4_fp8(v1[0], v1[1], v1[2], v1[3]);
                            const int k = row & 63, pi = 32 * ((k >> 2) & 1) + ((k & 3) | (((k >> 3) & 3) << 2) | ((k >> 5) << 4));
                            unsigned char* vt = ws + C::VT8_OFF + (size_t)(gc0 + bj * HALF - 4096) * C::SROWS + (row & ~63) + pi;
#pragma unroll
                            for (int e = 0; e < 4; ++e) { vt[(size_t)e * C::SROWS] = (unsigned char)(w8.x >> (8 * e)); vt[(size_t)(4 + e) * C::SROWS] = (unsigned char)(w8.y >> (8 * e)); } } }
                        if constexpr (C::F8MODE == 4) { if (u.pn < 16) {
                            u32x2 w8; w8.x = pk4_fp8(v0[0], v0[1], v0[2], v0[3]); w8.y = pk4_fp8(v1[0], v1[1], v1[2], v1[3]);
                            *(u32x2*)(ws + C::K8_OFF + (size_t)row * 4096 + gc0 + bj * HALF) = w8; } }
                        if constexpr (C::F8MODE == 3) { const int dc = col0 + bj * HALF; if (!first && dc >= 1280 && dc < 1344) {
                            u32x2 w8; w8.x = pk4_fp8(v0[0], v0[1], v0[2], v0[3]); w8.y = pk4_fp8(v1[0], v1[1], v1[2], v1[3]);
                            *(u32x2*)(ws + C::KR8_OFF + (size_t)row * 64 + (dc - 1280)) = w8; } }
                    } }
                if (GAINSS) { ss += shx<16>(ss); ss = sum32(ss); if (fq == 0 && first) SSout[(size_t)row * ssout_stride + u.pn * 4 + wc] = ss; } }
        if (COLSUM) { if (docs) {
#pragma unroll
            for (int bj = 0; bj < 2; ++bj)
#pragma unroll
                for (int e = 0; e < 8; ++e) { float t = csum[bj][e]; t += shx<1>(t); t += shx<2>(t); t += shx<4>(t); t += shx<8>(t); csum[bj][e] = t; }
            if (fr == 0) {
#pragma unroll
                for (int bj = 0; bj < 2; ++bj) { float* kp = KMP + (size_t)(u.pm * 2 + wr) * cs_ld + (gc0 + bj * HALF - cs_lo * BM);
                    *(f32x4*)kp = (f32x4){csum[bj][0], csum[bj][1], csum[bj][2], csum[bj][3]}; *(f32x4*)(kp + 4) = (f32x4){csum[bj][4], csum[bj][5], csum[bj][6], csum[bj][7]}; } } } }
    }
};
struct EpiUp8 {
    static constexpr bool PERM = true, AFTER_DRAIN = false;
    unsigned char* O; int ld;
    __device__ __forceinline__ void operator()(const f32x4 (&acc)[2][2][4][2], const Unit& u, int wr, int wc, int fr, int fq) const {
        const int row0 = u.pm * BM + wr * 64 + fr, col0 = u.pn * BM + wc * 32 + 8 * fq;
#pragma unroll
        for (int ai = 0; ai < 2; ++ai)
#pragma unroll
            for (int m = 0; m < 4; ++m) { unsigned char* rowp = O + (size_t)(row0 + ai * HALF + m * 16) * ld + col0;
#pragma unroll
                for (int bj = 0; bj < 2; ++bj) { f32x4 v0 = acc[ai][bj][m][0], v1 = acc[ai][bj][m][1];
#pragma unroll
                    for (int e = 0; e < 4; ++e) { const float a = fmaxf(v0[e], 0.f), b = fmaxf(v1[e], 0.f); v0[e] = fminf(a * a, 448.f); v1[e] = fminf(b * b, 448.f); }
                    u32x2 w; w.x = pk4_fp8(v0[0], v0[1], v0[2], v0[3]); w.y = pk4_fp8(v1[0], v1[1], v1[2], v1[3]);
                    *(u32x2*)(rowp + bj * HALF) = w; } }
    }
};
struct EpiStore8 {
    static constexpr bool PERM = true, AFTER_DRAIN = false;
    unsigned char* O; int ld;
    __device__ __forceinline__ void operator()(const f32x4 (&acc)[2][2][4][2], const Unit& u, int wr, int wc, int fr, int fq) const {
        const int row0 = u.pm * BM + wr * 64 + fr, col0 = u.pn * BM + wc * 32 + 8 * fq;
#pragma unroll
        for (int ai = 0; ai < 2; ++ai)
#pragma unroll
            for (int m = 0; m < 4; ++m) { unsigned char* rowp = O + (size_t)(row0 + ai * HALF + m * 16) * ld + col0;
#pragma unroll
                for (int bj = 0; bj < 2; ++bj) { const f32x4 v0 = acc[ai][bj][m][0], v1 = acc[ai][bj][m][1];
                    u32x2 w; w.x = pk4_fp8(v0[0], v0[1], v0[2], v0[3]); w.y = pk4_fp8(v1[0], v1[1], v1[2], v1[3]);
                    *(u32x2*)(rowp + bj * HALF) = w; } }
    }
};
struct EpiUpI8 {
    static constexpr bool PERM = true, AFTER_DRAIN = false;
    unsigned char* O; int ld; const float* ascale; const float* wscale;
    __device__ __forceinline__ void operator()(const f32x4 (&acc)[2][2][4][2], const Unit& u, int wr, int wc, int fr, int fq) const {
        const int row0 = u.pm * BM + wr * 64 + fr, col0 = u.pn * BM + wc * 32 + 8 * fq;
        f32x4 wsv[2][2];
#pragma unroll
        for (int bj = 0; bj < 2; ++bj) { wsv[bj][0] = *(const f32x4*)(wscale + col0 + bj * HALF); wsv[bj][1] = *(const f32x4*)(wscale + col0 + bj * HALF + 4); }
#pragma unroll
        for (int ai = 0; ai < 2; ++ai)
#pragma unroll
            for (int m = 0; m < 4; ++m) { const int row = row0 + ai * HALF + m * 16; unsigned char* rowp = O + (size_t)row * ld + col0; const float as = ascale[row];
#pragma unroll
                for (int bj = 0; bj < 2; ++bj) { const i32x4 i0 = __builtin_bit_cast(i32x4, acc[ai][bj][m][0]), i1 = __builtin_bit_cast(i32x4, acc[ai][bj][m][1]); f32x4 v0, v1;
#pragma unroll
                    for (int e = 0; e < 4; ++e) { const float a = fmaxf((float)i0[e] * as * wsv[bj][0][e], 0.f), b = fmaxf((float)i1[e] * as * wsv[bj][1][e], 0.f); v0[e] = fminf(a * a, 448.f); v1[e] = fminf(b * b, 448.f); }
                    u32x2 w; w.x = pk4_fp8(v0[0], v0[1], v0[2], v0[3]); w.y = pk4_fp8(v1[0], v1[1], v1[2], v1[3]);
                    *(u32x2*)(rowp + bj * HALF) = w; } }
    }
};
template <class C> struct EpiOutI8 {
    static constexpr bool PERM = true, AFTER_DRAIN = false;
    unsigned char* ws;
    __device__ __forceinline__ void operator()(const f32x4 (&acc)[2][2][4][2], const Unit& u, int wr, int wc, int fr, int fq) const {
        bf16_t* const O = (bf16_t*)(ws + C::O_OFF); float* const SS = (float*)(ws + C::SS_OFF); const float* const ascale = (const float*)(ws + C::ASC_OFF); const float* const wscale = (const float*)(ws + C::WSC_OFF); constexpr int ld = C::LD;
        const int row0 = u.pm * BM + wr * 64 + fr, col0 = u.pn * BM + wc * 32 + 8 * fq;
        f32x4 wsv[2][2];
#pragma unroll
        for (int bj = 0; bj < 2; ++bj) { wsv[bj][0] = *(const f32x4*)(wscale + col0 + bj * HALF); wsv[bj][1] = *(const f32x4*)(wscale + col0 + bj * HALF + 4); }
#pragma unroll
        for (int ai = 0; ai < 2; ++ai)
#pragma unroll
            for (int m = 0; m < 4; ++m) { const int row = row0 + ai * HALF + m * 16; bf16_t* rowp = O + (size_t)row * ld + col0; const float as = ascale[row]; float ss = 0.f;
#pragma unroll
                for (int bj = 0; bj < 2; ++bj) { const i32x4 i0 = __builtin_bit_cast(i32x4, acc[ai][bj][m][0]), i1 = __builtin_bit_cast(i32x4, acc[ai][bj][m][1]); f32x4 v0, v1;
#pragma unroll
                    for (int e = 0; e < 4; ++e) { v0[e] = (float)i0[e] * as * wsv[bj][0][e]; v1[e] = (float)i1[e] * as * wsv[bj][1][e]; }
                    ss += (v0[0] * v0[0] + v0[1] * v0[1]) + (v0[2] * v0[2] + v0[3] * v0[3]) + (v1[0] * v1[0] + v1[1] * v1[1]) + (v1[2] * v1[2] + v1[3] * v1[3]);
                    u32x4 w; w.x = cvt_pk_bf16(v0[0], v0[1]); w.y = cvt_pk_bf16(v0[2], v0[3]); w.z = cvt_pk_bf16(v1[0], v1[1]); w.w = cvt_pk_bf16(v1[2], v1[3]);
                    *(u32x4*)(rowp + bj * HALF) = w; }
                ss += shx<16>(ss); ss = sum32(ss); if (fq == 0) SS[(size_t)row * 32 + u.pn * 4 + wc] = ss; }
    }
};
struct EpiDown8 {
    static constexpr bool PERM = true, AFTER_DRAIN = false;
    bf16_t* O; int ld; float* SS; float sc;
    __device__ __forceinline__ void operator()(const f32x4 (&acc)[2][2][4][2], const Unit& u, int wr, int wc, int fr, int fq) const {
        const int row0 = u.pm * BM + wr * 64 + fr, col0 = u.pn * BM + wc * 32 + 8 * fq;
#pragma unroll
        for (int ai = 0; ai < 2; ++ai)
#pragma unroll
            for (int m = 0; m < 4; ++m) { const int row = row0 + ai * HALF + m * 16; bf16_t* rowp = O + (size_t)row * ld + col0; float ss = 0.f;
#pragma unroll
                for (int bj = 0; bj < 2; ++bj) { const f32x4 v0 = acc[ai][bj][m][0] * sc, v1 = acc[ai][bj][m][1] * sc;
                    ss += (v0[0] * v0[0] + v0[1] * v0[1]) + (v0[2] * v0[2] + v0[3] * v0[3]) + (v1[0] * v1[0] + v1[1] * v1[1]) + (v1[2] * v1[2] + v1[3] * v1[3]);
                    u32x4 w; w.x = cvt_pk_bf16(v0[0], v0[1]); w.y = cvt_pk_bf16(v0[2], v0[3]); w.z = cvt_pk_bf16(v1[0], v1[1]); w.w = cvt_pk_bf16(v1[2], v1[3]);
                    *(u32x4*)(rowp + bj * HALF) = w; }
                ss += shx<16>(ss); ss = sum32(ss); if (fq == 0) SS[(size_t)row * 32 + u.pn * 4 + wc] = ss; }
    }
};
template <bool NEXT> struct EpiPle {
    static constexpr bool PERM = true, AFTER_DRAIN = false, HGOUT = NEXT && !(QKV_I8);
    bf16_t* H16; float* OUT; const unsigned char* PP; const float* bias; int ld; bf16_t* HG; const float* gnext; float* SS; float asc;
    __device__ __forceinline__ void operator()(const f32x4 (&acc)[2][2][4][2], const Unit& u, int wr, int wc, int fr, int fq) const {
        const int row0 = u.pm * BM + wr * 64 + fr, col0 = u.pn * BM + wc * 32 + 8 * fq;
        float ssq[2][4];
#pragma unroll
        for (int ai = 0; ai < 2; ++ai)
#pragma unroll
            for (int m = 0; m < 4; ++m) ssq[ai][m] = 0.f;
#pragma unroll
        for (int bj = 0; bj < 2; ++bj) { const f32x4 b0 = *(const f32x4*)(bias + col0 + bj * HALF), b1 = *(const f32x4*)(bias + col0 + bj * HALF + 4);
            f32x4 g0 = (f32x4){0.f, 0.f, 0.f, 0.f}, g1 = g0; if (HGOUT) { g0 = *(const f32x4*)(gnext + col0 + bj * HALF); g1 = *(const f32x4*)(gnext + col0 + bj * HALF + 4); }
#pragma unroll
            for (int ai = 0; ai < 2; ++ai)
#pragma unroll
                for (int m = 0; m < 4; ++m) { const size_t off = (size_t)(row0 + ai * HALF + m * 16) * ld + col0 + bj * HALF;
                    const u32x2 pw8 = *(const u32x2*)(PP + off); const u32x4 hw = *(const u32x4*)(H16 + off);
                    f32x4 h0 = (f32x4){__uint_as_float(hw.x << 16), __uint_as_float(hw.x & 0xffff0000u), __uint_as_float(hw.y << 16), __uint_as_float(hw.y & 0xffff0000u)}, h1 = (f32x4){__uint_as_float(hw.z << 16), __uint_as_float(hw.z & 0xffff0000u), __uint_as_float(hw.w << 16), __uint_as_float(hw.w & 0xffff0000u)};
                    const f32x4 a0 = acc[ai][bj][m][0] * asc + b0, a1 = acc[ai][bj][m][1] * asc + b1;
                    { const f32x2 q0 = __builtin_amdgcn_cvt_pk_f32_fp8((int)pw8.x, false), q1 = __builtin_amdgcn_cvt_pk_f32_fp8((int)pw8.x, true), q2 = __builtin_amdgcn_cvt_pk_f32_fp8((int)pw8.y, false), q3 = __builtin_amdgcn_cvt_pk_f32_fp8((int)pw8.y, true);
                      const f32x4 pA = (f32x4){q0.x, q0.y, q1.x, q1.y}, pB = (f32x4){q2.x, q2.y, q3.x, q3.y};
#pragma unroll
                      for (int e = 0; e < 4; ++e) { h0[e] += pA[e] / (1.f + __expf(-a0[e])); h1[e] += pB[e] / (1.f + __expf(-a1[e])); } }
                    if (NEXT) { u32x4 ho; ho.x = cvt_pk_bf16(h0[0], h0[1]); ho.y = cvt_pk_bf16(h0[2], h0[3]); ho.z = cvt_pk_bf16(h1[0], h1[1]); ho.w = cvt_pk_bf16(h1[2], h1[3]); *(u32x4*)(H16 + off) = ho; }
                    else { *(f32x4*)(OUT + off) = h0; *(f32x4*)(OUT + off + 4) = h1; }
                    if (HGOUT) { ssq[ai][m] += (h0[0] * h0[0] + h0[1] * h0[1]) + (h0[2] * h0[2] + h0[3] * h0[3]) + (h1[0] * h1[0] + h1[1] * h1[1]) + (h1[2] * h1[2] + h1[3] * h1[3]);
                        const f32x4 x0 = h0 * g0, x1 = h1 * g1; u32x4 w; w.x = cvt_pk_bf16(x0[0], x0[1]); w.y = cvt_pk_bf16(x0[2], x0[3]); w.z = cvt_pk_bf16(x1[0], x1[1]); w.w = cvt_pk_bf16(x1[2], x1[3]);
                        *(u32x4*)(HG + off) = w; } } }
        if (HGOUT) {
#pragma unroll
            for (int ai = 0; ai < 2; ++ai)
#pragma unroll
                for (int m = 0; m < 4; ++m) { float t = ssq[ai][m]; t += shx<16>(t); t = sum32(t); if (fq == 0) SS[(size_t)(row0 + ai * HALF + m * 16) * 32 + u.pn * 4 + wc] = t; } }
    }
};
template <class Epi, class Sched, bool ALIGN_EPI = false, bool SP2 = false, int F8 = 0>
__device__ __forceinline__ void gemm_phase(PG8_LAS unsigned char* lds, const Gemm g, const Sched& S, const Epi& E) {
    int wid = g.wave; asm volatile("" : "+s"(wid));
    int tid = wid * 64 + lane_id(); asm volatile("" : "+v"(tid));
    const int lane = tid & 63, wr = wid >> 2, wc = wid & 3, fr = lane & 15, fq = lane >> 4;
    const int K = g.K, nt = K / BK;
    unsigned voffA[2], voffB[2];
#pragma unroll
    for (int i = 0; i < 2; ++i) { int R, C; stage_rc(tid * 16 + i * 8192, R, C); const int Rb = Epi::PERM ? ((R & ~31) + perm32(R & 31)) : R;
        voffA[i] = (unsigned)(R * g.lda + C) * 2u; voffB[i] = (unsigned)(Rb * K + C) * 2u; }
    const size_t kstep = (size_t)(BK * 2);
    const size_t hstepA = (size_t)HALF * g.lda * 2, hstepB = (size_t)HALF * K * 2;
    const size_t tstepA = 2 * hstepA, tstepB = 2 * hstepB;
    const unsigned ldsw = (unsigned)wid * 1024u;
    const int aoff = lds_byte(wr * 64 + fr, fq * 8), boff = lds_byte(wc * 32 + fr, fq * 8);
#define PG8_SA(b, h) (((b) * 2 + (h)) * HTB)
#define PG8_SB(b, h) ((4 + (b) * 2 + (h)) * HTB)
#define PG8_STAGE(bufoff, gbase, voff) do { _Pragma("unroll") for (int _i = 0; _i < 2; ++_i) { unsigned vo_ = (voff)[_i]; asm volatile("" : "+v"(vo_));     \
        __builtin_amdgcn_global_load_lds((const unsigned*)((const char*)(gbase) + vo_), (PG8_LAS unsigned*)(lds + (bufoff) + ldsw + _i * 8192), 16, 0, 0); } } while (0)
#define PG8_LDA(dst, b, h) do { _Pragma("unroll") for (int m = 0; m < 4; ++m) _Pragma("unroll") for (int k = 0; k < 2; ++k) dst[m][k] = *(const PG8_LAS bf16x8*)(lds + PG8_SA(b, h) + aoff + m * 2048 + k * 1024); } while (0)
#define PG8_LDB(dst, b, h) do { _Pragma("unroll") for (int n = 0; n < 2; ++n) _Pragma("unroll") for (int k = 0; k < 2; ++k) dst[n][k] = *(const PG8_LAS bf16x8*)(lds + PG8_SB(b, h) + boff + n * 2048 + k * 1024); } while (0)
#define PG8_CAT8(x, y) __builtin_shufflevector(__builtin_bit_cast(i32x4, x), __builtin_bit_cast(i32x4, y), 0, 1, 2, 3, 4, 5, 6, 7)
#define PG8_MMA(ai, bj, At, Bt) do { __builtin_amdgcn_s_setprio(1); \
        if constexpr (F8 == 2) { _Pragma("unroll") for (int m = 0; m < 4; ++m) _Pragma("unroll") for (int n = 0; n < 2; ++n) _Pragma("unroll") for (int k = 0; k < 2; ++k) \
            acc[ai][bj][m][n] = __builtin_bit_cast(f32x4, __builtin_amdgcn_mfma_i32_16x16x64_i8(__builtin_bit_cast(i32x4, Bt[n][k]), __builtin_bit_cast(i32x4, At[m][k]), __builtin_bit_cast(i32x4, acc[ai][bj][m][n]), 0, 0, 0)); } \
        else if constexpr (F8 == 1) { _Pragma("unroll") for (int m = 0; m < 4; ++m) _Pragma("unroll") for (int n = 0; n < 2; ++n) \
            acc[ai][bj][m][n] = __builtin_amdgcn_mfma_scale_f32_16x16x128_f8f6f4(PG8_CAT8(Bt[n][0], Bt[n][1]), PG8_CAT8(At[m][0], At[m][1]), acc[ai][bj][m][n], 0, 0, 0, 0x7f7f7f7f, 0, 0x7f7f7f7f); } \
        else { _Pragma("unroll") for (int m = 0; m < 4; ++m) _Pragma("unroll") for (int n = 0; n < 2; ++n) _Pragma("unroll") for (int k = 0; k < 2; ++k) \
            acc[ai][bj][m][n] = __builtin_amdgcn_mfma_f32_16x16x32_bf16(Bt[n][k], At[m][k], acc[ai][bj][m][n], 0, 0, 0); } \
        __builtin_amdgcn_s_setprio(0); } while (0)
#define PG8_WAIT_V(n) asm volatile("s_waitcnt vmcnt(" #n ")" ::: "memory")
#define PG8_WAIT_L(n) asm volatile("s_waitcnt lgkmcnt(" #n ")" ::: "memory")
#define PG8_BAR __builtin_amdgcn_s_barrier()
#define PG8_SCHED __builtin_amdgcn_sched_barrier(0)
    Unit cur, nxt; int ui = 0;
    if (!S.next(0, cur)) return;
    f32x4 acc[2][2][4][2];
#pragma unroll
    for (int a = 0; a < 2; ++a)
#pragma unroll
        for (int b = 0; b < 2; ++b)
#pragma unroll
            for (int m = 0; m < 4; ++m)
#pragma unroll
                for (int n = 0; n < 2; ++n) acc[a][b][m][n] = (f32x4){0.f, 0.f, 0.f, 0.f};
    bf16x8 At[4][2], B0[2][2], B1[2][2];
    const char* cA = (const char*)g.A + (size_t)cur.pm * tstepA; const char* cB = (const char*)g.Bt + (size_t)cur.pn * tstepB;
    S.a_ready(cur);
    if constexpr (SP2) {
        PG8_STAGE(PG8_SB(0, 0), cB, voffB); PG8_STAGE(PG8_SB(0, 1), cB + hstepB, voffB); PG8_STAGE(PG8_SA(0, 0), cA, voffA); PG8_STAGE(PG8_SA(0, 1), cA + hstepA, voffA);
        if (wr == 1) PG8_BAR;
        PG8_WAIT_V(2); PG8_BAR;
        PG8_STAGE(PG8_SB(1, 0), cB + kstep, voffB); PG8_STAGE(PG8_SA(1, 0), cA + kstep, voffA); PG8_STAGE(PG8_SB(1, 1), cB + hstepB + kstep, voffB);
        PG8_WAIT_V(6); PG8_BAR;
    } else {
        PG8_STAGE(PG8_SB(0, 0), cB, voffB); PG8_STAGE(PG8_SA(0, 0), cA, voffA); PG8_STAGE(PG8_SB(0, 1), cB + hstepB, voffB); PG8_STAGE(PG8_SA(0, 1), cA + hstepA, voffA);
        if (wr == 1) PG8_BAR;
        PG8_WAIT_V(4); PG8_BAR;
        PG8_STAGE(PG8_SB(1, 0), cB + kstep, voffB); PG8_STAGE(PG8_SA(1, 0), cA + kstep, voffA); PG8_STAGE(PG8_SB(1, 1), cB + hstepB + kstep, voffB);
        PG8_WAIT_V(6); PG8_BAR;
    }
    for (;;) {
        const bool has_next = S.next(ui + 1, nxt);
        const char* nA = has_next ? (const char*)g.A + (size_t)nxt.pm * tstepA : cA; const char* nB = has_next ? (const char*)g.Bt + (size_t)nxt.pn * tstepB : cB;
        for (int t = 0; t < nt; t += 2) {
            const bool last = (t == nt - 2);
            const char* a1 = cA + (size_t)(t + 1) * kstep;
            const char* a2 = last ? nA : cA + (size_t)(t + 2) * kstep; const char* b2 = last ? nB : cB + (size_t)(t + 2) * kstep;
            const char* a3 = a2 + kstep; const char* b3 = b2 + kstep;
            if (last && has_next) S.a_ready(nxt);
            if constexpr (SP2) {
            PG8_LDB(B0, 0, 0); PG8_LDB(B1, 0, 1); PG8_SCHED; PG8_LDA(At, 0, 0); PG8_STAGE(PG8_SA(1, 1), a1 + hstepA, voffA);
            PG8_WAIT_V(8); PG8_WAIT_L(0); PG8_BAR; PG8_MMA(0, 0, At, B0); PG8_MMA(0, 1, At, B1); PG8_BAR; PG8_SCHED;
            PG8_LDA(At, 0, 1); PG8_STAGE(PG8_SB(0, 0), b2, voffB); PG8_STAGE(PG8_SB(0, 1), b2 + hstepB, voffB); PG8_STAGE(PG8_SA(0, 0), a2, voffA);
            PG8_WAIT_V(8); PG8_WAIT_L(0); PG8_BAR; PG8_MMA(1, 0, At, B0); PG8_MMA(1, 1, At, B1); PG8_BAR; PG8_SCHED;
            PG8_LDB(B0, 1, 0); PG8_LDB(B1, 1, 1); PG8_SCHED; PG8_LDA(At, 1, 0); PG8_STAGE(PG8_SA(0, 1), a2 + hstepA, voffA);
            PG8_WAIT_V(8); PG8_WAIT_L(0); PG8_BAR; PG8_MMA(0, 0, At, B0); PG8_MMA(0, 1, At, B1); PG8_BAR; PG8_SCHED;
            PG8_LDA(At, 1, 1); PG8_STAGE(PG8_SB(1, 0), b3, voffB); PG8_STAGE(PG8_SB(1, 1), b3 + hstepB, voffB); PG8_STAGE(PG8_SA(1, 0), a3, voffA);
            PG8_WAIT_V(8); PG8_WAIT_L(0); PG8_BAR; PG8_MMA(1, 0, At, B0); PG8_MMA(1, 1, At, B1); PG8_BAR; PG8_SCHED;
            } else {
            PG8_LDB(B0, 0, 0); PG8_SCHED; PG8_LDA(At, 0, 0); PG8_STAGE(PG8_SA(1, 1), a1 + hstepA, voffA);
            PG8_WAIT_L(8); PG8_BAR; PG8_WAIT_L(0); PG8_MMA(0, 0, At, B0); PG8_BAR; PG8_SCHED;
            PG8_LDB(B1, 0, 1); PG8_STAGE(PG8_SB(0, 0), b2, voffB);
            PG8_BAR; PG8_WAIT_L(0); PG8_MMA(0, 1, At, B1); PG8_BAR;
            PG8_LDA(At, 0, 1); PG8_STAGE(PG8_SA(0, 0), a2, voffA);
            PG8_BAR; PG8_WAIT_L(0); PG8_MMA(1, 0, At, B0); PG8_BAR; PG8_SCHED;
            PG8_STAGE(PG8_SB(0, 1), b2 + hstepB, voffB);
            PG8_WAIT_V(6); PG8_BAR; PG8_MMA(1, 1, At, B1); PG8_BAR;
            PG8_LDB(B0, 1, 0); PG8_SCHED; PG8_LDA(At, 1, 0); PG8_STAGE(PG8_SA(0, 1), a2 + hstepA, voffA);
            PG8_WAIT_L(8); PG8_BAR; PG8_WAIT_L(0); PG8_MMA(0, 0, At, B0); PG8_BAR; PG8_SCHED;
            PG8_LDB(B1, 1, 1); PG8_STAGE(PG8_SB(1, 0), b3, voffB);
            PG8_BAR; PG8_WAIT_L(0); PG8_MMA(0, 1, At, B1); PG8_BAR;
            PG8_LDA(At, 1, 1); PG8_STAGE(PG8_SA(1, 0), a3, voffA);
            PG8_BAR; PG8_WAIT_L(0); PG8_MMA(1, 0, At, B0); PG8_BAR; PG8_SCHED;
            PG8_STAGE(PG8_SB(1, 1), b3 + hstepB, voffB);
            PG8_WAIT_V(6); PG8_BAR; PG8_MMA(1, 1, At, B1); PG8_BAR;
            }
        }
        if constexpr (ALIGN_EPI) { if (wr == 0) PG8_BAR; }
        if constexpr (!Epi::AFTER_DRAIN) { int l2 = lane_id(); asm volatile("" : "+v"(l2));
            const int w2 = wid; E(acc, cur, w2 >> 2, w2 & 3, l2 & 15, l2 >> 4); S.done(cur); }
        if (!has_next) break;
#pragma unroll
        for (int a = 0; a < 2; ++a)
#pragma unroll
            for (int b = 0; b < 2; ++b)
#pragma unroll
                for (int m = 0; m < 4; ++m)
#pragma unroll
                    for (int n = 0; n < 2; ++n) acc[a][b][m][n] = (f32x4){0.f, 0.f, 0.f, 0.f};
        cur = nxt; cA = nA; cB = nB; ++ui;
        if constexpr (ALIGN_EPI) { if (wr == 1) PG8_BAR; }
    }
    PG8_WAIT_V(0);
    if constexpr (!ALIGN_EPI) { if (wr == 0) PG8_BAR; }
    PG8_BAR;
    if constexpr (Epi::AFTER_DRAIN) { E.fused(acc, cur, wr, wc, fr, fq, lds, wid, lane); S.done(cur); }
#undef PG8_SA
#undef PG8_SB
#undef PG8_STAGE
#undef PG8_LDA
#undef PG8_LDB
#undef PG8_MMA
#undef PG8_CAT8
#undef PG8_WAIT_V
#undef PG8_WAIT_L
#undef PG8_BAR
#undef PG8_SCHED
}
}

namespace att {
typedef unsigned short bf16_t;
typedef short bf16x8 __attribute__((ext_vector_type(8)));
typedef short s16x4 __attribute__((ext_vector_type(4)));
typedef float f32x16 __attribute__((ext_vector_type(16)));
typedef float f32x4 __attribute__((ext_vector_type(4)));
typedef unsigned u32x4 __attribute__((ext_vector_type(4)));
constexpr int NW = 8, QBLK = 32, KVBLK = 64, SHM_V = 16384;
constexpr int LDS_V = 0, LDS_K = 2 * SHM_V, LDS_WS = LDS_K + 2 * 32768, LDS_OTAB = LDS_WS + NW * 256, LDS_PFX = LDS_OTAB + NW * 128, LDS_END = LDS_PFX + 8192;
#define SBAR() __builtin_amdgcn_sched_barrier(0)
__device__ __forceinline__ int v_st(int k, int c) { const int kk = (k & ~0xC) | ((k & 4) << 1) | ((k & 8) >> 1); return ((kk >> 3) * 4 + (c >> 5)) * 512 + ((kk & 7) * 32 + (c & 31)) * 2; }
__device__ __forceinline__ int v_rd_base(int lane) { return ((lane & 3) << 3) | (((lane >> 2) & 3) << 6) | (((lane >> 4) & 1) << 5) | (((lane >> 5) & 1) << 8); }
constexpr int v_rd_off(int d0, int ks, int half) { return d0 * 512 + ks * 4096 + half * 2048; }
__device__ __forceinline__ int crow(int r, int hi) { return (r & 3) + 8 * (r >> 2) + 4 * hi; }
__device__ __forceinline__ unsigned cvtpk(float lo, float hi) { unsigned r; asm volatile("v_cvt_pk_bf16_f32 %0, %1, %2" : "=v"(r) : "v"(lo), "v"(hi)); return r; }
__device__ __forceinline__ float bf2f(unsigned short x) { return __uint_as_float((unsigned)x << 16); }
template <int DQK> __device__ __forceinline__ int kswz(int row, int colB) { return row * (DQK * 2) + (colB ^ ((row & 7) << 4)); }
__device__ __forceinline__ void mask_tile(f32x16& p0, f32x16& p1, int dq, unsigned W) {
    const float NEG = -__builtin_inff();
#pragma unroll
    for (int r = 0; r < 16; ++r) { const int c = (r & 3) + 8 * (r >> 2);
        if ((unsigned)(dq - c) >= W) p0[r] = NEG;
        if ((unsigned)(dq - c - 32) >= W) p1[r] = NEG; }
}
__device__ __forceinline__ void partialSM(f32x16& p0, f32x16& p1, float& m_reg, float& alpha, float sc, float c2) {
    float pmax = p0[0];
#pragma unroll
    for (int r = 1; r < 16; ++r) pmax = fmaxf(pmax, p0[r]);
#pragma unroll
    for (int r = 0; r < 16; ++r) pmax = fmaxf(pmax, p1[r]);
    { auto rr = __builtin_amdgcn_permlane32_swap(__float_as_uint(pmax), __float_as_uint(pmax), false, false);
      pmax = fmaxf(__uint_as_float(rr[0]), __uint_as_float(rr[1])); }
    float mn;
    if (__builtin_expect(__all((pmax - m_reg) * sc <= 8.f), 1)) { mn = m_reg; alpha = 1.f; }
    else { mn = fmaxf(m_reg, pmax); alpha = __builtin_amdgcn_exp2f((m_reg - mn) * c2); m_reg = mn; }
    const float mnL = -mn * c2;
#pragma unroll
    for (int r = 0; r < 16; ++r) p0[r] = __builtin_amdgcn_exp2f(fmaf(p0[r], c2, mnL));
#pragma unroll
    for (int r = 0; r < 16; ++r) p1[r] = __builtin_amdgcn_exp2f(fmaf(p1[r], c2, mnL));
}
__device__ __forceinline__ void finishSM(f32x16& p0, f32x16& p1, float alpha, float& l_reg, bf16x8& pa0, bf16x8& pa1, bf16x8& pa2, bf16x8& pa3) {
    float ps = 0;
#pragma unroll
    for (int r = 0; r < 16; ++r) ps += p0[r];
#pragma unroll
    for (int r = 0; r < 16; ++r) ps += p1[r];
    { auto rr = __builtin_amdgcn_permlane32_swap(__float_as_uint(ps), __float_as_uint(ps), false, false);
      ps = __uint_as_float(rr[0]) + __uint_as_float(rr[1]); }
    l_reg = l_reg * alpha + ps;
#define PK4(P, B_, OUT) do { unsigned a0 = cvtpk(P[B_+0], P[B_+1]), a1 = cvtpk(P[B_+2], P[B_+3]);                          \
        unsigned b0 = cvtpk(P[B_+4], P[B_+5]), b1 = cvtpk(P[B_+6], P[B_+7]);                                             \
        auto r0 = __builtin_amdgcn_permlane32_swap(a0, b0, false, false); auto r1 = __builtin_amdgcn_permlane32_swap(a1, b1, false, false); \
        u32x4 w = {r0[0], r1[0], r0[1], r1[1]}; OUT = *reinterpret_cast<bf16x8*>(&w); } while (0)
    PK4(p0, 0, pa0); PK4(p0, 8, pa1); PK4(p1, 0, pa2); PK4(p1, 8, pa3);
#undef PK4
}
template <int DQK>
__device__ __forceinline__ void qkt(f32x16& p0, f32x16& p1, const char* Kbuf, int r32, int hi, const bf16x8* qr) {
    p0 = f32x16{}; p1 = f32x16{};
    const int sw = (r32 & 7) << 4; const char* rb = Kbuf + r32 * (DQK * 2);
#pragma unroll
    for (int d0 = 0; d0 < DQK / 16; ++d0) { const char* a = rb + ((d0 * 32 + hi * 16) ^ sw);
        const bf16x8 b0 = *reinterpret_cast<const bf16x8*>(a);
        const bf16x8 b1 = *reinterpret_cast<const bf16x8*>(a + 32 * DQK * 2);
        p0 = __builtin_amdgcn_mfma_f32_32x32x16_bf16(b0, qr[d0], p0, 0, 0, 0);
        p1 = __builtin_amdgcn_mfma_f32_32x32x16_bf16(b1, qr[d0], p1, 0, 0, 0); }
}
template <int DV>
__device__ __forceinline__ void pv_tile(f32x16* o, int vb, bf16x8 pa0, bf16x8 pa1, bf16x8 pa2, bf16x8 pa3) {
#define TRRD(dst, off) asm volatile("ds_read_b64_tr_b16 %0, %1 offset:%2" : "=&v"(dst) : "v"(vb), "i"(off) : "memory")
#define PV_KS(ks, PA) do { s16x4 l0, h0, l1, h1, l2, h2, l3, h3; constexpr int b_ = v_rd_off(0, ks, 0);   \
        TRRD(l0, b_); TRRD(h0, b_ + 2048); TRRD(l1, b_ + 512); TRRD(h1, b_ + 512 + 2048); \
        if constexpr (DV == 128) { TRRD(l2, b_ + 1024); TRRD(h2, b_ + 1024 + 2048); TRRD(l3, b_ + 1536); TRRD(h3, b_ + 1536 + 2048); } \
        asm volatile("s_waitcnt lgkmcnt(0)" ::: "memory"); SBAR();   \
        o[0] = __builtin_amdgcn_mfma_f32_32x32x16_bf16(PA, (bf16x8){l0[0], l0[1], l0[2], l0[3], h0[0], h0[1], h0[2], h0[3]}, o[0], 0, 0, 0);   \
        o[1] = __builtin_amdgcn_mfma_f32_32x32x16_bf16(PA, (bf16x8){l1[0], l1[1], l1[2], l1[3], h1[0], h1[1], h1[2], h1[3]}, o[1], 0, 0, 0);   \
        if constexpr (DV == 128) { \
        o[2] = __builtin_amdgcn_mfma_f32_32x32x16_bf16(PA, (bf16x8){l2[0], l2[1], l2[2], l2[3], h2[0], h2[1], h2[2], h2[3]}, o[2], 0, 0, 0);   \
        o[3] = __builtin_amdgcn_mfma_f32_32x32x16_bf16(PA, (bf16x8){l3[0], l3[1], l3[2], l3[3], h3[0], h3[1], h3[2], h3[3]}, o[3], 0, 0, 0); } } while (0)
    PV_KS(0, pa0); PV_KS(1, pa1); PV_KS(2, pa2); PV_KS(3, pa3);
#undef PV_KS
#undef TRRD
}
struct Job {
    const bf16_t* K; long ldk;
    const bf16_t* K2; long ldk2;
    const bf16_t* V; long ldv;
    int j_lo, j_hi;
    int wave;
    int wq_lo;
    int qpos;
    unsigned W;
    int nomask;
    float m0, l0;
    float sc, c2;
};
template <int DQK, int DV>
__device__ __forceinline__ void attn_core(__attribute__((address_space(3))) unsigned char* lds3, const Job& J, const bf16x8* qr, f32x16* o, float& m_reg, float& l_reg) {
    constexpr int KB = KVBLK * DQK * 2, NKC = DQK / 8, NKT = DQK / 64, NVT = DV / 64;
    char* lds = (char*)lds3;
    int wid = J.wave; asm volatile("" : "+s"(wid)); int tid = wid * 64 + lane_id(); asm volatile("" : "+v"(tid));
    const int lane = tid & 63, r32 = lane & 31, hi = lane >> 5;
    char* V_lds = lds + LDS_V; char* K_lds = lds + LDS_K;
    float* al_l = (float*)(lds + LDS_WS) + wid * 64 + 32;
    const bf16_t* ksrc[NKT]; long kld[NKT]; const bf16_t* vsrc[NVT];
#pragma unroll
    for (int i = 0; i < NKT; ++i) { const int q = (wid * NKT + i) * 64 + lane, row = q / NKC, pos = q % NKC, ch = pos ^ (row & 7);
        if (DQK == 192 && ch >= 16) { ksrc[i] = J.K2 + (long)row * J.ldk2 + (ch - 16) * 8; kld[i] = J.ldk2; } else { ksrc[i] = J.K + (long)row * J.ldk + ch * 8; kld[i] = J.ldk; } }
#pragma unroll
    for (int i = 0; i < NVT; ++i) { const int m = (DV == 128) ? (wid * 2 + i) : (wid * 2), q = m * 64 + lane, st = q >> 5, w = q & 31, kk = ((st >> 2) << 3) | (w >> 2), c = (st & 3) * 32 + (w & 3) * 8;
        const int k = (kk & ~0xC) | ((kk & 4) << 1) | ((kk & 8) >> 1); vsrc[i] = J.V + (long)k * J.ldv + c; }
#define LOADT(j, bf) do { const long kb_ = (long)(j) * KVBLK; \
        _Pragma("unroll") for (int i = 0; i < NKT; ++i) __builtin_amdgcn_global_load_lds((const unsigned*)(ksrc[i] + kb_ * kld[i]), (__attribute__((address_space(3))) unsigned*)(lds3 + LDS_K + (bf) * KB + (wid * NKT + i) * 1024), 16, 0, 0); \
        _Pragma("unroll") for (int i = 0; i < NVT; ++i) __builtin_amdgcn_global_load_lds((const unsigned*)(vsrc[i] + kb_ * J.ldv), (__attribute__((address_space(3))) unsigned*)(lds3 + LDS_V + (bf) * SHM_V + ((DV == 128) ? (wid * 2 + i) : (wid * 2)) * 1024), 16, 0, 0); } while (0)
    const int vb0 = (int)(uintptr_t)V_lds + v_rd_base(lane);
    m_reg = J.m0; l_reg = J.l0;
#pragma unroll
    for (int d = 0; d < DV / 32; ++d) o[d] = f32x16{};
    const int NT = J.j_hi - J.j_lo;
    LOADT(J.j_lo, 0); asm volatile("s_waitcnt vmcnt(0)" ::: "memory"); __syncthreads();
    for (int t = 0; t < NT; ++t) {
        const int bf = t & 1, kbase = (J.j_lo + t) * KVBLK;
        if (t + 1 < NT) LOADT(J.j_lo + t + 1, bf ^ 1);
        const bool act = J.nomask || ((kbase <= J.wq_lo + QBLK - 1) && (kbase + KVBLK - 1 >= J.wq_lo - (int)J.W + 1));
        if (act) {
            f32x16 p0, p1; bf16x8 pa0, pa1, pa2, pa3; float alpha;
            qkt<DQK>(p0, p1, K_lds + bf * KB, r32, hi, qr);
            if (!J.nomask && (kbase + KVBLK - 1 > J.wq_lo || kbase <= J.wq_lo + QBLK - 1 - (int)J.W)) mask_tile(p0, p1, J.qpos - 4 * hi - kbase, J.W);
            partialSM(p0, p1, m_reg, alpha, J.sc, J.c2);
            if (__any(alpha < 1.f)) { if (hi == 0) al_l[r32] = alpha; asm volatile("s_waitcnt lgkmcnt(0)" ::: "memory");
#pragma unroll
                for (int d_ = 0; d_ < DV / 32; ++d_)
#pragma unroll
                    for (int r = 0; r < 16; ++r) o[d_][r] *= al_l[crow(r, hi)]; }
            finishSM(p0, p1, alpha, l_reg, pa0, pa1, pa2, pa3); SBAR();
            pv_tile<DV>(o, vb0 + bf * SHM_V, pa0, pa1, pa2, pa3);
        }
        asm volatile("s_waitcnt vmcnt(0)" ::: "memory");
        __syncthreads();
    }
#undef LOADT
}

typedef int i32x8 __attribute__((ext_vector_type(8)));
typedef int i32x4v __attribute__((ext_vector_type(4)));
struct Job8 { const unsigned char* Kn; const unsigned char* Kr; };
template <int DV>
__device__ __forceinline__ void attn_core_k8(__attribute__((address_space(3))) unsigned char* lds3, const Job& J, const Job8& J8, const i32x8* qf, f32x16* o, float& m_reg, float& l_reg) {
    constexpr int KB8 = KVBLK * 256, NVT = DV / 64;
    char* lds = (char*)lds3;
    int wid = J.wave; asm volatile("" : "+s"(wid)); int tid = wid * 64 + lane_id(); asm volatile("" : "+v"(tid));
    const int lane = tid & 63, r32 = lane & 31, hi = lane >> 5;
    char* V_lds = lds + LDS_V; char* K_lds = lds + LDS_K;
    float* al_l = (float*)(lds + LDS_WS) + wid * 64 + 32;
    const unsigned char* ksrc[2]; long kld[2]; const bf16_t* vsrc[NVT];
#pragma unroll
    for (int i = 0; i < 2; ++i) { const int q = (wid * 2 + i) * 64 + lane, row = q >> 4, pos = q & 15; int c = pos ^ (row & 15); if (c > 11) c = 11;
        if (c >= 8) { ksrc[i] = J8.Kr + (long)row * 64 + (c - 8) * 16; kld[i] = 64; } else { ksrc[i] = J8.Kn + (long)row * 1024 + c * 16; kld[i] = 1024; } }
#pragma unroll
    for (int i = 0; i < NVT; ++i) { const int m = (DV == 128) ? (wid * 2 + i) : (wid * 2), q = m * 64 + lane, st = q >> 5, w = q & 31, kk = ((st >> 2) << 3) | (w >> 2), c = (st & 3) * 32 + (w & 3) * 8;
        const int k = (kk & ~0xC) | ((kk & 4) << 1) | ((kk & 8) >> 1); vsrc[i] = J.V + (long)k * J.ldv + c; }
#define LOADT8(j, bf) do { const long kb_ = (long)(j) * KVBLK; \
        _Pragma("unroll") for (int i = 0; i < 2; ++i) __builtin_amdgcn_global_load_lds((const unsigned*)(ksrc[i] + kb_ * kld[i]), (__attribute__((address_space(3))) unsigned*)(lds3 + LDS_K + (bf) * KB8 + (wid * 2 + i) * 1024), 16, 0, 0); \
        _Pragma("unroll") for (int i = 0; i < NVT; ++i) __builtin_amdgcn_global_load_lds((const unsigned*)(vsrc[i] + kb_ * J.ldv), (__attribute__((address_space(3))) unsigned*)(lds3 + LDS_V + (bf) * SHM_V + ((DV == 128) ? (wid * 2 + i) : (wid * 2)) * 1024), 16, 0, 0); } while (0)
    const int vb0 = (int)(uintptr_t)V_lds + v_rd_base(lane);
    m_reg = J.m0; l_reg = J.l0;
#pragma unroll
    for (int d = 0; d < DV / 32; ++d) o[d] = f32x16{};
    const int NT = J.j_hi - J.j_lo;
    LOADT8(J.j_lo, 0); asm volatile("s_waitcnt vmcnt(0)" ::: "memory"); __syncthreads();
    for (int t = 0; t < NT; ++t) {
        const int bf = t & 1, kbase = (J.j_lo + t) * KVBLK;
        if (t + 1 < NT) LOADT8(J.j_lo + t + 1, bf ^ 1);
        const bool act = J.nomask || ((kbase <= J.wq_lo + QBLK - 1) && (kbase + KVBLK - 1 >= J.wq_lo - (int)J.W + 1));
        if (act) {
            f32x16 p0 = f32x16{}, p1 = f32x16{}; bf16x8 pa0, pa1, pa2, pa3; float alpha;
            { const char* rb = K_lds + bf * KB8 + r32 * 256; const int sw = r32 & 15;
#pragma unroll
              for (int g = 0; g < 3; ++g) { const int c0 = (4 * g + 2 * hi) ^ sw;
                  const i32x4v a0 = *reinterpret_cast<const i32x4v*>(rb + (c0 << 4)), a1 = *reinterpret_cast<const i32x4v*>(rb + ((c0 ^ 1) << 4));
                  const i32x4v b0 = *reinterpret_cast<const i32x4v*>(rb + 32 * 256 + (c0 << 4)), b1 = *reinterpret_cast<const i32x4v*>(rb + 32 * 256 + ((c0 ^ 1) << 4));
                  const i32x8 A0 = __builtin_shufflevector(a0, a1, 0, 1, 2, 3, 4, 5, 6, 7), A1 = __builtin_shufflevector(b0, b1, 0, 1, 2, 3, 4, 5, 6, 7);
                  p0 = __builtin_amdgcn_mfma_scale_f32_32x32x64_f8f6f4(A0, qf[g], p0, 0, 0, 0, 0x7f7f7f7f, 0, 0x7f7f7f7f);
                  p1 = __builtin_amdgcn_mfma_scale_f32_32x32x64_f8f6f4(A1, qf[g], p1, 0, 0, 0, 0x7f7f7f7f, 0, 0x7f7f7f7f); } }
            if (!J.nomask && (kbase + KVBLK - 1 > J.wq_lo || kbase <= J.wq_lo + QBLK - 1 - (int)J.W)) mask_tile(p0, p1, J.qpos - 4 * hi - kbase, J.W);
            partialSM(p0, p1, m_reg, alpha, J.sc, J.c2);
            if (__any(alpha < 1.f)) { if (hi == 0) al_l[r32] = alpha; asm volatile("s_waitcnt lgkmcnt(0)" ::: "memory");
#pragma unroll
                for (int d_ = 0; d_ < DV / 32; ++d_)
#pragma unroll
                    for (int r = 0; r < 16; ++r) o[d_][r] *= al_l[crow(r, hi)]; }
            finishSM(p0, p1, alpha, l_reg, pa0, pa1, pa2, pa3); SBAR();
            pv_tile<DV>(o, vb0 + bf * SHM_V, pa0, pa1, pa2, pa3);
        }
        asm volatile("s_waitcnt vmcnt(0)" ::: "memory");
        __syncthreads();
    }
#undef LOADT8
}

struct Job8v { const unsigned char* Kn; const unsigned char* Kr; const unsigned char* Vt; long ldvt; };
template <int DV>
__device__ __forceinline__ void attn_core_kv8(__attribute__((address_space(3))) unsigned char* lds3, const Job& J, const Job8v& J8, const i32x8* qf, f32x16* o, float& m_reg, float& l_reg) {
    constexpr int KB8 = KVBLK * 256, VB8 = DV * 64;
    static_assert(DV == 128, "one LDS-DMA instruction per wave fills the 128 x 64 B V^T tile");
    char* lds = (char*)lds3;
    int wid = J.wave; asm volatile("" : "+s"(wid)); int tid = wid * 64 + lane_id(); asm volatile("" : "+v"(tid));
    const int lane = tid & 63, r32 = lane & 31, hi = lane >> 5;
    char* V_lds = lds + LDS_V; char* K_lds = lds + LDS_K;
    float* al_l = (float*)(lds + LDS_WS) + wid * 64 + 32;
    const unsigned char* ksrc[2]; long kld[2]; const unsigned char* vsrc;
#pragma unroll
    for (int i = 0; i < 2; ++i) { const int q = (wid * 2 + i) * 64 + lane, row = q >> 4, pos = q & 15; int c = pos ^ (row & 15); if (c > 11) c = 11;
        if (c >= 8) { ksrc[i] = J8.Kr + (long)row * 64 + (c - 8) * 16; kld[i] = 64; } else { ksrc[i] = J8.Kn + (long)row * 1024 + c * 16; kld[i] = 1024; } }
    { const int q = wid * 64 + lane, row = q >> 2, pos = q & 3, c = pos ^ ((row >> 2) & 3); vsrc = J8.Vt + (long)row * J8.ldvt + c * 16; }
#define LOADT9(j, bf) do { const long kb_ = (long)(j) * KVBLK; \
        _Pragma("unroll") for (int i = 0; i < 2; ++i) __builtin_amdgcn_global_load_lds((const unsigned*)(ksrc[i] + kb_ * kld[i]), (__attribute__((address_space(3))) unsigned*)(lds3 + LDS_K + (bf) * KB8 + (wid * 2 + i) * 1024), 16, 0, 0); \
        __builtin_amdgcn_global_load_lds((const unsigned*)(vsrc + kb_), (__attribute__((address_space(3))) unsigned*)(lds3 + LDS_V + (bf) * VB8 + wid * 1024), 16, 0, 0); } while (0)
    m_reg = J.m0; l_reg = J.l0;
#pragma unroll
    for (int d = 0; d < DV / 32; ++d) o[d] = f32x16{};
    const int NT = J.j_hi - J.j_lo;
    LOADT9(J.j_lo, 0); asm volatile("s_waitcnt vmcnt(0)" ::: "memory"); __syncthreads();
    const int swv = (r32 >> 2) & 3;
    for (int t = 0; t < NT; ++t) {
        const int bf = t & 1, kbase = (J.j_lo + t) * KVBLK;
        if (t + 1 < NT) LOADT9(J.j_lo + t + 1, bf ^ 1);
        const bool act = J.nomask || ((kbase <= J.wq_lo + QBLK - 1) && (kbase + KVBLK - 1 >= J.wq_lo - (int)J.W + 1));
        if (act) {
            f32x16 p0 = f32x16{}, p1 = f32x16{}; float alpha;
            { const char* rb = K_lds + bf * KB8 + r32 * 256; const int sw = r32 & 15;
#pragma unroll
              for (int g = 0; g < 3; ++g) { const int c0 = (4 * g + 2 * hi) ^ sw;
                  const i32x4v a0 = *reinterpret_cast<const i32x4v*>(rb + (c0 << 4)), a1 = *reinterpret_cast<const i32x4v*>(rb + ((c0 ^ 1) << 4));
                  const i32x4v b0 = *reinterpret_cast<const i32x4v*>(rb + 32 * 256 + (c0 << 4)), b1 = *reinterpret_cast<const i32x4v*>(rb + 32 * 256 + ((c0 ^ 1) << 4));
                  const i32x8 A0 = __builtin_shufflevector(a0, a1, 0, 1, 2, 3, 4, 5, 6, 7), A1 = __builtin_shufflevector(b0, b1, 0, 1, 2, 3, 4, 5, 6, 7);
                  p0 = __builtin_amdgcn_mfma_scale_f32_32x32x64_f8f6f4(A0, qf[g], p0, 0, 0, 0, 0x7f7f7f7f, 0, 0x7f7f7f7f);
                  p1 = __builtin_amdgcn_mfma_scale_f32_32x32x64_f8f6f4(A1, qf[g], p1, 0, 0, 0, 0x7f7f7f7f, 0, 0x7f7f7f7f); } }
            if (!J.nomask && (kbase + KVBLK - 1 > J.wq_lo || kbase <= J.wq_lo + QBLK - 1 - (int)J.W)) mask_tile(p0, p1, J.qpos - 4 * hi - kbase, J.W);
            {
                float pmax = p0[0];
#pragma unroll
                for (int r = 1; r < 16; ++r) pmax = fmaxf(pmax, p0[r]);
#pragma unroll
                for (int r = 0; r < 16; ++r) pmax = fmaxf(pmax, p1[r]);
                pmax = max32(pmax);
                float mn;
                if (__builtin_expect(__all((pmax - m_reg) * J.sc <= 5.f), 1)) { mn = m_reg; alpha = 1.f; }
                else { mn = fmaxf(m_reg, pmax); alpha = __builtin_amdgcn_exp2f((m_reg - mn) * J.c2); m_reg = mn; }
                const float mnL = -mn * J.c2; float ps = 0.f;
#pragma unroll
                for (int r = 0; r < 16; ++r) { p0[r] = __builtin_amdgcn_exp2f(fmaf(p0[r], J.c2, mnL)); ps += p0[r]; }
#pragma unroll
                for (int r = 0; r < 16; ++r) { p1[r] = __builtin_amdgcn_exp2f(fmaf(p1[r], J.c2, mnL)); ps += p1[r]; }
                ps = sum32(ps); l_reg = l_reg * alpha + ps; }
            if (__any(alpha < 1.f)) { if (hi == 0) al_l[r32] = alpha; asm volatile("s_waitcnt lgkmcnt(0)" ::: "memory");
#pragma unroll
                for (int d_ = 0; d_ < DV / 32; ++d_)
#pragma unroll
                    for (int r = 0; r < 16; ++r) o[d_][r] *= al_l[crow(r, hi)]; }
            i32x8 P8;
#pragma unroll
            for (int q4 = 0; q4 < 4; ++q4) { P8[q4] = (int)pg8::pk4_fp8(p0[4 * q4], p0[4 * q4 + 1], p0[4 * q4 + 2], p0[4 * q4 + 3]); P8[4 + q4] = (int)pg8::pk4_fp8(p1[4 * q4], p1[4 * q4 + 1], p1[4 * q4 + 2], p1[4 * q4 + 3]); }
            SBAR();
            { const char* vb = V_lds + bf * VB8 + r32 * 64; const int c0 = (2 * hi) ^ swv;
#pragma unroll
              for (int d0 = 0; d0 < DV / 32; ++d0) { const i32x4v x0 = *reinterpret_cast<const i32x4v*>(vb + d0 * 32 * 64 + (c0 << 4)), x1 = *reinterpret_cast<const i32x4v*>(vb + d0 * 32 * 64 + ((c0 ^ 1) << 4));
                  o[d0] = __builtin_amdgcn_mfma_scale_f32_32x32x64_f8f6f4(P8, __builtin_shufflevector(x0, x1, 0, 1, 2, 3, 4, 5, 6, 7), o[d0], 0, 0, 0, 0x7f7f7f7f, 0, 0x7f7f7f7f); } }
        }
        asm volatile("s_waitcnt vmcnt(0)" ::: "memory");
        __syncthreads();
    }
#undef LOADT9
}
template <int DV>
__device__ __forceinline__ void attn_core_kv8x2(__attribute__((address_space(3))) unsigned char* lds3, const Job& J, const Job8v& J8, const i32x8* qf, f32x16* o, float& m_reg, float& l_reg) {
    constexpr int KB8 = KVBLK * 256, VB8 = DV * 64, KB2 = 2 * KB8, VB2 = 2 * VB8;
    static_assert(DV == 128, "one LDS-DMA instruction per wave fills the 128 x 64 B V^T tile");
    char* lds = (char*)lds3;
    int wid = J.wave; asm volatile("" : "+s"(wid)); int tid = wid * 64 + lane_id(); asm volatile("" : "+v"(tid));
    const int lane = tid & 63, r32 = lane & 31, hi = lane >> 5;
    char* V_lds = lds + LDS_V; char* K_lds = lds + LDS_K;
    float* al_l = (float*)(lds + LDS_WS) + wid * 64 + 32;
    const unsigned char* ksrc[2]; long kld[2]; const unsigned char* vsrc;
#pragma unroll
    for (int i = 0; i < 2; ++i) { const int q = (wid * 2 + i) * 64 + lane, row = q >> 4, pos = q & 15; int c = pos ^ (row & 15); if (c > 11) c = 11;
        if (c >= 8) { ksrc[i] = J8.Kr + (long)row * 64 + (c - 8) * 16; kld[i] = 64; } else { ksrc[i] = J8.Kn + (long)row * 1024 + c * 16; kld[i] = 1024; } }
    { const int q = wid * 64 + lane, row = q >> 2, pos = q & 3, c = pos ^ ((row >> 2) & 3); vsrc = J8.Vt + (long)row * J8.ldvt + c * 16; }
#define LOADT9(j, bf) do { _Pragma("unroll") for (int sb = 0; sb < 2; ++sb) { const long kb_ = (long)(2 * (j) + sb) * KVBLK; \
        _Pragma("unroll") for (int i = 0; i < 2; ++i) __builtin_amdgcn_global_load_lds((const unsigned*)(ksrc[i] + kb_ * kld[i]), (__attribute__((address_space(3))) unsigned*)(lds3 + LDS_K + (bf) * KB2 + sb * KB8 + (wid * 2 + i) * 1024), 16, 0, 0); \
        __builtin_amdgcn_global_load_lds((const unsigned*)(vsrc + kb_), (__attribute__((address_space(3))) unsigned*)(lds3 + LDS_V + (bf) * VB2 + sb * VB8 + wid * 1024), 16, 0, 0); } } while (0)
    m_reg = J.m0; l_reg = J.l0;
#pragma unroll
    for (int d = 0; d < DV / 32; ++d) o[d] = f32x16{};
    const int NT = (J.j_hi - J.j_lo) >> 1;
    LOADT9(0, 0); asm volatile("s_waitcnt vmcnt(0)" ::: "memory"); __syncthreads();
    const int swv = (r32 >> 2) & 3;
    for (int t = 0; t < NT; ++t) {
        const int bf = t & 1;
        if (t + 1 < NT) LOADT9(t + 1, bf ^ 1);
#pragma unroll
        for (int sb = 0; sb < 2; ++sb) { const int kbase = (2 * t + sb) * KVBLK;
        const bool act = J.nomask || ((kbase <= J.wq_lo + QBLK - 1) && (kbase + KVBLK - 1 >= J.wq_lo - (int)J.W + 1));
        if (act) {
            f32x16 p0 = f32x16{}, p1 = f32x16{}; float alpha;
            { const char* rb = K_lds + bf * KB2 + sb * KB8 + r32 * 256; const int sw = r32 & 15;
#pragma unroll
              for (int g = 0; g < 3; ++g) { const int c0 = (4 * g + 2 * hi) ^ sw;
                  const i32x4v a0 = *reinterpret_cast<const i32x4v*>(rb + (c0 << 4)), a1 = *reinterpret_cast<const i32x4v*>(rb + ((c0 ^ 1) << 4));
                  const i32x4v b0 = *reinterpret_cast<const i32x4v*>(rb + 32 * 256 + (c0 << 4)), b1 = *reinterpret_cast<const i32x4v*>(rb + 32 * 256 + ((c0 ^ 1) << 4));
                  const i32x8 A0 = __builtin_shufflevector(a0, a1, 0, 1, 2, 3, 4, 5, 6, 7), A1 = __builtin_shufflevector(b0, b1, 0, 1, 2, 3, 4, 5, 6, 7);
                  p0 = __builtin_amdgcn_mfma_scale_f32_32x32x64_f8f6f4(A0, qf[g], p0, 0, 0, 0, 0x7f7f7f7f, 0, 0x7f7f7f7f);
                  p1 = __builtin_amdgcn_mfma_scale_f32_32x32x64_f8f6f4(A1, qf[g], p1, 0, 0, 0, 0x7f7f7f7f, 0, 0x7f7f7f7f); } }
            if (!J.nomask && (kbase + KVBLK - 1 > J.wq_lo || kbase <= J.wq_lo + QBLK - 1 - (int)J.W)) mask_tile(p0, p1, J.qpos - 4 * hi - kbase, J.W);
            {
                float pmax = p0[0];
#pragma unroll
                for (int r = 1; r < 16; ++r) pmax = fmaxf(pmax, p0[r]);
#pragma unroll
                for (int r = 0; r < 16; ++r) pmax = fmaxf(pmax, p1[r]);
                pmax = max32(pmax);
                float mn;
                if (__builtin_expect(__all((pmax - m_reg) * J.sc <= 5.f), 1)) { mn = m_reg; alpha = 1.f; }
                else { mn = fmaxf(m_reg, pmax); alpha = __builtin_amdgcn_exp2f((m_reg - mn) * J.c2); m_reg = mn; }
                const float mnL = -mn * J.c2; float ps = 0.f;
#pragma unroll
                for (int r = 0; r < 16; ++r) { p0[r] = __builtin_amdgcn_exp2f(fmaf(p0[r], J.c2, mnL)); ps += p0[r]; }
#pragma unroll
                for (int r = 0; r < 16; ++r) { p1[r] = __builtin_amdgcn_exp2f(fmaf(p1[r], J.c2, mnL)); ps += p1[r]; }
                ps = sum32(ps); l_reg = l_reg * alpha + ps; }
            if (__any(alpha < 1.f)) { if (hi == 0) al_l[r32] = alpha; asm volatile("s_waitcnt lgkmcnt(0)" ::: "memory");
#pragma unroll
                for (int d_ = 0; d_ < DV / 32; ++d_)
#pragma unroll
                    for (int r = 0; r < 16; ++r) o[d_][r] *= al_l[crow(r, hi)]; }
            i32x8 P8;
#pragma unroll
            for (int q4 = 0; q4 < 4; ++q4) { P8[q4] = (int)pg8::pk4_fp8(p0[4 * q4], p0[4 * q4 + 1], p0[4 * q4 + 2], p0[4 * q4 + 3]); P8[4 + q4] = (int)pg8::pk4_fp8(p1[4 * q4], p1[4 * q4 + 1], p1[4 * q4 + 2], p1[4 * q4 + 3]); }
            SBAR();
            { const char* vb = V_lds + bf * VB2 + sb * VB8 + r32 * 64; const int c0 = (2 * hi) ^ swv;
#pragma unroll
              for (int d0 = 0; d0 < DV / 32; ++d0) { const i32x4v x0 = *reinterpret_cast<const i32x4v*>(vb + d0 * 32 * 64 + (c0 << 4)), x1 = *reinterpret_cast<const i32x4v*>(vb + d0 * 32 * 64 + ((c0 ^ 1) << 4));
                  o[d0] = __builtin_amdgcn_mfma_scale_f32_32x32x64_f8f6f4(P8, __builtin_shufflevector(x0, x1, 0, 1, 2, 3, 4, 5, 6, 7), o[d0], 0, 0, 0, 0x7f7f7f7f, 0, 0x7f7f7f7f); } }
        } }
        asm volatile("s_waitcnt vmcnt(0)" ::: "memory");
        __syncthreads();
    }
#undef LOADT9
}
template <int DV, bool CONTIG>
__device__ __forceinline__ void store_o(__attribute__((address_space(3))) unsigned char* lds3, const f32x16* o, float l_reg, bf16_t* Ob, long ldo, int wave, int ws_off = LDS_WS, int rt_off = LDS_OTAB) {
    char* lds = (char*)lds3; int wid = wave; asm volatile("" : "+s"(wid)); int tid = wid * 64 + lane_id(); asm volatile("" : "+v"(tid));
    const int lane = tid & 63, r32 = lane & 31, hi = lane >> 5;
    float* li_l = (float*)(lds + ws_off) + wid * 64; const int* rtab = (const int*)(lds + rt_off) + wid * 32;
    if (hi == 0) li_l[r32] = l_reg; asm volatile("s_waitcnt lgkmcnt(0)" ::: "memory");
#pragma unroll
    for (int r = 0; r < 16; ++r) { const int orow = crow(r, hi); const float rl = __builtin_amdgcn_rcpf(li_l[orow]);
        long drow = orow; if (!CONTIG) drow = rtab[orow];
#pragma unroll
        for (int d0 = 0; d0 < DV / 32; ++d0) { const float v = o[d0][r] * rl; const float vn = shx<1>(v);
            if ((r32 & 1) == 0 && drow >= 0) *(unsigned*)(Ob + drow * ldo + d0 * 32 + r32) = cvtpk(v, vn); } }
}

__device__ __forceinline__ void store_o_staged(__attribute__((address_space(3))) unsigned char* lds3, const f32x16* o, float l_reg, bf16_t* Ob, int ws_off, int rt_off, int st_off, int wave) {
    char* lds = (char*)lds3; int wid = wave; asm volatile("" : "+s"(wid)); int tid = wid * 64 + lane_id(); asm volatile("" : "+v"(tid));
    const int lane = tid & 63, r32 = lane & 31, hi = lane >> 5;
    float* li_l = (float*)(lds + ws_off) + wid * 64; const int* rtab = (const int*)(lds + rt_off) + wid * 32; bf16_t* stg = (bf16_t*)(lds + st_off) + wid * 1024;
    if (hi == 0) li_l[r32] = l_reg; asm volatile("s_waitcnt lgkmcnt(0)" ::: "memory");
    float rl[16];
#pragma unroll
    for (int r = 0; r < 16; ++r) rl[r] = __builtin_amdgcn_rcpf(li_l[crow(r, hi)]);
    const int rowA = lane >> 2, ch = lane & 3; const long dA = rtab[rowA], dB = rtab[rowA + 16];
#pragma unroll
    for (int d0 = 0; d0 < 4; ++d0) {
#pragma unroll
        for (int r = 0; r < 16; ++r) { const float v = o[d0][r] * rl[r]; const float vn = shx<1>(v); if ((r32 & 1) == 0) *(unsigned*)(stg + crow(r, hi) * 32 + r32) = cvtpk(v, vn); }
        asm volatile("s_waitcnt lgkmcnt(0)" ::: "memory");
        const u32x4 va = *(const u32x4*)(stg + rowA * 32 + ch * 8), vb = *(const u32x4*)(stg + (rowA + 16) * 32 + ch * 8);
        if (dA >= 0) *(u32x4*)(Ob + dA * 128 + d0 * 32 + ch * 8) = va;
        if (dB >= 0) *(u32x4*)(Ob + dB * 128 + d0 * 32 + ch * 8) = vb;
        asm volatile("s_waitcnt lgkmcnt(0)" ::: "memory");
    }
}

__device__ __forceinline__ void store_o_staged8(__attribute__((address_space(3))) unsigned char* lds3, const f32x16* o, float l_reg, unsigned char* Ob, int ws_off, int rt_off, int st_off, int wave) {
    char* lds = (char*)lds3; int wid = wave; asm volatile("" : "+s"(wid)); int tid = wid * 64 + lane_id(); asm volatile("" : "+v"(tid));
    const int lane = tid & 63, r32 = lane & 31, hi = lane >> 5;
    float* li_l = (float*)(lds + ws_off) + wid * 64; const int* rtab = (const int*)(lds + rt_off) + wid * 32; unsigned char* stg = (unsigned char*)(lds + st_off) + wid * 2048;
    if (hi == 0) li_l[r32] = l_reg; asm volatile("s_waitcnt lgkmcnt(0)" ::: "memory");
    float rl[16];
#pragma unroll
    for (int r = 0; r < 16; ++r) rl[r] = 16.f * __builtin_amdgcn_rcpf(li_l[crow(r, hi)]);
    const int rowA = lane >> 2, ch = lane & 3; const long dA = rtab[rowA], dB = rtab[rowA + 16];
#pragma unroll
    for (int hf = 0; hf < 2; ++hf) {
#pragma unroll
        for (int dl = 0; dl < 2; ++dl)
#pragma unroll
            for (int r = 0; r < 16; ++r) { const float v = o[2 * hf + dl][r] * rl[r]; const float vn = shx<1>(v);
                if ((r32 & 1) == 0) *(unsigned short*)(stg + crow(r, hi) * 64 + dl * 32 + r32) = (unsigned short)__builtin_amdgcn_cvt_pk_fp8_f32(v, vn, 0, false); }
        asm volatile("s_waitcnt lgkmcnt(0)" ::: "memory");
        const u32x4 va = *(const u32x4*)(stg + rowA * 64 + ch * 16), vb = *(const u32x4*)(stg + (rowA + 16) * 64 + ch * 16);
        if (dA >= 0) *(u32x4*)(Ob + dA * 128 + hf * 64 + ch * 16) = va;
        if (dB >= 0) *(u32x4*)(Ob + dB * 128 + hf * 64 + ch * 16) = vb;
        asm volatile("s_waitcnt lgkmcnt(0)" ::: "memory");
    }
}

__device__ __forceinline__ void chunk_resident(__attribute__((address_space(3))) unsigned char* lds3, int k_off, int v_off, int ws_off, int ntile, bool causal, int wq_lo, int qrel,
                                               float sc, float c2, const bf16x8* qr, f32x16* o, float& m_reg, float& l_reg, int wave) {
    char* lds = (char*)lds3; int wid = wave; asm volatile("" : "+s"(wid)); int tid = wid * 64 + lane_id(); asm volatile("" : "+v"(tid));
    const int lane = tid & 63, r32 = lane & 31, hi = lane >> 5;
    float* al_l = (float*)(lds + ws_off) + wid * 64 + 32;
    const int vb0 = (int)(uintptr_t)(lds + v_off) + v_rd_base(lane);
    m_reg = -1e30f; l_reg = 0.f;
#pragma unroll
    for (int d = 0; d < 4; ++d) o[d] = f32x16{};
    for (int t = 0; t < ntile; ++t) {
        f32x16 p0, p1; bf16x8 pa0, pa1, pa2, pa3; float alpha;
        qkt<128>(p0, p1, lds + k_off + t * 16384, r32, hi, qr);
        if (causal && (t * KVBLK + KVBLK - 1 > wq_lo)) mask_tile(p0, p1, qrel - 4 * hi - t * KVBLK, 1u << 30);
        partialSM(p0, p1, m_reg, alpha, sc, c2);
        if (__any(alpha < 1.f)) { if (hi == 0) al_l[r32] = alpha; asm volatile("s_waitcnt lgkmcnt(0)" ::: "memory");
#pragma unroll
            for (int d_ = 0; d_ < 4; ++d_)
#pragma unroll
                for (int r = 0; r < 16; ++r) o[d_][r] *= al_l[crow(r, hi)]; }
        finishSM(p0, p1, alpha, l_reg, pa0, pa1, pa2, pa3); SBAR();
        pv_tile<128>(o, vb0 + t * 16384, pa0, pa1, pa2, pa3);
    }
}

__device__ __forceinline__ void chunk_resident8(__attribute__((address_space(3))) unsigned char* lds3, int k_off, int v_off, int ws_off, int ntile, bool causal, int wq_lo, int qrel,
                                                float sc, float c2, const i32x8* qf, f32x16* o, float& m_reg, float& l_reg, int wave) {
    char* lds = (char*)lds3; int wid = wave; asm volatile("" : "+s"(wid)); int tid = wid * 64 + lane_id(); asm volatile("" : "+v"(tid));
    const int lane = tid & 63, r32 = lane & 31, hi = lane >> 5;
    float* al_l = (float*)(lds + ws_off) + wid * 64 + 32;
    const int vb0 = (int)(uintptr_t)(lds + v_off) + v_rd_base(lane);
    m_reg = -1e30f; l_reg = 0.f;
#pragma unroll
    for (int d = 0; d < 4; ++d) o[d] = f32x16{};
    const int sw = (r32 >> 1) & 7;
    for (int t = 0; t < ntile; ++t) {
        f32x16 p0 = f32x16{}, p1 = f32x16{}; bf16x8 pa0, pa1, pa2, pa3; float alpha;
        { const char* rb = lds + k_off + t * 8192 + r32 * 128;
#pragma unroll
          for (int g = 0; g < 2; ++g) { const int c0 = (4 * g + 2 * hi) ^ sw;
              const i32x4v a0 = *reinterpret_cast<const i32x4v*>(rb + (c0 << 4)), a1 = *reinterpret_cast<const i32x4v*>(rb + ((c0 ^ 1) << 4));
              const i32x4v b0 = *reinterpret_cast<const i32x4v*>(rb + 32 * 128 + (c0 << 4)), b1 = *reinterpret_cast<const i32x4v*>(rb + 32 * 128 + ((c0 ^ 1) << 4));
              const i32x8 A0 = __builtin_shufflevector(a0, a1, 0, 1, 2, 3, 4, 5, 6, 7), A1 = __builtin_shufflevector(b0, b1, 0, 1, 2, 3, 4, 5, 6, 7);
              p0 = __builtin_amdgcn_mfma_scale_f32_32x32x64_f8f6f4(A0, qf[g], p0, 0, 0, 0, 0x7f7f7f7f, 0, 0x7f7f7f7f);
              p1 = __builtin_amdgcn_mfma_scale_f32_32x32x64_f8f6f4(A1, qf[g], p1, 0, 0, 0, 0x7f7f7f7f, 0, 0x7f7f7f7f); } }
        if (causal && (t * KVBLK + KVBLK - 1 > wq_lo)) mask_tile(p0, p1, qrel - 4 * hi - t * KVBLK, 1u << 30);
        partialSM(p0, p1, m_reg, alpha, sc, c2);
        if (__any(alpha < 1.f)) { if (hi == 0) al_l[r32] = alpha; asm volatile("s_waitcnt lgkmcnt(0)" ::: "memory");
#pragma unroll
            for (int d_ = 0; d_ < 4; ++d_)
#pragma unroll
                for (int r = 0; r < 16; ++r) o[d_][r] *= al_l[crow(r, hi)]; }
        finishSM(p0, p1, alpha, l_reg, pa0, pa1, pa2, pa3); SBAR();
        pv_tile<128>(o, vb0 + t * 16384, pa0, pa1, pa2, pa3);
    }
}

__device__ __forceinline__ void chunk_resident_kv8(__attribute__((address_space(3))) unsigned char* lds3, int k_off, int v_off, int ws_off, int ntile, bool causal, int wq_lo, int qrel,
                                                   float sc, float c2, const i32x8* qf, f32x16* o, float& m_reg, float& l_reg, int wave) {
    char* lds = (char*)lds3; int wid = wave; asm volatile("" : "+s"(wid)); int tid = wid * 64 + lane_id(); asm volatile("" : "+v"(tid));
    const int lane = tid & 63, r32 = lane & 31, hi = lane >> 5;
    float* al_l = (float*)(lds + ws_off) + wid * 64 + 32;
    m_reg = -1e30f; l_reg = 0.f;
#pragma unroll
    for (int d = 0; d < 4; ++d) o[d] = f32x16{};
    const int sw = (r32 >> 1) & 7, swv = (r32 >> 2) & 3;
    for (int t = 0; t < ntile; ++t) {
        f32x16 p0 = f32x16{}, p1 = f32x16{}; float alpha;
        { const char* rb = lds + k_off + t * 8192 + r32 * 128;
#pragma unroll
          for (int g = 0; g < 2; ++g) { const int c0 = (4 * g + 2 * hi) ^ sw;
              const i32x4v a0 = *reinterpret_cast<const i32x4v*>(rb + (c0 << 4)), a1 = *reinterpret_cast<const i32x4v*>(rb + ((c0 ^ 1) << 4));
              const i32x4v b0 = *reinterpret_cast<const i32x4v*>(rb + 32 * 128 + (c0 << 4)), b1 = *reinterpret_cast<const i32x4v*>(rb + 32 * 128 + ((c0 ^ 1) << 4));
              const i32x8 A0 = __builtin_shufflevector(a0, a1, 0, 1, 2, 3, 4, 5, 6, 7), A1 = __builtin_shufflevector(b0, b1, 0, 1, 2, 3, 4, 5, 6, 7);
              p0 = __builtin_amdgcn_mfma_scale_f32_32x32x64_f8f6f4(A0, qf[g], p0, 0, 0, 0, 0x7f7f7f7f, 0, 0x7f7f7f7f);
              p1 = __builtin_amdgcn_mfma_scale_f32_32x32x64_f8f6f4(A1, qf[g], p1, 0, 0, 0, 0x7f7f7f7f, 0, 0x7f7f7f7f); } }
        if (causal && (t * KVBLK + KVBLK - 1 > wq_lo)) mask_tile(p0, p1, qrel - 4 * hi - t * KVBLK, 1u << 30);
        { float pmax = p0[0];
#pragma unroll
          for (int r = 1; r < 16; ++r) pmax = fmaxf(pmax, p0[r]);
#pragma unroll
          for (int r = 0; r < 16; ++r) pmax = fmaxf(pmax, p1[r]);
          pmax = max32(pmax);
          float mn;
          if (__builtin_expect(__all((pmax - m_reg) * sc <= 5.f), 1)) { mn = m_reg; alpha = 1.f; }
          else { mn = fmaxf(m_reg, pmax); alpha = __builtin_amdgcn_exp2f((m_reg - mn) * c2); m_reg = mn; }
          const float mnL = -mn * c2; float ps = 0.f;
#pragma unroll
          for (int r = 0; r < 16; ++r) { p0[r] = __builtin_amdgcn_exp2f(fmaf(p0[r], c2, mnL)); ps += p0[r]; }
#pragma unroll
          for (int r = 0; r < 16; ++r) { p1[r] = __builtin_amdgcn_exp2f(fmaf(p1[r], c2, mnL)); ps += p1[r]; }
          ps = sum32(ps); l_reg = l_reg * alpha + ps; }
        if (__any(alpha < 1.f)) { if (hi == 0) al_l[r32] = alpha; asm volatile("s_waitcnt lgkmcnt(0)" ::: "memory");
#pragma unroll
            for (int d_ = 0; d_ < 4; ++d_)
#pragma unroll
                for (int r = 0; r < 16; ++r) o[d_][r] *= al_l[crow(r, hi)]; }
        i32x8 P8;
#pragma unroll
        for (int q4 = 0; q4 < 4; ++q4) { P8[q4] = (int)pg8::pk4_fp8(p0[4 * q4], p0[4 * q4 + 1], p0[4 * q4 + 2], p0[4 * q4 + 3]); P8[4 + q4] = (int)pg8::pk4_fp8(p1[4 * q4], p1[4 * q4 + 1], p1[4 * q4 + 2], p1[4 * q4 + 3]); }
        SBAR();
        { const char* vb = lds + v_off + t * 8192 + r32 * 64; const int c0 = (2 * hi) ^ swv;
#pragma unroll
          for (int d0 = 0; d0 < 4; ++d0) { const i32x4v x0 = *reinterpret_cast<const i32x4v*>(vb + d0 * 32 * 64 + (c0 << 4)), x1 = *reinterpret_cast<const i32x4v*>(vb + d0 * 32 * 64 + ((c0 ^ 1) << 4));
              o[d0] = __builtin_amdgcn_mfma_scale_f32_32x32x64_f8f6f4(P8, __builtin_shufflevector(x0, x1, 0, 1, 2, 3, 4, 5, 6, 7), o[d0], 0, 0, 0, 0x7f7f7f7f, 0, 0x7f7f7f7f); } }
    }
}
#undef SBAR
}

#define GAS __attribute__((address_space(1)))
#define LAS __attribute__((address_space(3)))
typedef unsigned short bf16;
typedef unsigned v4u __attribute__((ext_vector_type(4)));
typedef float f32x4 __attribute__((ext_vector_type(4)));
typedef short bf16x8 __attribute__((ext_vector_type(8)));
typedef GAS unsigned gu32;
typedef GAS unsigned long long gu64;
#define RLX_AGENT __ATOMIC_RELAXED, __HIP_MEMORY_SCOPE_AGENT
#define LDS_WAIT() asm volatile("s_waitcnt lgkmcnt(0)" ::: "memory")
#define VM_WAIT() asm volatile("s_waitcnt vmcnt(0)" ::: "memory")
__device__ __forceinline__ unsigned long long rt() { return __builtin_amdgcn_s_memrealtime(); }
__device__ __forceinline__ unsigned f2bf(float f) { unsigned u = __builtin_bit_cast(unsigned, f); return (u + 0x7fffu + ((u >> 16) & 1u)) >> 16; }
__device__ __forceinline__ unsigned pk2(float lo, float hi) { return f2bf(lo) | (f2bf(hi) << 16); }

#define XB_TMO      128
#define XB_XCNT(j)  (256  + 64 * (j))
#define XB_XSUB(j)  (1280 + 64 * (j))
#define XB_XGEN(j)  (2304 + 64 * (j))
#define XB_TOP      3328
#define XB_TOPGEN   3392
#define XCD_BAR_WORDS 3456
#define XB_SPIN_CAP (1u << 18)

__device__ __forceinline__ unsigned xb_ld(unsigned* p)              { return __hip_atomic_load(p, __ATOMIC_RELAXED, __HIP_MEMORY_SCOPE_AGENT); }
__device__ __forceinline__ unsigned xb_add(unsigned* p, unsigned v) { return __hip_atomic_fetch_add(p, v, __ATOMIC_RELAXED, __HIP_MEMORY_SCOPE_AGENT); }
__device__ __forceinline__ unsigned xb_xcc_id() { return (unsigned)__builtin_amdgcn_s_getreg((3 << 11) | 20) & 0xFu; }
#define XB_SPIN(cond, bar) do { unsigned _sp = 0; while (cond) { __builtin_amdgcn_s_sleep(1); \
    if ((++_sp & 255u) == 0u) { if (xb_ld(&(bar)[XB_TMO])) break; if (_sp > XB_SPIN_CAP) { atomicAdd(&(bar)[XB_TMO], 1u); break; } } } } while (0)

struct XcdBarrier {
    unsigned* bar; unsigned x;
    volatile LAS unsigned* st;
};

__device__ __forceinline__ XcdBarrier xcd_barrier_post(unsigned* bar, volatile LAS unsigned* st) {
    XcdBarrier b; b.bar = bar; b.x = xb_xcc_id(); b.st = st;
    if (threadIdx.x == 0) (void)xb_add(&bar[XB_XCNT(b.x)], 1u);
    return b;
}
__device__ __forceinline__ void xcd_barrier_complete(unsigned* bar, unsigned x, unsigned& nloc, unsigned& nx) {
    const unsigned G = gridDim.x * gridDim.y * gridDim.z;
    unsigned sum, cnt, mine, sp = 0u;
    for (;;) {
        sum = 0u; cnt = 0u; mine = 0u;
#pragma unroll
        for (unsigned j = 0; j < 16; ++j) { const unsigned c = xb_ld(&bar[XB_XCNT(j)]); sum += c; cnt += (c > 0u) ? 1u : 0u; mine = (j == x) ? c : mine; }
        if (sum == G) break;
        __builtin_amdgcn_s_sleep(1);
        if ((++sp & 255u) == 0u) { if (xb_ld(&bar[XB_TMO])) break; if (sp > XB_SPIN_CAP) { atomicAdd(&bar[XB_TMO], 1u); break; } }
    }
    nloc = mine > 0u ? mine : 1u; nx = cnt > 0u ? cnt : 1u;
}

__device__ __forceinline__ void xcd_barrier(const XcdBarrier& b) {
    asm volatile("s_waitcnt vmcnt(0)" ::: "memory");
    __syncthreads();
    if (threadIdx.x == 0) {
        unsigned oz_; asm volatile("s_mov_b32 %0, 0" : "=s"(oz_));
        unsigned* bar = b.bar + oz_; const unsigned bx = (unsigned)__builtin_amdgcn_readfirstlane((int)b.x) + oz_;
        __builtin_amdgcn_s_waitcnt(0);
        unsigned nloc = b.st[0], nx = b.st[1];
        if (nloc == 0u) { xcd_barrier_complete(bar, bx, nloc, nx); b.st[0] = nloc; b.st[1] = nx; }
        const unsigned old = xb_add(&bar[XB_XSUB(bx)], 1u);
        const unsigned gen = old / nloc;
        if (old + 1u == (gen + 1u) * nloc) {
            __builtin_amdgcn_fence(__ATOMIC_RELEASE, "agent");
            asm volatile("s_waitcnt vmcnt(0)" ::: "memory");
            const unsigned og = xb_add(&bar[XB_TOP], 1u);
            const unsigned tg = og / nx;
            if (og + 1u == (tg + 1u) * nx) xb_add(&bar[XB_TOPGEN], 1u);
            else XB_SPIN(xb_ld(&bar[XB_TOPGEN]) == tg, bar);
            __builtin_amdgcn_fence(__ATOMIC_ACQUIRE, "agent");
            xb_add(&bar[XB_XGEN(bx)], 1u);
            asm volatile("s_waitcnt vmcnt(0)" ::: "memory");
        } else {
            XB_SPIN(xb_ld(&bar[XB_XGEN(bx)]) == gen, bar);
            __builtin_amdgcn_fence(__ATOMIC_ACQUIRE, "agent");
            asm volatile("s_waitcnt vmcnt(0)" ::: "memory");
        }
    }
    __syncthreads();
}

constexpr int NWAVES = 8;
constexpr int S = 16384, DM = 2048, FF = 8192, PLED = 256;
constexpr int NIN_PAD = 2560;
constexpr int SWAW = 1344;
constexpr float NORM_EPS = 1e-6f;
constexpr float W8_DOWN_SC = 128.f, W8_GATE_SC = 64.f;
#ifndef DUP_MASK
#define DUP_MASK 0
#endif
#ifndef MK_N_LAUNCHES
#define MK_N_LAUNCHES 1
#endif
constexpr size_t MiB = 1u << 20;
constexpr size_t WS_CTL = 0, CTL_ZERO_BYTES = 1 * MiB;
constexpr size_t WS_CS64 = 1 * MiB, WS_CS128 = 5 * MiB, WS_SS = 13 * MiB, WS_KM = 15 * MiB, WS_LIST = 16 * MiB, WS_PLSE = 32 * MiB, WS_PB = 36 * MiB;
constexpr size_t WS_WB = 52 * MiB, WS_XN = 160 * MiB, WS_M = 224 * MiB, WS_AR = 288 * MiB, WS_END = 555 * MiB;
constexpr size_t WB_MIX = 81 * MiB, WB_IN = WB_MIX, WB_QUP = WB_MIX + 10 * MiB, WB_KVUP = WB_QUP + 3 * MiB / 2, WB_QKV = WB_MIX;
__host__ __device__ constexpr size_t wo_up(int l) { return 52 * MiB + (size_t)l * 16 * MiB; }
__host__ __device__ constexpr size_t wo_upsc(int l) { return 52 * MiB + 107 * MiB + (size_t)l * 32768; }
__host__ __device__ constexpr size_t wo_down(int l) { return 52 * MiB + 32 * MiB + (size_t)l * 16 * MiB; }
__host__ __device__ constexpr size_t wo_gate(int l) { return 52 * MiB + 64 * MiB + (size_t)l * 4 * MiB; }
__host__ __device__ constexpr size_t wo_proj(int l) { return l ? 552 * MiB : 52 * MiB + 72 * MiB; }
__host__ __device__ constexpr size_t wo_out(int l) { return l ? 544 * MiB : 52 * MiB + 73 * MiB; }
constexpr size_t WS_CQKV = WS_AR, WS_SWAB = WS_AR + 32 * MiB, WS_Q = WS_AR + 74 * MiB, WS_KV = WS_AR + 122 * MiB;
constexpr size_t WS_VT8 = 522 * MiB;
constexpr size_t WS_K8N = WS_AR + 186 * MiB, WS_KR8 = WS_AR + 202 * MiB;
constexpr size_t WS_HID = WS_AR, WS_PP = WS_AR, WS_HG = WS_AR + 128 * MiB, WS_H16L = WS_AR + 128 * MiB;
constexpr size_t WS_SSQ = WS_PLSE;
constexpr size_t WS_ASC2 = WS_PLSE;
constexpr size_t WS_ASC = WS_KM;
constexpr size_t WS_VT8B = 124 * MiB;
constexpr size_t WS_QK8 = WS_XN;
constexpr size_t WS_QKV = WS_M, WS_PART = WS_M + 192 * MiB;
constexpr size_t WS_WQKV1 = 498 * MiB;
static_assert(WS_KV + 64 * MiB <= WS_WQKV1 && WS_HG + 64 * MiB <= WS_WQKV1 && WS_WQKV1 + 24 * MiB <= 544 * MiB && WS_HID + 128 * MiB <= WS_HG && WS_PART + 128 * MiB <= WS_END, "d_ws map");
constexpr int CW_TMO = 0, CW_BAR = 4096, CW_CNT = 131072, CW_QH = 135168;
constexpr int LIST_PER_HEAD = 516096;
__host__ __device__ __forceinline__ int list_off(int j) { return 256 * (63 * j - (j * (j - 1)) / 2); }
constexpr int RING_BYTES = 131072, LDSCTL_OFF = RING_BYTES, MISC_OFF = LDSCTL_OFF + 320, LDS_BYTES = 163840;
static_assert(att::LDS_END <= RING_BYTES, "attention scratch inside the ring region");

typedef unsigned v2u __attribute__((ext_vector_type(2)));
typedef float f32x2 __attribute__((ext_vector_type(2)));
__device__ __forceinline__ float bflo(unsigned w) { return __uint_as_float(w << 16); }
__device__ __forceinline__ float bfhi(unsigned w) { return __uint_as_float(w & 0xffff0000u); }

#define PH_TID() int wave_ = F.wave; asm volatile("" : "+s"(wave_)); int tid_ = wave_ * 64 + lane_id(); asm volatile("" : "+v"(tid_)); const int lane_ = tid_ & 63; (void)lane_; (void)wave_; \
    unsigned oz_; asm volatile("s_mov_b32 %0, 0" : "=s"(oz_)); unsigned char* wsb = F.ws + oz_; const void* const* inb = F.in + oz_; (void)wsb; (void)inb
struct Frame {
    LAS unsigned char* lds; unsigned char* ldsg; volatile LAS unsigned* MISC; gu32* ctl;
    int vcu, G, wave;
    const void* const* in; float* out; unsigned char* ws;
};
__device__ __forceinline__ float wave_sum(float v) { v += shx<1>(v); v += shx<2>(v); v += shx<4>(v); v += shx<8>(v); v += shx<16>(v); return sum32(v); }
constexpr int X_WS = MISC_OFF + 128;
__device__ __forceinline__ void place_cols(int mode, int n0, int& r0, int& rs) {
    r0 = n0; rs = 1;
    if (mode == 1) { int sec, base, rope = 1;
        if (n0 < 1024) { sec = 0; base = 0; rope = 0; } else if (n0 < 1088) { sec = 1024; base = 2304; } else if (n0 < 2112) { sec = 1088; base = 1024; } else if (n0 < 2240) { sec = 2112; base = 2048; } else { sec = 2240; base = 2176; rope = 0; }
        const int d = n0 - sec;
        if (!rope) { r0 = base + d; } else { const int blk = d >> 6, half = (d >> 5) & 1; r0 = base + blk * 64 + half; rs = 2; } }
    else if (mode == 2) { if (n0 < 4096) { const int hb = n0 & ~127, d = n0 & 127, half = d >> 6; r0 = hb + 2 * (d - 64 * half) + half; rs = 2; } }
    else if (mode == 3) { const int hb = (n0 / 192) * 192, d = n0 - hb; if (d >= 128) { const int half = (d - 128) >> 5; r0 = hb + 128 + half; rs = 2; } }
}
__device__ __forceinline__ void transpose_item(const float* W, int K, int N, bf16* WT, int mode, LAS float* scr, int item, int lane) {
    const int nblk = N / 32, kb = item / nblk, nb = item % nblk, k0 = 64 * kb, n0 = 32 * nb; int r0, rs; place_cols(mode, n0, r0, rs);
#pragma unroll CONV_UNROLL
    for (int i = 0; i < 32; ++i) { const int kk = 2 * i + (lane >> 5); scr[kk * 33 + (lane & 31)] = W[(size_t)(k0 + kk) * N + n0 + (lane & 31)]; }
    LDS_WAIT(); asm volatile("" ::: "memory");
    const int c = lane & 7;
#pragma unroll
    for (int j = 0; j < 4; ++j) { const int n = (lane >> 3) + 8 * j; const LAS float* s = scr + (8 * c) * 33 + n;
        v4u o; o.x = pk2(s[0 * 33], s[1 * 33]); o.y = pk2(s[2 * 33], s[3 * 33]); o.z = pk2(s[4 * 33], s[5 * 33]); o.w = pk2(s[6 * 33], s[7 * 33]);
        *(GAS v4u*)(WT + (size_t)(r0 + n * rs) * K + k0 + 8 * c) = o; }
    LDS_WAIT(); asm volatile("" ::: "memory");
}
__device__ __forceinline__ void transpose_item8(const float* W, int K, int N, unsigned char* WT, float sc, LAS float* scr, int item, int lane) {
    const int nblk = N / 32, kb = item / nblk, nb = item % nblk, k0 = 64 * kb, n0 = 32 * nb;
#pragma unroll CONV_UNROLL
    for (int i = 0; i < 32; ++i) { const int kk = 2 * i + (lane >> 5); scr[kk * 33 + (lane & 31)] = W[(size_t)(k0 + kk) * N + n0 + (lane & 31)] * sc; }
    LDS_WAIT(); asm volatile("" ::: "memory");
    const int c = lane & 7;
#pragma unroll
    for (int j = 0; j < 4; ++j) { const int n = (lane >> 3) + 8 * j; const LAS float* s = scr + (8 * c) * 33 + n;
        v2u o; o.x = pg8::pk4_fp8(s[0 * 33], s[1 * 33], s[2 * 33], s[3 * 33]); o.y = pg8::pk4_fp8(s[4 * 33], s[5 * 33], s[6 * 33], s[7 * 33]);
        *(GAS v2u*)(WT + (size_t)(n0 + n) * K + k0 + 8 * c) = o; }
    LDS_WAIT(); asm volatile("" ::: "memory");
}
__device__ __forceinline__ void convert_i8_all(Frame& F) {
    PH_TID();
    LAS float* scr = (LAS float*)(F.lds + wave_ * 16384); LAS float* red = (LAS float*)(F.lds + X_WS);
    constexpr int T_UP = FF / 32, T_QKV = (QKV_I8) ? 6144 / 32 : 0, T_IN = (PROJ_I8) ? 2368 / 32 : 0, T_O1 = (OUT1_I8) ? DM / 32 : 0, T_O0 = (OUT0_I8) ? DM / 32 : 0, T_ALL = 2 * T_UP + T_QKV + T_IN + T_O1 + T_O0;
    const int col = lane_ & 31, hi = lane_ >> 5;
    for (int g = F.vcu; g < T_ALL; g += F.G) {
        int t = g, N, mode; const float* W; signed char* W8; float* WSC;
        if (t < 2 * T_UP) { const int layer = t >= T_UP ? 1 : 0; t -= layer * T_UP; W = (const float*)inb[17] + (size_t)layer * DM * FF; N = FF; mode = 0; W8 = (signed char*)(wsb + wo_up(layer)); WSC = (float*)(wsb + wo_upsc(layer)); }
        else if (t < 2 * T_UP + T_QKV) { t -= 2 * T_UP; W = (const float*)inb[13]; N = 6144; mode = 2; W8 = (signed char*)(wsb + WS_WQKV1); WSC = (float*)(wsb + wo_upsc(2)); }
        else if (t < 2 * T_UP + T_QKV + T_IN) { t -= 2 * T_UP + T_QKV; W = (const float*)inb[4]; N = 2368; mode = 1; W8 = (signed char*)(wsb + WS_WB + WB_IN); WSC = (float*)(wsb + wo_upsc(3)); }
        else if (t < 2 * T_UP + T_QKV + T_IN + T_O1) { t -= 2 * T_UP + T_QKV + T_IN; W = (const float*)inb[14]; N = DM; mode = 0; W8 = (signed char*)(wsb + wo_out(1)); WSC = (float*)(wsb + wo_upsc(4)); }
        else { t -= 2 * T_UP + T_QKV + T_IN + T_O1; W = (const float*)inb[10]; N = DM; mode = 0; W8 = (signed char*)(wsb + wo_out(0)); WSC = (float*)(wsb + wo_upsc(5)); }
        const int n0 = t * 32; int r0, rs; place_cols(mode, n0, r0, rs);
        float v[128]; float m = 0.f;
        { const float* wp = W + (size_t)(wave_ * 256 + hi) * N + n0 + col; const size_t st = (size_t)2 * N;
#pragma unroll
          for (int i = 0; i < 128; ++i) v[i] = wp[i * st]; }
#pragma unroll
        for (int i = 0; i < 128; ++i) m = fmaxf(m, fabsf(v[i]));
        m = max32(m); if (lane_ < 32) red[wave_ * 32 + lane_] = m;
        __syncthreads();
        if (tid_ < 32) { float c = red[tid_];
#pragma unroll
            for (int w = 1; w < 8; ++w) c = fmaxf(c, red[w * 32 + tid_]);
            c = c > 0.f ? c : 1.f; red[256 + tid_] = 127.f / c; WSC[r0 + tid_ * rs] = c * (1.f / 127.f); }
        __syncthreads();
#pragma unroll
        for (int bq = 0; bq < 4; ++bq) { const int k0 = wave_ * 256 + 64 * bq;
#pragma unroll
            for (int i = 0; i < 32; ++i) scr[(2 * i + hi) * 33 + col] = v[32 * bq + i];
            LDS_WAIT(); asm volatile("" ::: "memory");
            const int c = lane_ & 7;
#pragma unroll
            for (int j = 0; j < 4; ++j) { const int n = (lane_ >> 3) + 8 * j; const LAS float* s = scr + (8 * c) * 33 + n; const float inv = red[256 + n]; unsigned w0 = 0u, w1 = 0u;
#pragma unroll
                for (int e = 0; e < 4; ++e) { const int q0 = (int)__builtin_rintf(s[e * 33] * inv), q1 = (int)__builtin_rintf(s[(4 + e) * 33] * inv); w0 |= ((unsigned)q0 & 0xffu) << (8 * e); w1 |= ((unsigned)q1 & 0xffu) << (8 * e); }
                *(GAS v2u*)(W8 + (size_t)(r0 + n * rs) * DM + k0 + 8 * c) = (v2u){w0, w1}; }
            LDS_WAIT(); asm volatile("" ::: "memory");
        }
        __syncthreads();
    }
}
__device__ __forceinline__ void convert_weights(Frame& F, int layer) {
    PH_TID();
    LAS float* scr = (LAS float*)(F.lds + wave_ * 16384);
    const int gw = F.vcu * NWAVES + wave_, NGW = F.G * NWAVES;
    bf16* WB = (bf16*)(wsb + WS_WB);
    const float* wdn = (const float*)inb[18] + (size_t)layer * FF * DM;
    const float* wgt = (const float*)inb[20] + (size_t)layer * DM * DM; const float* wpj = (const float*)inb[22] + (size_t)layer * PLED * DM;
    constexpr int I_DN = (FF / 64) * (DM / 32), I_G = (DM / 64) * (DM / 32), I_PJ = (PLED / 64) * (DM / 32), I_O = I_G;
    constexpr int I_IN = (PROJ_I8) ? 0 : (DM / 64) * (2368 / 32), I_QU = (512 / 64) * (1536 / 32), I_KVU = (512 / 64) * (2048 / 32), I_QKV = (DM / 64) * (6144 / 32);
    const int nmix = layer == 0 ? (I_IN + I_QU + I_KVU) : (QKV_I8 ? 0 : I_QKV);
    const int NITEMS = I_DN + I_G + I_PJ + I_O + nmix;
    for (int it = gw; it < NITEMS; it += NGW) {
        int r = it;
        if (r < I_DN) { transpose_item8(wdn, FF, DM, wsb + wo_down(layer), W8_DOWN_SC, scr, r, lane_); continue; } r -= I_DN;
        if (r < I_G) { transpose_item8(wgt, DM, DM, wsb + wo_gate(layer), W8_GATE_SC, scr, r, lane_); continue; } r -= I_G;
        if (r < I_PJ) { transpose_item(wpj, PLED, DM, (bf16*)(wsb + wo_proj(layer)), 0, scr, r, lane_); continue; } r -= I_PJ;
        if (r < I_O) { if (layer == 0 ? !(OUT0_I8) : !(OUT1_I8)) transpose_item((const float*)inb[layer == 0 ? 10 : 14], DM, DM, (bf16*)(wsb + wo_out(layer)), 0, scr, r, lane_); continue; } r -= I_O;
        if (layer == 0) {
            if (r < I_IN) { transpose_item((const float*)inb[4], DM, 2368, (bf16*)((char*)WB + WB_IN), 1, scr, r, lane_); continue; } r -= I_IN;
            if (r < I_QU) { transpose_item((const float*)inb[6], 512, 1536, (bf16*)((char*)WB + WB_QUP), 3, scr, r, lane_); continue; } r -= I_QU;
            transpose_item((const float*)inb[8], 512, 2048, (bf16*)((char*)WB + WB_KVUP), 0, scr, r, lane_);
        } else {
            transpose_item((const float*)inb[13], DM, 6144, (bf16*)(wsb + WS_WQKV1), 2, scr, r, lane_);
        }
    }
    if (layer == 0) {
        GAS v4u* z = (GAS v4u*)((char*)WB + WB_IN + (size_t)2368 * DM * ((PROJ_I8) ? 1 : 2)); const int nz = 192 * DM * ((PROJ_I8) ? 1 : 2) / 16;
        for (int i = (F.vcu * NWAVES + wave_) * 64 + lane_; i < nz; i += F.G * NWAVES * 64) { z[i] = (v4u){0u, 0u, 0u, 0u}; if ((PROJ_I8) && i < 192) ((float*)(wsb + wo_upsc(3)))[2368 + i] = 0.f; }
    }
}
__device__ __forceinline__ void sincos_acc(float ang, float& sn, float& cs) {
    const double x = (double)ang, k = __builtin_rint(x * 0.6366197723675814);
    double r = __builtin_fma(-k, 1.5707963267948966, x); r = __builtin_fma(-k, 6.123233995736766e-17, r);
    const double r2 = r * r;
    double sp = -1.0 / 1307674368000.0; sp = sp * r2 + 1.0 / 6227020800.0; sp = sp * r2 - 1.0 / 39916800.0; sp = sp * r2 + 1.0 / 362880.0; sp = sp * r2 - 1.0 / 5040.0; sp = sp * r2 + 1.0 / 120.0; sp = sp * r2 - 1.0 / 6.0; sp = sp * r2 * r + r;
    double cp = 1.0 / 20922789888000.0; cp = cp * r2 - 1.0 / 87178291200.0; cp = cp * r2 + 1.0 / 479001600.0; cp = cp * r2 - 1.0 / 3628800.0; cp = cp * r2 + 1.0 / 40320.0; cp = cp * r2 - 1.0 / 720.0; cp = cp * r2 + 1.0 / 24.0; cp = cp * r2 - 0.5; cp = cp * r2 + 1.0;
    const int q = (int)(long long)k & 3;
    const double s_ = (q & 1) ? cp : sp, c_ = (q & 1) ? sp : cp;
    sn = (float)((q & 2) ? -s_ : s_); cs = (float)(((q + 1) & 2) ? -c_ : c_);
}
__device__ __forceinline__ void rms_row_to_bf16(int lane_, const float* xrow, const float* g, bf16* orow) {
    const GAS f32x4* xr = (const GAS f32x4*)xrow + lane_; const GAS f32x4* gr = (const GAS f32x4*)g + lane_;
    f32x4 v[8]; float s = 0.f;
#pragma unroll
    for (int j = 0; j < 8; ++j) { v[j] = xr[64 * j]; s += (v[j].x * v[j].x + v[j].y * v[j].y) + (v[j].z * v[j].z + v[j].w * v[j].w); }
    const float rstd = 1.f / sqrtf(wave_sum(s) * (1.f / DM) + NORM_EPS);
    GAS v2u* o8 = (GAS v2u*)orow + lane_;
#pragma unroll
    for (int j = 0; j < 8; ++j) { const f32x4 gg = gr[64 * j]; v2u w; w.x = pk2(v[j].x * rstd * gg.x, v[j].y * rstd * gg.y); w.y = pk2(v[j].z * rstd * gg.z, v[j].w * rstd * gg.w); o8[64 * j] = w; }
}
template <int MODE> __device__ __forceinline__ void p_rows(Frame& F, const float* hprev32, const bf16* hprev16, bf16* hout16, const float* gpost, const float* gnext);
__device__ __forceinline__ void p_prologue(Frame& F) {
    PH_TID();
    convert_weights(F, 0);
    convert_weights(F, 1);
    convert_i8_all(F);
    const int gt = (F.vcu * NWAVES + wave_) * 64 + lane_, NGT = F.G * NWAVES * 64;
    {
        const GAS f32x4* p4 = (const GAS f32x4*)inb[1]; GAS v4u* o = (GAS v4u*)(wsb + WS_PB); const int n = 2 * S * PLED / 8;
#pragma unroll 4
        for (int i = gt; i < n; i += NGT) { const f32x4 a = p4[2 * i], b = p4[2 * i + 1]; v4u w; w.x = pk2(a.x, a.y); w.y = pk2(a.z, a.w); w.z = pk2(b.x, b.y); w.w = pk2(b.z, b.w); o[i] = w; }
    }
    {
        const int* pos = (const int*)inb[2]; GAS f32x2* c64 = (GAS f32x2*)(wsb + WS_CS64); GAS f32x2* c128 = (GAS f32x2*)(wsb + WS_CS128);
        for (int i = gt; i < S * 96; i += NGT) { const int s = i / 96, r = i % 96; const float pf = (float)pos[s]; float sn, cs;
            if (r < 32) { const float inv = exp2f(-(float)r * (2.0f / 64.f) * 13.287712379549449f); sincos_acc(pf * inv, sn, cs); c64[s * 32 + r] = (f32x2){cs, sn}; }
            else { const int q = r - 32; const float inv = exp2f(-(float)q * (2.0f / 128.f) * 13.287712379549449f); sincos_acc(pf * inv, sn, cs); c128[s * 64 + q] = (f32x2){cs, sn}; } }
    }
#if PROJ_I8
    p_rows<3>(F, (const float*)inb[0], nullptr, nullptr, nullptr, (const float*)inb[3]);
#else
    {
        const int gw = F.vcu * NWAVES + wave_, NGW = F.G * NWAVES;
        for (int m = gw; m < S; m += NGW) rms_row_to_bf16(lane_, (const float*)inb[0] + (size_t)m * DM, (const float*)inb[3], (bf16*)(wsb + WS_XN) + (size_t)m * DM);
    }
#endif
}
#if ROWS_X16
template <int MODE>
__device__ __forceinline__ void p_rows(Frame& F, const float* hprev32, const bf16* hprev16, bf16* hout16, const float* gpost, const float* gnext) {
    PH_TID();
    const int gw = F.vcu * NWAVES + wave_, NGW = F.G * NWAVES;
    const bf16* Mb = (const bf16*)(wsb + WS_M); const float* SS = (const float*)(wsb + WS_SS); bf16* XN = (bf16*)(wsb + WS_XN);
    f32x4 gpv[8], gnv[8];
#pragma unroll
    for (int j = 0; j < 8; ++j) { gpv[j] = (f32x4){0.f, 0.f, 0.f, 0.f}; gnv[j] = gpv[j]; }
    if (MODE < 2) { const GAS f32x4* gp = (const GAS f32x4*)gpost + 2 * lane_;
#pragma unroll
        for (int j = 0; j < 8; ++j) gpv[j] = gp[128 * (j >> 1) + (j & 1)]; }
    if (MODE != 1 && MODE != 4) { const GAS f32x4* gn = (const GAS f32x4*)gnext + 2 * lane_;
#pragma unroll
        for (int j = 0; j < 8; ++j) gnv[j] = gn[128 * (j >> 1) + (j & 1)]; }
    for (int s = gw; s < S; s += NGW) {
        GAS v4u* orow = (GAS v4u*)(hout16 + (size_t)s * DM) + lane_;
        f32x4 v[8];
        if (hprev32) { const GAS f32x4* hr = (const GAS f32x4*)(hprev32 + (size_t)s * DM) + 2 * lane_;
#pragma unroll
            for (int q = 0; q < 4; ++q) { v[2 * q] = hr[128 * q]; v[2 * q + 1] = hr[128 * q + 1]; } }
        else { const GAS v4u* hr = (const GAS v4u*)(hprev16 + (size_t)s * DM) + lane_;
#pragma unroll
            for (int q = 0; q < 4; ++q) { const v4u w = hr[64 * q]; v[2 * q] = (f32x4){bflo(w.x), bfhi(w.x), bflo(w.y), bfhi(w.y)}; v[2 * q + 1] = (f32x4){bflo(w.z), bfhi(w.z), bflo(w.w), bfhi(w.w)}; } }
        if (MODE < 2) {
            float t = SS[(size_t)s * 32 + (lane_ & 31)];
            t += shx<1>(t); t += shx<2>(t); t += shx<4>(t); t += shx<8>(t); t += shx<16>(t);
            const float rstd = 1.f / sqrtf(t * (1.f / DM) + NORM_EPS);
            const GAS v4u* mr = (const GAS v4u*)(Mb + (size_t)s * DM) + lane_;
#pragma unroll
            for (int q = 0; q < 4; ++q) { const v4u w = mr[64 * q]; const f32x4 g0 = gpv[2 * q], g1 = gpv[2 * q + 1];
                v[2 * q].x += bflo(w.x) * rstd * g0.x; v[2 * q].y += bfhi(w.x) * rstd * g0.y; v[2 * q].z += bflo(w.y) * rstd * g0.z; v[2 * q].w += bfhi(w.y) * rstd * g0.w;
                v[2 * q + 1].x += bflo(w.z) * rstd * g1.x; v[2 * q + 1].y += bfhi(w.z) * rstd * g1.y; v[2 * q + 1].z += bflo(w.w) * rstd * g1.z; v[2 * q + 1].w += bfhi(w.w) * rstd * g1.w;
                v4u hw; hw.x = pk2(v[2 * q].x, v[2 * q].y); hw.y = pk2(v[2 * q].z, v[2 * q].w); hw.z = pk2(v[2 * q + 1].x, v[2 * q + 1].y); hw.w = pk2(v[2 * q + 1].z, v[2 * q + 1].w); orow[64 * q] = hw; }
        }
        if (MODE == 1) {
            GAS v2u* o8 = (GAS v2u*)((unsigned char*)XN + (size_t)s * DM) + lane_;
#pragma unroll
            for (int q = 0; q < 4; ++q) o8[64 * q] = (v2u){pg8::pk4_fp8(v[2 * q].x, v[2 * q].y, v[2 * q].z, v[2 * q].w), pg8::pk4_fp8(v[2 * q + 1].x, v[2 * q + 1].y, v[2 * q + 1].z, v[2 * q + 1].w)};
        } else {
            float ss = 0.f;
#pragma unroll
            for (int j = 0; j < 8; ++j) ss += (v[j].x * v[j].x + v[j].y * v[j].y) + (v[j].z * v[j].z + v[j].w * v[j].w);
            const float r2 = MODE == 4 ? 1.f : 1.f / sqrtf(wave_sum(ss) * (1.f / DM) + NORM_EPS);
            float am = 0.f;
#pragma unroll
            for (int j = 0; j < 8; ++j) { const f32x4 g = MODE == 4 ? (f32x4){1.f, 1.f, 1.f, 1.f} : gnv[j]; v[j].x *= r2 * g.x; v[j].y *= r2 * g.y; v[j].z *= r2 * g.z; v[j].w *= r2 * g.w; am = fmaxf(fmaxf(am, fmaxf(fabsf(v[j].x), fabsf(v[j].y))), fmaxf(fabsf(v[j].z), fabsf(v[j].w))); }
            am = fmaxf(am, shx<1>(am)); am = fmaxf(am, shx<2>(am)); am = fmaxf(am, shx<4>(am)); am = fmaxf(am, shx<8>(am)); am = fmaxf(am, shx<16>(am)); am = max32(am); am = am > 0.f ? am : 1.f;
            const float inv = 127.f / am; GAS v2u* o8 = (GAS v2u*)(((MODE == 2 || MODE == 4) ? wsb + WS_HG : (unsigned char*)XN) + (size_t)s * DM) + lane_;
#pragma unroll
            for (int q = 0; q < 4; ++q) { unsigned w2[2];
#pragma unroll
                for (int e = 0; e < 2; ++e) { const f32x4 x = v[2 * q + e]; const int q0 = (int)__builtin_rintf(x.x * inv), q1 = (int)__builtin_rintf(x.y * inv), q2 = (int)__builtin_rintf(x.z * inv), q3 = (int)__builtin_rintf(x.w * inv);
                    w2[e] = ((unsigned)q0 & 0xffu) | (((unsigned)q1 & 0xffu) << 8) | (((unsigned)q2 & 0xffu) << 16) | ((unsigned)q3 << 24); }
                o8[64 * q] = (v2u){w2[0], w2[1]}; }
            if (lane_ == 0) ((float*)(wsb + (MODE == 2 ? WS_ASC2 : WS_ASC)))[s] = am * (1.f / 127.f);
        }
    }
}
#else
template <int MODE>
__device__ __forceinline__ void p_rows(Frame& F, const float* hprev32, const bf16* hprev16, bf16* hout16, const float* gpost, const float* gnext) {
    PH_TID();
    const int gw = F.vcu * NWAVES + wave_, NGW = F.G * NWAVES;
    const bf16* Mb = (const bf16*)(wsb + WS_M); const float* SS = (const float*)(wsb + WS_SS); bf16* XN = (bf16*)(wsb + WS_XN);
    for (int s = gw; s < S; s += NGW) {
        GAS v2u* orow = (GAS v2u*)(hout16 + (size_t)s * DM) + lane_;
        f32x4 v[8];
        if (hprev32) { const GAS f32x4* hr = (const GAS f32x4*)(hprev32 + (size_t)s * DM) + lane_;
#pragma unroll
            for (int j = 0; j < 8; ++j) v[j] = hr[64 * j]; }
        else { const GAS v2u* hr = (const GAS v2u*)(hprev16 + (size_t)s * DM) + lane_;
#pragma unroll
            for (int j = 0; j < 8; ++j) { const v2u w = hr[64 * j]; v[j] = (f32x4){bflo(w.x), bfhi(w.x), bflo(w.y), bfhi(w.y)}; } }
        if (MODE < 2) {
            float t = SS[(size_t)s * 32 + (lane_ & 31)];
            t += shx<1>(t); t += shx<2>(t); t += shx<4>(t); t += shx<8>(t); t += shx<16>(t);
            const float rstd = 1.f / sqrtf(t * (1.f / DM) + NORM_EPS);
            const GAS v2u* mr = (const GAS v2u*)(Mb + (size_t)s * DM) + lane_; const GAS f32x4* gp = (const GAS f32x4*)gpost + lane_;
#pragma unroll
            for (int j = 0; j < 8; ++j) { const v2u w = mr[64 * j]; const f32x4 g = gp[64 * j];
                v[j].x += bflo(w.x) * rstd * g.x; v[j].y += bfhi(w.x) * rstd * g.y; v[j].z += bflo(w.y) * rstd * g.z; v[j].w += bfhi(w.y) * rstd * g.w; v2u hw; hw.x = pk2(v[j].x, v[j].y); hw.y = pk2(v[j].z, v[j].w); orow[64 * j] = hw; }
        }
        if (MODE == 1) {
            GAS unsigned* o4 = (GAS unsigned*)((unsigned char*)XN + (size_t)s * DM) + lane_;
#pragma unroll
            for (int j = 0; j < 8; ++j) o4[64 * j] = pg8::pk4_fp8(v[j].x, v[j].y, v[j].z, v[j].w);
        } else {
            float ss = 0.f;
#pragma unroll
            for (int j = 0; j < 8; ++j) ss += (v[j].x * v[j].x + v[j].y * v[j].y) + (v[j].z * v[j].z + v[j].w * v[j].w);
            const float r2 = 1.f / sqrtf(wave_sum(ss) * (1.f / DM) + NORM_EPS); const GAS f32x4* gn = (const GAS f32x4*)gnext + lane_;
            float am = 0.f;
#pragma unroll
            for (int j = 0; j < 8; ++j) { const f32x4 g = gn[64 * j]; v[j].x *= r2 * g.x; v[j].y *= r2 * g.y; v[j].z *= r2 * g.z; v[j].w *= r2 * g.w; am = fmaxf(fmaxf(am, fmaxf(fabsf(v[j].x), fabsf(v[j].y))), fmaxf(fabsf(v[j].z), fabsf(v[j].w))); }
            am = fmaxf(am, shx<1>(am)); am = fmaxf(am, shx<2>(am)); am = fmaxf(am, shx<4>(am)); am = fmaxf(am, shx<8>(am)); am = fmaxf(am, shx<16>(am)); am = max32(am); am = am > 0.f ? am : 1.f;
            const float inv = 127.f / am; GAS unsigned* o4 = (GAS unsigned*)((MODE == 2 ? wsb + WS_HG : (unsigned char*)XN) + (size_t)s * DM) + lane_;
#pragma unroll
            for (int j = 0; j < 8; ++j) { const int q0 = (int)__builtin_rintf(v[j].x * inv), q1 = (int)__builtin_rintf(v[j].y * inv), q2 = (int)__builtin_rintf(v[j].z * inv), q3 = (int)__builtin_rintf(v[j].w * inv);
                o4[64 * j] = ((unsigned)q0 & 0xffu) | (((unsigned)q1 & 0xffu) << 8) | (((unsigned)q2 & 0xffu) << 16) | ((unsigned)q3 << 24); }
            if (lane_ == 0) ((float*)(wsb + (MODE == 2 ? WS_ASC2 : WS_ASC)))[s] = am * (1.f / 127.f);
        }
    }
}
#endif
__device__ __forceinline__ void p_l0_attn(Frame& F) {
    PH_TID();
    char* lds = (char*)F.ldsg; const int r32 = lane_ & 31, hi = lane_ >> 5;
    const bf16* Q = (const bf16*)(wsb + WS_Q); const bf16* KV = (const bf16*)(wsb + WS_KV); const bf16* SW = (const bf16*)(wsb + WS_SWAB); bf16* ATT = (bf16*)(wsb + WS_XN);
    for (int it = F.vcu; it < 256; it += F.G) {
        const int hm = it >> 5, x = it & 31;
        for (int pass = 0; pass < 2; ++pass) {
            const int qb = pass ? 63 - x : x, P0 = qb * 256, s = P0 + wave_ * 32 + r32;
            att::i32x8 qf[3]; { const unsigned char* q8 = (const unsigned char*)Q + (size_t)s * 1536 + hm * 192 + hi * 32;
#pragma unroll
                for (int g = 0; g < 3; ++g) { const att::i32x4v lo = *(const att::i32x4v*)(q8 + g * 64), hi4 = *(const att::i32x4v*)(q8 + g * 64 + 16); qf[g] = __builtin_shufflevector(lo, hi4, 0, 1, 2, 3, 4, 5, 6, 7); } }
            att::Job J; J.K = KV; J.ldk = 0; J.K2 = KV; J.ldk2 = 0; J.V = KV + hm * 256 + 128; J.ldv = 2048;
            J.wave = wave_; J.j_lo = 0; J.j_hi = 4 * qb + 4; J.wq_lo = P0 + wave_ * 32; J.qpos = s; J.W = 1u << 30; J.nomask = 0; J.m0 = -1e30f; J.l0 = 0.f;
            J.sc = 0.07216878364870322f; J.c2 = 0.07216878364870322f * 1.4426950408889634f;
            att::Job8v J8; J8.Kn = wsb + WS_K8N + hm * 128; J8.Kr = wsb + WS_KR8; J8.Vt = wsb + WS_VT8 + (size_t)hm * 128 * S; J8.ldvt = S;
            att::f32x16 o[4]; float m_reg, l_reg;
            att::attn_core_kv8x2<128>(F.lds, J, J8, qf, o, m_reg, l_reg);
            att::store_o<128, true>(F.lds, o, l_reg, ATT + (size_t)(P0 + wave_ * 32) * DM + hm * 128, DM, wave_);
            __syncthreads();
        }
    }
    const float* sinks = (const float*)inb[9];
    for (int rep2_ = 0; rep2_ < ((((DUP_MASK) >> 17) & 1) ? 2 : 1); ++rep2_)
    for (int u = F.vcu; u < 1024; u += F.G) {
        const int h = u >> 6, qb = u & 63, P0 = qb * 256, s = P0 + wave_ * 32 + r32, kvh = h >> 3;
        att::bf16x8 qr[4]; const bf16* qrow = SW + (size_t)s * SWAW + h * 64 + hi * 8;
#pragma unroll
        for (int d0 = 0; d0 < 4; ++d0) qr[d0] = *(const att::bf16x8*)(qrow + d0 * 16);
        att::Job J; J.K = SW + 1024 + kvh * 64; J.ldk = SWAW; J.K2 = J.K; J.ldk2 = SWAW; J.V = SW + 1152 + kvh * 64; J.ldv = SWAW;
        J.wave = wave_; J.j_lo = qb == 0 ? 0 : 4 * qb - 2; J.j_hi = 4 * qb + 4; J.wq_lo = P0 + wave_ * 32; J.qpos = s; J.W = 128u; J.nomask = 0; J.m0 = sinks[h] * 8.f; J.l0 = 1.f;
        J.sc = 0.125f; J.c2 = 0.125f * 1.4426950408889634f;
        att::f32x16 o[2]; float m_reg, l_reg;
        att::attn_core<64, 64>(F.lds, J, qr, o, m_reg, l_reg);
        att::store_o<64, true>(F.lds, o, l_reg, ATT + (size_t)(P0 + wave_ * 32) * DM + 1024 + h * 64, DM, wave_);
        __syncthreads();
    }
}
#if GATE_MFMA
#define GATE_INS(a_, n_) { const float a__ = (a_); const int n__ = (n_); \
    if (a__ > t0 || (a__ == t0 && n__ < i0)) { t2 = t1; i2 = i1; t1 = t0; i1 = i0; t0 = a__; i0 = n__; } \
    else if (a__ > t1 || (a__ == t1 && n__ < i1)) { t2 = t1; i2 = i1; t1 = a__; i1 = n__; } \
    else if (a__ > t2 || (a__ == t2 && n__ < i2)) { t2 = a__; i2 = n__; } }
__device__ __forceinline__ void p_l1_gate(Frame& F) {
    PH_TID();
    const bf16* QKV = (const bf16*)(wsb + WS_QKV); const float* KM = (const float*)(wsb + WS_KM); unsigned short* LIST = (unsigned short*)(wsb + WS_LIST);
    unsigned* CNT = (unsigned*)(F.ctl + CW_CNT); LAS unsigned char* L = F.lds;
    LAS unsigned* lc = (LAS unsigned*)(F.lds + X_WS);
    const int r32 = lane_ & 31, hi = lane_ >> 5;
    constexpr int KROW = 272, KLO = 64 * KROW;
    for (int u = F.vcu; u < 512; u += F.G) {
        const int h = u >> 5, c = (u < 256) ? (u & 31) : 31 - (u & 31), nrows = 2 * c + 1, nr32 = (nrows + 31) & ~31;
        if (tid_ < 64) lc[tid_] = 0u;
        for (int i = tid_; i < nr32 * 32; i += NWAVES * 64) { const int n = i >> 5, c4 = i & 31; f32x4 m = (f32x4){0.f, 0.f, 0.f, 0.f};
            if (n < nrows) { const GAS f32x4* p0 = (const GAS f32x4*)(KM + (size_t)(n * 2) * 2048 + h * 128) + c4; const f32x4 a = p0[0], bb = p0[512]; m = (a + bb) * (1.f / 256.f); }
            const unsigned h0 = f2bf(m.x), h1 = f2bf(m.y), h2 = f2bf(m.z), h3 = f2bf(m.w);
            const float l0 = m.x - __uint_as_float(h0 << 16), l1 = m.y - __uint_as_float(h1 << 16), l2 = m.z - __uint_as_float(h2 << 16), l3 = m.w - __uint_as_float(h3 << 16);
            *(LAS v2u*)(L + n * KROW + c4 * 8) = (v2u){h0 | (h1 << 16), h2 | (h3 << 16)}; *(LAS v2u*)(L + KLO + n * KROW + c4 * 8) = (v2u){pk2(l0, l1), pk2(l2, l3)}; }
        __syncthreads();
        const int qb = 2 * c + (wave_ >> 2), nvalid = qb < 3 ? qb : 3;
        int sel[2][3]; unsigned lp[2][3];
#pragma unroll
        for (int qt = 0; qt < 2; ++qt) { const int s = c * 512 + wave_ * 64 + qt * 32 + r32;
            att::bf16x8 qf[8]; { const bf16* qrow = QKV + (size_t)s * 6144 + h * 128 + hi * 8;
#pragma unroll
                for (int kk = 0; kk < 8; ++kk) qf[kk] = *(const att::bf16x8*)(qrow + kk * 16); }
            att::f32x16 acc0 = att::f32x16{}, acc1 = att::f32x16{};
            { const LAS unsigned char* rb = L + r32 * KROW + hi * 16;
#pragma unroll
              for (int kk = 0; kk < 8; ++kk) { const att::bf16x8 ah = *(const LAS att::bf16x8*)(rb + kk * 32), al = *(const LAS att::bf16x8*)(rb + KLO + kk * 32);
                  acc0 = __builtin_amdgcn_mfma_f32_32x32x16_bf16(ah, qf[kk], acc0, 0, 0, 0); acc0 = __builtin_amdgcn_mfma_f32_32x32x16_bf16(al, qf[kk], acc0, 0, 0, 0); }
              if (nrows > 32) {
#pragma unroll
                  for (int kk = 0; kk < 8; ++kk) { const att::bf16x8 ah = *(const LAS att::bf16x8*)(rb + 32 * KROW + kk * 32), al = *(const LAS att::bf16x8*)(rb + 32 * KROW + KLO + kk * 32);
                      acc1 = __builtin_amdgcn_mfma_f32_32x32x16_bf16(ah, qf[kk], acc1, 0, 0, 0); acc1 = __builtin_amdgcn_mfma_f32_32x32x16_bf16(al, qf[kk], acc1, 0, 0, 0); } } }
            float t0 = -__builtin_inff(), t1 = t0, t2 = t0; int i0 = 0, i1 = 0, i2 = 0;
#pragma unroll
            for (int i = 0; i < 16; ++i) { const int n = (i & 3) + 8 * (i >> 2) + 4 * hi; GATE_INS(n < qb ? acc0[i] : -__builtin_inff(), n); }
            if (nrows > 32) {
#pragma unroll
                for (int i = 0; i < 16; ++i) { const int n = 32 + (i & 3) + 8 * (i >> 2) + 4 * hi; GATE_INS(n < qb ? acc1[i] : -__builtin_inff(), n); } }
            {
                const auto rt0 = __builtin_amdgcn_permlane32_swap(__float_as_uint(t0), __float_as_uint(t0), false, false), rt1 = __builtin_amdgcn_permlane32_swap(__float_as_uint(t1), __float_as_uint(t1), false, false), rt2 = __builtin_amdgcn_permlane32_swap(__float_as_uint(t2), __float_as_uint(t2), false, false);
                const auto ri0 = __builtin_amdgcn_permlane32_swap((unsigned)i0, (unsigned)i0, false, false), ri1 = __builtin_amdgcn_permlane32_swap((unsigned)i1, (unsigned)i1, false, false), ri2 = __builtin_amdgcn_permlane32_swap((unsigned)i2, (unsigned)i2, false, false);
                t0 = __uint_as_float(rt0[0]); t1 = __uint_as_float(rt1[0]); t2 = __uint_as_float(rt2[0]); i0 = (int)ri0[0]; i1 = (int)ri1[0]; i2 = (int)ri2[0];
                GATE_INS(__uint_as_float(rt0[1]), (int)ri0[1]); GATE_INS(__uint_as_float(rt1[1]), (int)ri1[1]); GATE_INS(__uint_as_float(rt2[1]), (int)ri2[1]); }
            sel[qt][0] = i0; sel[qt][1] = i1; sel[qt][2] = i2;
#pragma unroll
            for (int r = 0; r < 3; ++r) { lp[qt][r] = 0u; if (hi == 0 && r < nvalid) lp[qt][r] = __hip_atomic_fetch_add(lc + sel[qt][r], 1u, __ATOMIC_RELAXED, __HIP_MEMORY_SCOPE_WORKGROUP); }
        }
        __syncthreads();
        if (tid_ < 64) { const unsigned n_ = lc[tid_]; lc[64 + tid_] = n_ ? atomicAdd(CNT + h * 64 + tid_, n_) : 0u; }
        __syncthreads();
        if (hi == 0) { unsigned short* lh = LIST + (size_t)h * LIST_PER_HEAD;
#pragma unroll
            for (int qt = 0; qt < 2; ++qt) { const int s = c * 512 + wave_ * 64 + qt * 32 + r32;
#pragma unroll
                for (int r = 0; r < 3; ++r) if (r < nvalid) { const int j = sel[qt][r]; lh[list_off(j) + lc[64 + j] + lp[qt][r]] = (unsigned short)(s | (r << 14)); } } }
        __syncthreads();
    }
}
#undef GATE_INS
#else
__device__ __forceinline__ void p_l1_gate(Frame& F) {
    PH_TID();
    const bf16* QKV = (const bf16*)(wsb + WS_QKV); const float* KM = (const float*)(wsb + WS_KM); unsigned short* LIST = (unsigned short*)(wsb + WS_LIST);
    unsigned* CNT = (unsigned*)(F.ctl + CW_CNT); LAS f32x4* km4 = (LAS f32x4*)F.lds;
    LAS unsigned* lc = (LAS unsigned*)(F.lds + X_WS);
    for (int u = F.vcu; u < 512; u += F.G) {
        const int h = u >> 5, c = (u < 256) ? (u & 31) : 31 - (u & 31), nrows = 2 * c + 1;
        if (tid_ < 64) lc[tid_] = 0u;
        for (int i = tid_; i < nrows * 32; i += NWAVES * 64) { const int n = i >> 5, c4 = i & 31; const GAS f32x4* p0 = (const GAS f32x4*)(KM + (size_t)(n * 2) * 2048 + h * 128) + c4; const f32x4 a = p0[0], bb = p0[512]; km4[i] = (a + bb) * (1.f / 256.f); }
        __syncthreads();
        const int s = c * 512 + tid_, qb = __builtin_amdgcn_readfirstlane(s >> 8);
        float q[128]; const GAS v4u* qp = (const GAS v4u*)(QKV + (size_t)s * 6144 + h * 128);
#pragma unroll
        for (int i = 0; i < 16; ++i) { const v4u w = qp[i]; q[8 * i] = bflo(w.x); q[8 * i + 1] = bfhi(w.x); q[8 * i + 2] = bflo(w.y); q[8 * i + 3] = bfhi(w.y); q[8 * i + 4] = bflo(w.z); q[8 * i + 5] = bfhi(w.z); q[8 * i + 6] = bflo(w.w); q[8 * i + 7] = bfhi(w.w); }
        float t0 = -__builtin_inff(), t1 = t0, t2 = t0; int i0 = 0, i1 = 0, i2 = 0;
        for (int n = 0; n < qb; ++n) { float a0 = 0.f, a1 = 0.f, a2 = 0.f, a3 = 0.f;
#pragma unroll
            for (int i = 0; i < 32; ++i) { const f32x4 k = km4[n * 32 + i]; a0 = fmaf(q[4 * i], k.x, a0); a1 = fmaf(q[4 * i + 1], k.y, a1); a2 = fmaf(q[4 * i + 2], k.z, a2); a3 = fmaf(q[4 * i + 3], k.w, a3); }
            const float a = (a0 + a1) + (a2 + a3);
            if (a > t0) { t2 = t1; i2 = i1; t1 = t0; i1 = i0; t0 = a; i0 = n; } else if (a > t1) { t2 = t1; i2 = i1; t1 = a; i1 = n; } else if (a > t2) { t2 = a; i2 = n; } }
        const int nvalid = qb < 3 ? qb : 3;
        unsigned lp0 = 0u, lp1 = 0u, lp2 = 0u;
        if (0 < nvalid) lp0 = __hip_atomic_fetch_add(lc + i0, 1u, __ATOMIC_RELAXED, __HIP_MEMORY_SCOPE_WORKGROUP);
        if (1 < nvalid) lp1 = __hip_atomic_fetch_add(lc + i1, 1u, __ATOMIC_RELAXED, __HIP_MEMORY_SCOPE_WORKGROUP);
        if (2 < nvalid) lp2 = __hip_atomic_fetch_add(lc + i2, 1u, __ATOMIC_RELAXED, __HIP_MEMORY_SCOPE_WORKGROUP);
        __syncthreads();
        if (tid_ < 64) { const unsigned n_ = lc[tid_]; lc[64 + tid_] = n_ ? atomicAdd(CNT + h * 64 + tid_, n_) : 0u; }
        __syncthreads();
        { unsigned short* lh = LIST + (size_t)h * LIST_PER_HEAD;
          if (0 < nvalid) lh[list_off(i0) + lc[64 + i0] + lp0] = (unsigned short)(s | (0 << 14));
          if (1 < nvalid) lh[list_off(i1) + lc[64 + i1] + lp1] = (unsigned short)(s | (1 << 14));
          if (2 < nvalid) lh[list_off(i2) + lc[64 + i2] + lp2] = (unsigned short)(s | (2 << 14)); }
        __syncthreads();
    }
}
#endif
constexpr int MOBA_CH = 32;
constexpr int X_RT = X_WS + 2048, X_PFX = X_RT + 1024, X_Q = X_PFX + 8320, X_ST = X_Q + 16, X_END = X_ST + 16384;
static_assert(X_END <= LDS_BYTES, "MoBA scratch beyond the ring");
__device__ __forceinline__ void p_l1_items(Frame& F, int qslot) {
    PH_TID();
    const int r32 = lane_ & 31, hi = lane_ >> 5;
    const bf16* QKV = (const bf16*)(wsb + WS_QKV); const unsigned char* QK8 = wsb + WS_QK8; const unsigned short* LIST = (const unsigned short*)(wsb + WS_LIST); const unsigned* CNT = (const unsigned*)(F.ctl + CW_CNT);
    unsigned char* PART = wsb + WS_PART; float* PLSE = (float*)(wsb + WS_PLSE); unsigned* QH = (unsigned*)(F.ctl + CW_QH) + 64 * qslot;
    LAS int* pfx = (LAS int*)(F.lds + X_PFX); LAS int* cn = pfx + 1032; LAS int* wt = pfx + 2064; LAS int* qw = (LAS int*)(F.lds + X_Q);
    {
        int v2[2];
#pragma unroll
        for (int k = 0; k < 2; ++k) { const int e = 2 * tid_ + k, j = e >> 4, h = e & 15;
            const int cnt = (int)__hip_atomic_load(CNT + h * 64 + j, __ATOMIC_RELAXED, __HIP_MEMORY_SCOPE_AGENT); const int nch = 8 + (cnt + 31) / 32; v2[k] = (nch + MOBA_CH - 1) / MOBA_CH; cn[e] = cnt; }
        int v = v2[0] + v2[1];
#pragma unroll
        for (int o = 1; o < 64; o <<= 1) { const int t = __builtin_amdgcn_ds_bpermute(((lane_ - o) & 63) << 2, v); if (lane_ >= o) v += t; }
        if (lane_ == 63) wt[wave_] = v;
        __syncthreads();
        int base = 0; for (int w = 0; w < wave_; ++w) base += wt[w];
        pfx[2 * tid_ + 2] = base + v; pfx[2 * tid_ + 1] = base + v - v2[1]; if (tid_ == 0) pfx[0] = 0;
        __syncthreads();
    }
    const int total = pfx[1024]; int* rtab = (int*)((char*)F.ldsg + X_RT) + wave_ * 32;
    const float sc = 0.08838834764831845f, c2 = 0.08838834764831845f * 1.4426950408889634f;
    int voff8; { const int q = wave_ * 64 + lane_, row = q >> 2, pos = q & 3, ch = pos ^ ((row >> 2) & 3); voff8 = row * S + ch * 16; }
    int voff[2]; int koff8; { const int q = wave_ * 64 + lane_, row = q >> 3, pos = q & 7, ch = pos ^ ((row >> 1) & 7); koff8 = row * 4096 + ch * 16; }
#pragma unroll
    for (int i = 0; i < 2; ++i) { const int q = (wave_ * 2 + i) * 64 + lane_;
        const int st = q >> 5, w = q & 31, kk = ((st >> 2) << 3) | (w >> 2), c = (st & 3) * 32 + (w & 3) * 8, k = (kk & ~0xC) | ((kk & 4) << 1) | ((kk & 8) >> 1); voff[i] = k * 6144 + c; }
    if (tid_ == 0) qw[0] = (int)atomicAdd(QH, 1u);
    __syncthreads();
    for (int par = 0;; par ^= 1) {
        const int it = qw[par];
        if (it >= total) break;
        unsigned nxt_ = 0u; if (tid_ == 0) nxt_ = atomicAdd(QH, 1u);
        int lo = 0, hi_ = 1024;
        while (hi_ - lo > 1) { const int mid = (lo + hi_) >> 1; if (pfx[mid] <= it) lo = mid; else hi_ = mid; }
        const int e = lo, j = e >> 4, h = e & 15, sub = it - pfx[e], cnt = cn[e], nch = 8 + (cnt + 31) / 32;
        const int c_lo = sub * MOBA_CH, c_hi = (c_lo + MOBA_CH < nch) ? c_lo + MOBA_CH : nch;
        {
            const unsigned char* K8b = QK8 + (size_t)(256 * j) * 4096 + 2048 + h * 128; const unsigned char* Vtb = wsb + WS_VT8B + (size_t)h * 128 * S + 256 * j;
#pragma unroll
            for (int t = 0; t < 4; ++t) {
                __builtin_amdgcn_global_load_lds((const unsigned*)(K8b + (size_t)t * 64 * 4096 + koff8), (LAS unsigned*)(F.lds + t * 8192 + wave_ * 1024), 16, 0, 0);
                __builtin_amdgcn_global_load_lds((const unsigned*)(Vtb + t * 64 + voff8), (LAS unsigned*)(F.lds + 32768 + t * 8192 + wave_ * 1024), 16, 0, 0); }
            asm volatile("s_waitcnt vmcnt(0)" ::: "memory");
        }
        __syncthreads();
        for (int c = c_lo + wave_; c < c_hi; c += 8) {
            int s, slot, ntile; bool valid = true;
            if (c < 8) { s = 256 * j + 32 * c + r32; slot = 3; ntile = (c >> 1) + 1; }
            else { const int gi = (c - 8) * 32 + r32; valid = gi < cnt; const unsigned ent = LIST[(size_t)h * LIST_PER_HEAD + list_off(j) + (valid ? gi : cnt - 1)]; s = ent & 16383; slot = ent >> 14; ntile = 4; }
            const int didx = (s * 16 + h) * 4 + slot;
            if (hi == 0) rtab[r32] = valid ? didx : -1;
            att::i32x8 qf[2]; { const unsigned char* q8 = QK8 + (size_t)s * 4096 + h * 128 + hi * 32;
#pragma unroll
                for (int g = 0; g < 2; ++g) { const att::i32x4v lo4 = *(const att::i32x4v*)(q8 + g * 64), hi4 = *(const att::i32x4v*)(q8 + g * 64 + 16); qf[g] = __builtin_shufflevector(lo4, hi4, 0, 1, 2, 3, 4, 5, 6, 7); } }
            att::f32x16 o[4]; float m_reg, l_reg;
            att::chunk_resident_kv8(F.lds, 0, 32768, X_WS, ntile, c < 8, 32 * c, 32 * c + r32, sc, c2, qf, o, m_reg, l_reg, wave_);
            att::store_o_staged8(F.lds, o, l_reg, PART, X_WS, X_RT, X_ST, wave_);
            if (hi == 0 && valid) PLSE[didx] = m_reg * c2 + __builtin_amdgcn_logf(l_reg);
        }
        if (tid_ == 0) qw[par ^ 1] = (int)nxt_;
        __syncthreads();
    }
}
__device__ __forceinline__ f32x4 sel4(bool c, f32x4 x, f32x4 y) { return (f32x4){c ? x[0] : y[0], c ? x[1] : y[1], c ? x[2] : y[2], c ? x[3] : y[3]}; }
template <int K> __device__ __forceinline__ f32x4 shx4(f32x4 v) { return (f32x4){shx<K>(v[0]), shx<K>(v[1]), shx<K>(v[2]), shx<K>(v[3])}; }
__device__ __forceinline__ void p_l1_combine(Frame& F) {
    PH_TID();
    const int gw = F.vcu * NWAVES + wave_, NGW = F.G * NWAVES;
    const unsigned char* PART = wsb + WS_PART; const float* PLSE = (const float*)(wsb + WS_PLSE); bf16* ATT = (bf16*)(wsb + WS_XN);
    const int slot = (lane_ >> 3) & 3, dch = lane_ & 7;
#if OUT1_I8
    const bool b0 = (slot & 1) != 0, b1 = (slot & 2) != 0;
#define CMB_LOAD(s_, L_, P_) { const int qb_ = (s_) >> 8, nv_ = qb_ < 3 ? qb_ : 3; const bool vl_ = (slot == 3) || (slot < nv_); \
        _Pragma("unroll") for (int i = 0; i < 8; ++i) { const int idx_ = ((s_) * 16 + 2 * i + (lane_ >> 5)) * 4 + slot; { f32x4 l4_ = *(const GAS f32x4*)(PLSE + (idx_ - slot)); const float ni_ = -__builtin_inff(); l4_.x = nv_ > 0 ? l4_.x : ni_; l4_.y = nv_ > 1 ? l4_.y : ni_; l4_.z = nv_ > 2 ? l4_.z : ni_; L_[i] = l4_; } P_[i] = (v4u){0u, 0u, 0u, 0u}; if (vl_) P_[i] = *(const GAS v4u*)(PART + (size_t)idx_ * 128 + dch * 16); } }
    f32x4 lse_[8]; v4u pw_[8];
#pragma unroll
    for (int i = 0; i < 8; ++i) { lse_[i] = (f32x4){0.f, 0.f, 0.f, 0.f}; pw_[i] = (v4u){0u, 0u, 0u, 0u}; }
    if (gw < S) CMB_LOAD(gw, lse_, pw_);
    for (int s = gw; s < S; s += NGW) {
        f32x4 lseN[8]; v4u pwN[8];
#pragma unroll
        for (int i = 0; i < 8; ++i) { lseN[i] = (f32x4){0.f, 0.f, 0.f, 0.f}; pwN[i] = (v4u){0u, 0u, 0u, 0u}; }
        if (s + NGW < S) CMB_LOAD(s + NGW, lseN, pwN);
        f32x4 keep[8]; float am = 0.f;
#pragma unroll
        for (int i = 0; i < 8; ++i) {
            const f32x4 l4 = lse_[i]; const float mx = fmaxf(fmaxf(l4.x, l4.y), fmaxf(l4.z, l4.w));
            const float w0 = __builtin_amdgcn_exp2f(l4.x - mx), w1 = __builtin_amdgcn_exp2f(l4.y - mx), w2 = __builtin_amdgcn_exp2f(l4.z - mx), w3 = __builtin_amdgcn_exp2f(l4.w - mx);
            const float wsum = (w0 + w1) + (w2 + w3), w = b1 ? (b0 ? w3 : w2) : (b0 ? w1 : w0);
            const v4u pw = pw_[i];
            f32x4 a0, a1, a2, a3;
            { const f32x2 l0 = __builtin_amdgcn_cvt_pk_f32_fp8((int)pw.x, false), h0 = __builtin_amdgcn_cvt_pk_f32_fp8((int)pw.x, true); a0 = (f32x4){l0.x * w, l0.y * w, h0.x * w, h0.y * w}; }
            { const f32x2 l0 = __builtin_amdgcn_cvt_pk_f32_fp8((int)pw.y, false), h0 = __builtin_amdgcn_cvt_pk_f32_fp8((int)pw.y, true); a1 = (f32x4){l0.x * w, l0.y * w, h0.x * w, h0.y * w}; }
            { const f32x2 l0 = __builtin_amdgcn_cvt_pk_f32_fp8((int)pw.z, false), h0 = __builtin_amdgcn_cvt_pk_f32_fp8((int)pw.z, true); a2 = (f32x4){l0.x * w, l0.y * w, h0.x * w, h0.y * w}; }
            { const f32x2 l0 = __builtin_amdgcn_cvt_pk_f32_fp8((int)pw.w, false), h0 = __builtin_amdgcn_cvt_pk_f32_fp8((int)pw.w, true); a3 = (f32x4){l0.x * w, l0.y * w, h0.x * w, h0.y * w}; }
            const f32x4 r0 = sel4(b0, a1, a0) + shx4<8>(sel4(b0, a0, a1)), r1 = sel4(b0, a3, a2) + shx4<8>(sel4(b0, a2, a3));
            const f32x4 f = (sel4(b1, r1, r0) + shx4<16>(sel4(b1, r0, r1))) * ((1.f / 16.f) / wsum);
            keep[i] = f; am = fmaxf(am, fmaxf(fmaxf(fabsf(f[0]), fabsf(f[1])), fmaxf(fabsf(f[2]), fabsf(f[3]))));
        }
        am = fmaxf(am, shx<1>(am)); am = fmaxf(am, shx<2>(am)); am = fmaxf(am, shx<4>(am)); am = fmaxf(am, shx<8>(am)); am = fmaxf(am, shx<16>(am)); am = max32(am); am = am > 0.f ? am : 1.f;
        const float inv = 127.f / am; GAS unsigned* o4 = (GAS unsigned*)((unsigned char*)ATT + (size_t)s * DM + (lane_ >> 5) * 128 + dch * 16 + slot * 4);
#pragma unroll
        for (int i = 0; i < 8; ++i) { const int q0 = (int)__builtin_rintf(keep[i][0] * inv), q1 = (int)__builtin_rintf(keep[i][1] * inv), q2 = (int)__builtin_rintf(keep[i][2] * inv), q3 = (int)__builtin_rintf(keep[i][3] * inv);
            o4[64 * i] = ((unsigned)q0 & 0xffu) | (((unsigned)q1 & 0xffu) << 8) | (((unsigned)q2 & 0xffu) << 16) | ((unsigned)q3 << 24); }
        if (lane_ == 0) ((float*)(wsb + WS_ASC))[s] = am * (1.f / 127.f);
#pragma unroll
        for (int i = 0; i < 8; ++i) { lse_[i] = lseN[i]; pw_[i] = pwN[i]; }
    }
#undef CMB_LOAD
#else
    for (int s = gw; s < S; s += NGW) {
        const int qb = s >> 8, nvalid = qb < 3 ? qb : 3; const bool valid = (slot == 3) || (slot < nvalid);
#pragma unroll
        for (int i = 0; i < 8; ++i) { const int h = 2 * i + (lane_ >> 5), idx = (s * 16 + h) * 4 + slot;
            const float lse = valid ? PLSE[idx] : -__builtin_inff(); float mx = fmaxf(lse, shx<8>(lse)); mx = fmaxf(mx, shx<16>(mx));
            const float w = valid ? __builtin_amdgcn_exp2f(lse - mx) : 0.f; float wsum = w + shx<8>(w); wsum += shx<16>(wsum);
            v4u pw = (v4u){0u, 0u, 0u, 0u}; if (valid) pw = *(const GAS v4u*)(PART + (size_t)idx * 128 + dch * 16);
            const unsigned pwv[4] = {pw.x, pw.y, pw.z, pw.w}; float a[16];
#pragma unroll
            for (int q = 0; q < 4; ++q) { const f32x2 lo = __builtin_amdgcn_cvt_pk_f32_fp8((int)pwv[q], false), hi2 = __builtin_amdgcn_cvt_pk_f32_fp8((int)pwv[q], true);
                a[4 * q] = lo.x * w; a[4 * q + 1] = lo.y * w; a[4 * q + 2] = hi2.x * w; a[4 * q + 3] = hi2.y * w; }
#pragma unroll
            for (int e = 0; e < 16; ++e) { a[e] += shx<8>(a[e]); a[e] += shx<16>(a[e]); }
            if (slot == 0) { const float rw = (1.f / 16.f) / wsum; v4u o0, o1;
                o0.x = pk2(a[0] * rw, a[1] * rw); o0.y = pk2(a[2] * rw, a[3] * rw); o0.z = pk2(a[4] * rw, a[5] * rw); o0.w = pk2(a[6] * rw, a[7] * rw);
                o1.x = pk2(a[8] * rw, a[9] * rw); o1.y = pk2(a[10] * rw, a[11] * rw); o1.z = pk2(a[12] * rw, a[13] * rw); o1.w = pk2(a[14] * rw, a[15] * rw);
                GAS v4u* op = (GAS v4u*)(ATT + (size_t)s * DM + h * 128 + dch * 16); op[0] = o0; op[1] = o1; } }
    }
#endif
}

struct CfgBase { static constexpr int BF16_NT = 1 << 20; static constexpr bool I8IN = false; static constexpr size_t ASC_OFF = 0, WSC_OFF = 0; static constexpr int F8MODE = 0; static constexpr size_t K8_OFF = 0, KR8_OFF = 0, VT8_OFF = 0, SROWS = S; static constexpr bool ROWSCALE = false, GAINSS = false, COLSUM = false; static constexpr int NSS = 4, ROPE = 0, ROPE_KIND = 0;
    static constexpr size_t O0_OFF = 0, O1_OFF = 0, SSIN_OFF = 0, SSOUT_OFF = 0, CS_OFF = 0, KMP_OFF = 0; static constexpr int LD0 = 0, NT0 = 1 << 20, LD1 = 0, NC1 = 0, SSIN_STRIDE = 0, SSIN_IDX = 0, SSOUT_STRIDE = 0, GSPLIT = 1 << 30, CS_LO = 0, CS_HI = 0, CS_LD = 0;
    static constexpr float INV_N = 0.f; };
struct CfgProj : CfgBase {
    static constexpr int F8MODE = 3; static constexpr size_t KR8_OFF = WS_KR8;
#if PROJ_I8
    static constexpr bool I8IN = true; static constexpr size_t ASC_OFF = WS_ASC, WSC_OFF = wo_upsc(3);
#endif
    static constexpr bool GAINSS = true; static constexpr int ROPE = 64, ROPE_KIND = 1, LD0 = 1024, NT0 = 4, LD1 = SWAW, NC1 = SWAW, SSOUT_STRIDE = 16, GSPLIT = 512;
    static constexpr size_t O0_OFF = WS_CQKV, O1_OFF = WS_SWAB, SSOUT_OFF = WS_SSQ, CS_OFF = WS_CS64; };
struct CfgQup : CfgBase {
    static constexpr int F8MODE = 1;
    static constexpr bool ROWSCALE = true; static constexpr int NSS = 8, ROPE = 64, ROPE_KIND = 2, LD0 = 1536, SSIN_STRIDE = 16, SSIN_IDX = 0;
    static constexpr size_t O0_OFF = WS_Q, SSIN_OFF = WS_SSQ, CS_OFF = WS_CS64; static constexpr float INV_N = 1.f / 512.f; };
struct CfgKVup : CfgBase {
    static constexpr int F8MODE = 2, BF16_NT = 0; static constexpr size_t K8_OFF = WS_K8N, VT8_OFF = WS_VT8;
    static constexpr bool ROWSCALE = true; static constexpr int NSS = 8, LD0 = 2048, SSIN_STRIDE = 16, SSIN_IDX = 8;
    static constexpr size_t O0_OFF = WS_KV, SSIN_OFF = WS_SSQ; static constexpr float INV_N = 1.f / 512.f; };
struct CfgQKV : CfgBase {
    static constexpr int F8MODE = 4, BF16_NT = 8; static constexpr size_t K8_OFF = WS_QK8, VT8_OFF = WS_VT8B;
#if QKV_I8
    static constexpr bool I8IN = true, ROWSCALE = false; static constexpr size_t ASC_OFF = WS_ASC2, WSC_OFF = wo_upsc(2);
#else
    static constexpr bool ROWSCALE = true;
#endif
    static constexpr bool COLSUM = true; static constexpr int NSS = 32, ROPE = 128, ROPE_KIND = 3, LD0 = 6144, SSIN_STRIDE = 32, SSIN_IDX = 0, CS_LO = 8, CS_HI = 16, CS_LD = 2048;
    static constexpr size_t O0_OFF = WS_QKV, SSIN_OFF = WS_SS, CS_OFF = WS_CS128, KMP_OFF = WS_KM; static constexpr float INV_N = 1.f / 2048.f; };

struct CfgOut1 { static constexpr size_t O_OFF = WS_M, SS_OFF = WS_SS, ASC_OFF = WS_ASC, WSC_OFF = wo_upsc(4); static constexpr int LD = DM; };
struct CfgOut0 { static constexpr size_t O_OFF = WS_M, SS_OFF = WS_SS, ASC_OFF = WS_ASC, WSC_OFF = wo_upsc(5); static constexpr int LD = DM; };

struct Args { const void* in[23]; float* out; unsigned char* ws; int ph_lo, ph_hi, li, pad; };
constexpr int NPH = 21;
__global__ void __launch_bounds__(NWAVES * 64, 2) fwd(Args args) {
    extern __shared__ __attribute__((aligned(16))) unsigned char lds[];
    Frame F;
    F.lds = (LAS unsigned char*)lds; F.ldsg = lds; F.MISC = (volatile LAS unsigned*)(F.lds + MISC_OFF);
    F.wave = __builtin_amdgcn_readfirstlane((int)threadIdx.x >> 6);
    F.G = gridDim.x; { const int bx = blockIdx.x; F.vcu = (F.G % 8 == 0) ? (bx % 8) * (F.G / 8) + bx / 8 : bx; }
    F.in = args.in; F.out = args.out; F.ws = args.ws; F.ctl = (gu32*)(args.ws + WS_CTL);
    for (int u = threadIdx.x; u < (LDS_BYTES - LDSCTL_OFF) / 4; u += NWAVES * 64) ((LAS unsigned*)(F.lds + LDSCTL_OFF))[u] = 0u;
    __syncthreads();
    XcdBarrier bar = xcd_barrier_post((unsigned*)(F.ctl + CW_BAR) + args.li * XCD_BAR_WORDS, F.MISC + 8);
    const int lo = args.ph_lo, hi = args.ph_hi; (void)lo; (void)hi;
#ifndef KMASK
#define KMASK 0xfffff
#endif
#define KIND(k) (((KMASK) >> (k)) & 1)
#ifndef DUP_MASK
#define DUP_MASK 0
#endif
#define REP(k) for (int rep_ = 0; rep_ < ((((DUP_MASK) >> (k)) & 1) ? 2 : 1); ++rep_)
#if MK_N_LAUNCHES == 1
#define IN(k) true
#else
#define IN(k) (lo <= (k) && (k) < hi)
#endif
#define SEAM(k) do { if (IN(k) && IN((k) + 1)) xcd_barrier(bar); } while (0)
#define PHB() unsigned oz_; asm volatile("s_mov_b32 %0, 0" : "=s"(oz_)); unsigned char* ws = args.ws + oz_; const void* const* inp = args.in + oz_; \
    bf16* WB = (bf16*)(ws + WS_WB); bf16* XN = (bf16*)(ws + WS_XN); bf16* Mb = (bf16*)(ws + WS_M); float* SS = (float*)(ws + WS_SS); float* SSQ = (float*)(ws + WS_SSQ); \
    const float* CS64 = (const float*)(ws + WS_CS64); const float* CS128 = (const float*)(ws + WS_CS128); (void)WB; (void)XN; (void)Mb; (void)SS; (void)SSQ; (void)CS64; (void)CS128; (void)inp
#define WBP(off) ((const pg8::bf16_t*)((const char*)WB + (off)))
#ifndef DUPG
#define DUPG 0
#endif
#define RUN_GEMM(KD, EPI_T, Ap, lda_, Bp, M_, N_, K_, Eobj) do { RUN_GEMM1(EPI_T, Ap, lda_, Bp, M_, N_, K_, Eobj); if (((DUPG) >> (KD)) & 1) RUN_GEMM1(EPI_T, Ap, lda_, Bp, M_, N_, K_, Eobj); } while (0)
#ifndef F8_SP2
#define F8_SP2 true
#endif
#ifndef F8_ALIGN
#define F8_ALIGN true
#endif
#define RUN_GEMMI8(EPI_T, Ap, lda_, Bp, M_, N_, K_, Eobj) do { pg8::Gemm g_{(const pg8::bf16_t*)(Ap), (Bp), (M_), (N_), (K_) / 2, (lda_) / 2, F.wave}; pg8::StaticOrder S_; S_.init((M_), (N_), F.G, (int)blockIdx.x); \
        pg8::gemm_phase<EPI_T, pg8::StaticOrder, true, true, 2>(F.lds, g_, S_, Eobj); } while (0)
#define RUN_GEMM8(EPI_T, Ap, lda_, Bp, M_, N_, K_, Eobj) do { pg8::Gemm g_{(const pg8::bf16_t*)(Ap), (Bp), (M_), (N_), (K_) / 2, (lda_) / 2, F.wave}; pg8::StaticOrder S_; S_.init((M_), (N_), F.G, (int)blockIdx.x); \
        pg8::gemm_phase<EPI_T, pg8::StaticOrder, F8_ALIGN, F8_SP2, 1>(F.lds, g_, S_, Eobj); } while (0)
#define RUN_GEMM1(EPI_T, Ap, lda_, Bp, M_, N_, K_, Eobj) do { pg8::Gemm g_{(const pg8::bf16_t*)(Ap), (Bp), (M_), (N_), (K_), (lda_), F.wave}; pg8::StaticOrder S_; S_.init((M_), (N_), F.G, (int)blockIdx.x); \
        pg8::gemm_phase<EPI_T, pg8::StaticOrder, true, true>(F.lds, g_, S_, Eobj); } while (0)

    if (KIND(0) && IN(0)) { REP(0) p_prologue(F); } SEAM(0);
#pragma unroll 1
    for (int l = 0; l < 2; ++l) {
        if (l == 0) {
            if (KIND(1) && IN(1)) { PHB();
                pg8::EpiX<CfgProj> E{ws, (const float*)inp[5], (const float*)inp[7]};
#if PROJ_I8
                RUN_GEMMI8(decltype(E), XN, DM, WBP(WB_IN), S, NIN_PAD, DM, E); } SEAM(1);
#else
                RUN_GEMM(1, decltype(E), XN, DM, WBP(WB_IN), S, NIN_PAD, DM, E); } SEAM(1);
#endif
            if (KIND(3) && IN(2)) { PHB();
                { pg8::EpiX<CfgQup> E{ws, nullptr, nullptr}; RUN_GEMM(3, decltype(E), ws + WS_CQKV, 1024, WBP(WB_QUP), S, 1536, 512, E); }
                { pg8::EpiX<CfgKVup> E{ws, nullptr, nullptr}; RUN_GEMM(3, decltype(E), ws + WS_CQKV + 1024, 1024, WBP(WB_KVUP), S, 2048, 512, E); } } SEAM(2);
            if (KIND(4) && IN(3)) { REP(4) p_l0_attn(F); } SEAM(3);
#if OUT0_I8
            if (KIND(4) && IN(3)) { PHB(); p_rows<4>(F, nullptr, (const bf16*)XN, nullptr, nullptr, nullptr); } SEAM(3);
#endif
        } else {
#if QKV_I8
            if (KIND(11) && IN(10)) { PHB(); p_rows<2>(F, nullptr, (const bf16*)args.out, nullptr, nullptr, (const float*)inp[12]); } SEAM(10);
            if (KIND(12) && IN(11)) { PHB();
                pg8::EpiX<CfgQKV> E{ws, nullptr, nullptr};
                RUN_GEMMI8(decltype(E), ws + WS_HG, DM, (const pg8::bf16_t*)(ws + WS_WQKV1), S, 6144, DM, E); } SEAM(11);
#else
            if (KIND(12) && IN(11)) { PHB();
                pg8::EpiX<CfgQKV> E{ws, nullptr, nullptr};
                RUN_GEMM(12, decltype(E), ws + WS_HG, DM, (const pg8::bf16_t*)(ws + WS_WQKV1), S, 6144, DM, E); } SEAM(11);
#endif
            if (KIND(14) && IN(12)) { p_l1_gate(F); } SEAM(12);
            if (KIND(15) && IN(13)) { REP(15) p_l1_items(F, rep_); } SEAM(13);
            if (KIND(16) && IN(14)) { REP(16) p_l1_combine(F); } SEAM(14);
        }
        const int tb = l ? 15 : 4;
        if (KIND(5) && IN(tb + 0)) { PHB();
#if OUT1_I8
            if (l == 1) { pg8::EpiOutI8<CfgOut1> E{ws}; RUN_GEMMI8(decltype(E), XN, DM, (const pg8::bf16_t*)(ws + wo_out(1)), S, DM, DM, E); } else
#endif
#if OUT0_I8
            { pg8::EpiOutI8<CfgOut0> E{ws}; RUN_GEMMI8(decltype(E), ws + WS_HG, DM, (const pg8::bf16_t*)(ws + wo_out(0)), S, DM, DM, E); } } SEAM(tb + 0);
#else
            { pg8::EpiStore<0, true> E{(pg8::bf16_t*)Mb, DM, 1 << 20, nullptr, 0, 0, SS}; RUN_GEMM(5, decltype(E), XN, DM, (const pg8::bf16_t*)(ws + wo_out(l)), S, DM, DM, E); } } SEAM(tb + 0);
#endif
        if (KIND(6) && IN(tb + 1)) { PHB(); p_rows<0>(F, l == 0 ? (const float*)inp[0] : nullptr, (const bf16*)args.out, (bf16*)args.out, (const float*)inp[l == 0 ? 11 : 15], (const float*)inp[16] + l * DM); } SEAM(tb + 1);
        if (KIND(7) && IN(tb + 2)) { PHB();
            pg8::EpiUpI8 E{ws + WS_HID, FF, (const float*)(ws + WS_ASC), (const float*)(ws + wo_upsc(l))}; RUN_GEMMI8(decltype(E), XN, DM, (const pg8::bf16_t*)(ws + wo_up(l)), S, FF, DM, E); } SEAM(tb + 2);
        if (KIND(8) && IN(tb + 3)) { PHB();
            pg8::EpiDown8 E{(pg8::bf16_t*)Mb, DM, SS, 1.f / W8_DOWN_SC}; RUN_GEMM8(decltype(E), ws + WS_HID, FF, (const pg8::bf16_t*)(ws + wo_down(l)), S, DM, FF, E); } SEAM(tb + 3);
        if (KIND(9) && IN(tb + 4)) { PHB();
            p_rows<1>(F, nullptr, (const bf16*)args.out, l == 0 ? (bf16*)args.out : (bf16*)(ws + WS_H16L), (const float*)inp[19] + l * DM, nullptr);
            pg8::EpiStore8 E{ws + WS_PP, DM}; RUN_GEMM(9, decltype(E), ws + WS_PB + (size_t)l * S * PLED * 2, PLED, (const pg8::bf16_t*)(ws + wo_proj(l)), S, DM, PLED, E); } SEAM(tb + 4);
        if (l == 0) {
            if (KIND(10) && IN(tb + 5)) { PHB();
                pg8::EpiPle<true> E{(pg8::bf16_t*)args.out, nullptr, ws + WS_PP, (const float*)inp[21], DM, (pg8::bf16_t*)(ws + WS_HG), (const float*)inp[12], SS, 1.f / W8_GATE_SC}; RUN_GEMM8(pg8::EpiPle<true>, XN, DM, (const pg8::bf16_t*)(ws + wo_gate(0)), S, DM, DM, E); } SEAM(tb + 5);
        } else {
            if (KIND(10) && IN(tb + 5)) { PHB(); pg8::EpiPle<false> E{(pg8::bf16_t*)(ws + WS_H16L), args.out, ws + WS_PP, (const float*)inp[21] + DM, DM, nullptr, nullptr, nullptr, 1.f / W8_GATE_SC}; RUN_GEMM8(pg8::EpiPle<false>, XN, DM, (const pg8::bf16_t*)(ws + wo_gate(1)), S, DM, DM, E); }
        }
    }
#undef IN
#undef SEAM
}

extern "C" void kernel_launch(void* const* d_in, const int* in_sizes, int n_in, void* d_out, int out_size, void* d_ws, size_t ws_size, hipStream_t stream) {
    static int grid = 0;
    if (grid == 0) {
        if (n_in != 23 || in_sizes[0] != S * DM || out_size != S * DM || ws_size < WS_END) { fprintf(stderr, "kernel_launch: unexpected shapes / workspace (%d inputs, ws %zu)\n", n_in, ws_size); grid = -1; return; }
        int dev = 0, cus = 0, per_cu = 0;
        if (hipGetDevice(&dev) != hipSuccess || hipDeviceGetAttribute(&cus, hipDeviceAttributeMultiprocessorCount, dev) != hipSuccess) { grid = -1; return; }
        if (hipFuncSetAttribute((const void*)fwd, hipFuncAttributeMaxDynamicSharedMemorySize, LDS_BYTES) != hipSuccess) { grid = -1; return; }
        if (hipOccupancyMaxActiveBlocksPerMultiprocessor(&per_cu, (const void*)fwd, NWAVES * 64, LDS_BYTES) != hipSuccess || per_cu < 1) { fprintf(stderr, "kernel_launch: occupancy query says %d\n", per_cu); }
        (void)hipGetLastError();
        grid = cus;
    }
    if (grid < 0) return;
    if (hipMemsetAsync((char*)d_ws + WS_CTL, 0, CTL_ZERO_BYTES, stream) != hipSuccess) return;
    Args a{};
    for (int i = 0; i < 23; ++i) a.in[i] = d_in[i];
    a.out = (float*)d_out; a.ws = (unsigned char*)d_ws; a.pad = 0;
#if MK_N_LAUNCHES == 1
    a.ph_lo = 0; a.ph_hi = NPH; a.li = 0;
    hipLaunchKernelGGL(fwd, dim3(grid), dim3(NWAVES * 64), LDS_BYTES, stream, a);
#else
    for (int ph = 0; ph < NPH; ++ph) { a.ph_lo = ph; a.ph_hi = ph + 1; a.li = ph; hipLaunchKernelGGL(fwd, dim3(grid), dim3(NWAVES * 64), LDS_BYTES, stream, a); }
#endif
}
```
